# Optimizing an MI355X kernel written in HIP

```python
import math
import jax
import jax.numpy as jnp
from jax import lax
import numpy as np

D_MODEL = 1024
BATCH = 2
SEQ = 8192
DEPTH = 2

LRU_WIDTH = 512
LRU_BLOCKS = 8
LRU_BD = LRU_WIDTH // LRU_BLOCKS
LRU_C = 8.0
CONV_W = 4
DIFF_HEADS = 4
DIFF_HD = 64
DIFF_QBLK = 128
SWA_HEADS = 8
SWA_KV_HEADS = 2
SWA_GROUP = SWA_HEADS // SWA_KV_HEADS
SWA_HD = 64
WINDOW = 128
SWA_BLK = WINDOW
N_BRANCHES = 3
BRANCH_WIDTH = 512
REL_BUCKETS = 32
REL_MAX_DIST = 128
N_ATTN_HEADS = DIFF_HEADS + SWA_HEADS
N_EXPERTS = 32
TOP_K = 4
D_FF = 1024
SWIGLU_LIMIT = 7.0
SWIGLU_ALPHA = 1.702
MOE_BLK = 128
NORM_EPS = 1e-6
NEG_INF = -1e30

IN_SPLITS = (LRU_WIDTH, LRU_WIDTH,
             DIFF_HEADS * 2 * DIFF_HD, DIFF_HEADS * 2 * DIFF_HD, DIFF_HEADS * 2 * DIFF_HD,
             SWA_HEADS * SWA_HD, SWA_KV_HEADS * SWA_HD, SWA_KV_HEADS * SWA_HD,
             N_BRANCHES * D_MODEL)
IN_WIDTH = sum(IN_SPLITS)

kernel_name = 'hybrid_rglru_diffattn_swa_moe_block'


def rms_norm(x, gain):
    xf = x.astype(jnp.float32)
    y = xf * lax.rsqrt(jnp.mean(xf * xf, axis=-1, keepdims=True) + NORM_EPS)
    return (y * gain.astype(jnp.float32)).astype(x.dtype)


def t5_bucket(dist):
    exact = REL_BUCKETS // 2
    is_small = dist < exact
    log_ratio = jnp.log(jnp.maximum(dist, 1).astype(jnp.float32) / exact) / math.log(REL_MAX_DIST / exact)
    large = exact + (log_ratio * (REL_BUCKETS - exact)).astype(jnp.int32)
    return jnp.where(is_small, dist, jnp.minimum(large, REL_BUCKETS - 1))


def rglru_branch(xr, gr, conv_w, conv_b, wa, ba, wx, bx, lam):
    B, S, C = xr.shape
    xp = jnp.pad(xr, ((0, 0), (CONV_W - 1, 0), (0, 0)))
    xc = conv_b + sum(xp[:, tap:tap + S] * conv_w[tap] for tap in range(CONV_W))
    xh = xc.reshape(B, S, LRU_BLOCKS, LRU_BD)
    gate_a = jnp.einsum('bshi,hij->bshj', xh, wa).reshape(B, S, C) + ba
    gate_x = jnp.einsum('bshi,hij->bshj', xh, wx).reshape(B, S, C) + bx
    r = jax.nn.sigmoid(gate_a.astype(jnp.float32))
    i = jax.nn.sigmoid(gate_x.astype(jnp.float32))
    log_a = -LRU_C * r * jax.nn.softplus(-lam.astype(jnp.float32))
    a = jnp.exp(log_a)
    mult = jnp.sqrt(-jnp.expm1(2.0 * log_a))
    b = xc.astype(jnp.float32) * i * mult

    def combine(left, right):
        a1, b1 = left
        a2, b2 = right
        return a1 * a2, a2 * b1 + b2

    _, h = lax.associative_scan(combine, (a, b), axis=1)
    return (h * jax.nn.gelu(gr.astype(jnp.float32), approximate=True)).astype(xr.dtype)


def diff_attention(q, k, v, q_gain, k_gain, lam_vecs, subln_gain, bias_table, lambda_init):
    B, S = q.shape[:2]
    nb = S // DIFF_QBLK
    q = rms_norm(q, q_gain)
    k = rms_norm(k, k_gain)
    lv = lam_vecs.astype(jnp.float32)
    lam = jnp.exp(jnp.sum(lv[0] * lv[1])) - jnp.exp(jnp.sum(lv[2] * lv[3])) + lambda_init
    bias_by_dist = bias_table[t5_bucket(jnp.arange(S))][:, :DIFF_HEADS].astype(jnp.float32)
    k_pos = jnp.arange(S)
    q_blocks = jnp.moveaxis(q.reshape(B, nb, DIFF_QBLK, DIFF_HEADS, 2, DIFF_HD), 1, 0)

    def attend_block(args):
        q_blk, blk = args
        dist = (blk * DIFF_QBLK + jnp.arange(DIFF_QBLK))[:, None] - k_pos[None, :]
        bias = jnp.moveaxis(bias_by_dist[jnp.maximum(dist, 0)], -1, 0)
        s = jnp.einsum('bqhmd,bkhmd->bhmqk', q_blk, k).astype(jnp.float32) * DIFF_HD ** -0.5
        s = jnp.where(dist >= 0, s + bias[None, :, None], NEG_INF)
        p = jax.nn.softmax(s, axis=-1)
        attn = (p[:, :, 0] - lam * p[:, :, 1]).astype(v.dtype)
        return jnp.einsum('bhqk,bkhe->bqhe', attn, v)

    o = lax.map(attend_block, (q_blocks, jnp.arange(nb)))
    o = jnp.moveaxis(o, 0, 1).reshape(B, S, DIFF_HEADS, 2 * DIFF_HD)
    o = rms_norm(o, subln_gain) * (1.0 - lambda_init)
    return o.reshape(B, S, DIFF_HEADS * 2 * DIFF_HD)


def swa_attention(q, k, v, q_gain, k_gain, sinks, bias_table):
    B, S = q.shape[:2]
    nb = S // SWA_BLK
    q = rms_norm(q, q_gain).reshape(B, nb, SWA_BLK, SWA_KV_HEADS, SWA_GROUP, SWA_HD)
    k = rms_norm(k, k_gain).reshape(B, nb, SWA_BLK, SWA_KV_HEADS, SWA_HD)
    v = v.reshape(B, nb, SWA_BLK, SWA_KV_HEADS, SWA_HD)

    def band(t):
        prev = jnp.pad(t, ((0, 0), (1, 0), (0, 0), (0, 0), (0, 0)))[:, :-1]
        return jnp.concatenate([prev, t], axis=2)

    k_band, v_band = band(k), band(v)
    qi = jnp.arange(SWA_BLK)[:, None]
    kj = jnp.arange(2 * SWA_BLK)[None, :]
    dist = SWA_BLK + qi - kj
    in_window = (dist >= 0) & (dist < WINDOW)
    has_prev = (jnp.arange(nb) > 0)[:, None, None] | (kj >= SWA_BLK)[None]
    mask = in_window[None] & has_prev
    bias = bias_table[t5_bucket(jnp.clip(dist, 0, WINDOW - 1))][..., DIFF_HEADS:].astype(jnp.float32)
    bias = bias.reshape(SWA_BLK, 2 * SWA_BLK, SWA_KV_HEADS, SWA_GROUP).transpose(2, 3, 0, 1)
    s = jnp.einsum('bnqhgd,bnkhd->bnhgqk', q, k_band).astype(jnp.float32) * SWA_HD ** -0.5 + bias
    s = jnp.where(mask[None, :, None, None], s, NEG_INF)
    sink = jnp.broadcast_to(sinks.astype(jnp.float32).reshape(SWA_KV_HEADS, SWA_GROUP, 1, 1),
                            s.shape[:-1] + (1,))
    p = jax.nn.softmax(jnp.concatenate([s, sink], axis=-1), axis=-1)[..., :-1]
    o = jnp.einsum('bnhgqk,bnkhd->bnqhgd', p.astype(v.dtype), v_band)
    return o.reshape(B, S, SWA_HEADS * SWA_HD)


def hybrid_mixer(h, w_in, conv_w, conv_b, lru_wa, lru_ba, lru_wx, lru_bx, lru_lambda,
                 diff_qnorm, diff_knorm, diff_lambda, diff_subln,
                 swa_qnorm, swa_knorm, swa_sinks, rel_bias, w_branch, w_out, lambda_init):
    B, S, D = h.shape
    proj = h @ w_in
    offsets = []
    acc = 0
    for width in IN_SPLITS[:-1]:
        acc += width
        offsets.append(acc)
    xr, gr, dq, dk, dv, sq, sk, sv, gl = jnp.split(proj, offsets, axis=-1)
    o_lru = rglru_branch(xr, gr, conv_w, conv_b, lru_wa, lru_ba, lru_wx, lru_bx, lru_lambda)
    o_diff = diff_attention(dq.reshape(B, S, DIFF_HEADS, 2, DIFF_HD),
                            dk.reshape(B, S, DIFF_HEADS, 2, DIFF_HD),
                            dv.reshape(B, S, DIFF_HEADS, 2 * DIFF_HD),
                            diff_qnorm, diff_knorm, diff_lambda, diff_subln, rel_bias, lambda_init)
    o_swa = swa_attention(sq.reshape(B, S, SWA_HEADS, SWA_HD),
                          sk.reshape(B, S, SWA_KV_HEADS, SWA_HD),
                          sv.reshape(B, S, SWA_KV_HEADS, SWA_HD),
                          swa_qnorm, swa_knorm, swa_sinks, rel_bias)
    branches = jnp.stack([o_lru, o_diff, o_swa], axis=2)
    branch_proj = jnp.einsum('bsnc,ncd->bsnd', branches, w_branch)
    gates = jax.nn.sigmoid(gl).reshape(B, S, N_BRANCHES, D)
    merged = jnp.einsum('bsnd,bsnd->bsd', gates, branch_proj)
    return merged @ w_out


def moe_ffn(h, w_router, b_router, w1, b1, w2, b2):
    B, S, D = h.shape
    T = B * S
    xt = h.reshape(T, D)
    logits = xt.astype(jnp.float32) @ w_router.astype(jnp.float32) + b_router.astype(jnp.float32)
    top_v, top_e = lax.top_k(logits, TOP_K)
    weights = jax.nn.softmax(top_v, axis=-1).astype(xt.dtype)
    n_pairs = T * TOP_K
    flat_e = top_e.reshape(-1)
    order = jnp.argsort(flat_e)
    sorted_e = flat_e[order]
    counts = jnp.bincount(flat_e, length=N_EXPERTS)
    starts = jnp.cumsum(counts) - counts
    padded = (counts + MOE_BLK - 1) // MOE_BLK * MOE_BLK
    pad_ends = jnp.cumsum(padded)
    pad_starts = pad_ends - padded
    dest_sorted = pad_starts[sorted_e] + (jnp.arange(n_pairs) - starts[sorted_e])
    n_rows = (n_pairs + MOE_BLK - 1) // MOE_BLK * MOE_BLK + N_EXPERTS * MOE_BLK
    n_blocks = n_rows // MOE_BLK
    row_token = jnp.full((n_rows,), T, jnp.int32).at[dest_sorted].set((order // TOP_K).astype(jnp.int32))
    dest = jnp.zeros_like(order).at[order].set(dest_sorted)
    block_expert = jnp.minimum(jnp.searchsorted(pad_ends, jnp.arange(n_blocks) * MOE_BLK, side='right'),
                               N_EXPERTS - 1)
    x_pad = jnp.concatenate([xt, jnp.zeros((1, D), xt.dtype)], axis=0)

    def expert_block(args):
        tok, e = args
        hcat = x_pad[tok] @ w1[e] + b1[e]
        x_glu = jnp.minimum(hcat[:, ::2], SWIGLU_LIMIT)
        x_lin = jnp.clip(hcat[:, 1::2], -SWIGLU_LIMIT, SWIGLU_LIMIT)
        act = x_glu * jax.nn.sigmoid(SWIGLU_ALPHA * x_glu) * (x_lin + 1.0)
        return act @ w2[e] + b2[e]

    y = lax.map(expert_block, (row_token.reshape(n_blocks, MOE_BLK), block_expert)).reshape(n_rows, D)
    out = jnp.sum(y[dest].reshape(T, TOP_K, D) * weights[..., None], axis=1)
    return out.reshape(B, S, D)


def setup_inputs(seed: int = 0) -> dict:
    key = jax.random.key(seed)
    keys = jax.random.split(key, 40)
    counter = [0]

    def next_key():
        k = keys[counter[0]]
        counter[0] += 1
        return k

    def nrm(shape, scale):
        return jax.random.normal(next_key(), shape, jnp.float32) * scale

    L = DEPTH
    D = D_MODEL
    x = nrm((BATCH, SEQ, D), 1.0)
    c = nrm((BATCH, D), 1.0)
    w_ada = nrm((L, D, 6 * D), 0.5 * D ** -0.5)
    b_ada = nrm((L, 6 * D), 0.02)
    norm_mix = 1.0 + nrm((L, D), 0.02)
    norm_ffn = 1.0 + nrm((L, D), 0.02)
    w_in = nrm((L, D, IN_WIDTH), D ** -0.5)
    conv_w = nrm((L, CONV_W, LRU_WIDTH), CONV_W ** -0.5)
    conv_b = nrm((L, LRU_WIDTH), 0.02)
    lru_wa = nrm((L, LRU_BLOCKS, LRU_BD, LRU_BD), LRU_BD ** -0.5)
    lru_ba = nrm((L, LRU_WIDTH), 0.02)
    lru_wx = nrm((L, LRU_BLOCKS, LRU_BD, LRU_BD), LRU_BD ** -0.5)
    lru_bx = nrm((L, LRU_WIDTH), 0.02)
    radius = jax.random.uniform(next_key(), (L, LRU_WIDTH), jnp.float32, 0.9, 0.999)
    lru_lambda = -jnp.log(jnp.expm1(-jnp.log(radius) / LRU_C))
    diff_qnorm = 1.0 + nrm((L, DIFF_HD), 0.02)
    diff_knorm = 1.0 + nrm((L, DIFF_HD), 0.02)
    diff_lambda = nrm((L, 4, DIFF_HD), 0.1)
    diff_subln = 1.0 + nrm((L, 2 * DIFF_HD), 0.02)
    swa_qnorm = 1.0 + nrm((L, SWA_HD), 0.02)
    swa_knorm = 1.0 + nrm((L, SWA_HD), 0.02)
    swa_sinks = nrm((L, SWA_HEADS), 0.5)
    rel_bias = nrm((REL_BUCKETS, N_ATTN_HEADS), 0.5)
    w_branch = nrm((L, N_BRANCHES, BRANCH_WIDTH, D), BRANCH_WIDTH ** -0.5)
    w_out = nrm((L, D, D), D ** -0.5)
    w_router = nrm((L, D, N_EXPERTS), D ** -0.5)
    b_router = nrm((L, N_EXPERTS), 0.01)
    w1 = nrm((L, N_EXPERTS, D, 2 * D_FF), D ** -0.5)
    b1 = nrm((L, N_EXPERTS, 2 * D_FF), 0.02)
    w2 = nrm((L, N_EXPERTS, D_FF, D), D_FF ** -0.5)
    b2 = nrm((L, N_EXPERTS, D), 0.02)
    return {'x': x, 'c': c, 'w_ada': w_ada, 'b_ada': b_ada, 'norm_mix': norm_mix, 'norm_ffn': norm_ffn,
            'w_in': w_in, 'conv_w': conv_w, 'conv_b': conv_b, 'lru_wa': lru_wa, 'lru_ba': lru_ba,
            'lru_wx': lru_wx, 'lru_bx': lru_bx, 'lru_lambda': lru_lambda, 'diff_qnorm': diff_qnorm,
            'diff_knorm': diff_knorm, 'diff_lambda': diff_lambda, 'diff_subln': diff_subln,
            'swa_qnorm': swa_qnorm, 'swa_knorm': swa_knorm, 'swa_sinks': swa_sinks, 'rel_bias': rel_bias,
            'w_branch': w_branch, 'w_out': w_out, 'w_router': w_router, 'b_router': b_router,
            'w1': w1, 'b1': b1, 'w2': w2, 'b2': b2}


def reference(x, c, w_ada, b_ada, norm_mix, norm_ffn, w_in, conv_w, conv_b, lru_wa, lru_ba,
              lru_wx, lru_bx, lru_lambda, diff_qnorm, diff_knorm, diff_lambda, diff_subln,
              swa_qnorm, swa_knorm, swa_sinks, rel_bias, w_branch, w_out, w_router, b_router,
              w1, b1, w2, b2):
    cond = jax.nn.silu(c)
    for layer in range(DEPTH):
        mod = cond @ w_ada[layer] + b_ada[layer]
        sh_m, sc_m, g_m, sh_f, sc_f, g_f = [m[:, None, :] for m in jnp.split(mod, 6, axis=-1)]
        lambda_init = 0.8 - 0.6 * math.exp(-0.3 * layer)
        h = rms_norm(x, norm_mix[layer]) * (1.0 + sc_m) + sh_m
        x = x + g_m * hybrid_mixer(h, w_in[layer], conv_w[layer], conv_b[layer], lru_wa[layer],
                                   lru_ba[layer], lru_wx[layer], lru_bx[layer], lru_lambda[layer],
                                   diff_qnorm[layer], diff_knorm[layer], diff_lambda[layer],
                                   diff_subln[layer], swa_qnorm[layer], swa_knorm[layer],
                                   swa_sinks[layer], rel_bias, w_branch[layer], w_out[layer],
                                   lambda_init)
        h = rms_norm(x, norm_ffn[layer]) * (1.0 + sc_f) + sh_f
        x = x + g_f * moe_ffn(h, w_router[layer], b_router[layer], w1[layer], b1[layer],
                              w2[layer], b2[layer])
    return x
```

```cpp
#include <hip/hip_runtime.h>
#include <hip/hip_bf16.h>
#include <cstdio>
#include <cstdint>
#include <cmath>
namespace pg8 {
#define PG8_LAS __attribute__((address_space(3)))
typedef unsigned short bf16_t;
typedef short bf16x8 __attribute__((ext_vector_type(8)));
typedef float f32x4 __attribute__((ext_vector_type(4)));
typedef unsigned u32x4 __attribute__((ext_vector_type(4)));
constexpr int BM = 256, BK = 64, HALF = 128, HTB = HALF * BK * 2  , STAGE_BYTES = 8 * HTB, NXCD = 8, WGM = 8;

__host__ __device__ __forceinline__ int lds_byte(int r, int c) { const int st = (r >> 4) * 2 + (c >> 5), rr = r & 15, cc = c & 31, ob = rr * 64 + cc * 2; return st * 1024 + (ob ^ (((ob >> 9) & 1) << 5)); }
__host__ __device__ __forceinline__ void stage_rc(int b, int& R, int& C) { const int st = b / 1024, sb = b % 1024, swz = sb ^ (((sb >> 9) & 1) << 5); R = (st >> 1) * 16 + swz / 64; C = (st & 1) * 32 + (swz % 64) / 2; }
__host__ __device__ __forceinline__ int perm32(int rho) { const int n = rho >> 4, i = rho & 15; return 8 * (i >> 2) + 4 * n + (i & 3); }

struct Unit { int pm, pn; };
struct Gemm { const bf16_t* A; const bf16_t* Bt; int M, N, K; };

struct StaticOrder {
    int nM, nN, nwg, G, c;
    __host__ __device__ void init(int M, int N, int G_, int c_) { nM = M / BM; nN = N / BM; nwg = nM * nN; G = G_; c = c_; }
    __host__ __device__ bool next(int i, Unit& u) const {
        const long L = (long)i * G + c; if (L >= nwg) return false;
        int wgid = (int)L; { const int q = nwg / NXCD, r = nwg % NXCD, xcd = wgid % NXCD, off = wgid / NXCD; wgid = (xcd < r ? xcd * (q + 1) : r * (q + 1) + (xcd - r) * q) + off; }
        const int nig = WGM * nN, gid = wgid / nig, fm = gid * WGM, gsz = (nM - fm) < WGM ? (nM - fm) : WGM;
        u.pm = fm + ((wgid % nig) % gsz); u.pn = (wgid % nig) / gsz; return true;
    }
    __device__ __forceinline__ void a_ready(const Unit&) const {}
    __device__ __forceinline__ void done(const Unit&) const {}
};

__device__ __forceinline__ unsigned cvt_pk_bf16(float lo, float hi) { unsigned r; asm volatile("v_cvt_pk_bf16_f32 %0, %1, %2" : "=v"(r) : "v"(lo), "v"(hi)); return r; }
typedef float f32x2 __attribute__((ext_vector_type(2)));
__device__ __forceinline__ f32x2 gelu_pk(f32x2 v) {
    const f32x2 av = __builtin_elementwise_abs(v), d = av * 0.2316418882f + 1.0f;
    f32x2 t; t.x = __builtin_amdgcn_rcpf(d.x); t.y = __builtin_amdgcn_rcpf(d.y);
    f32x2 q = t * 0.5307027145f + (-0.7265760135f); q = q * t + 0.7107068705f; q = q * t + (-0.142248368f); q = q * t + 0.127414796f; q = q * t;
    const f32x2 s = (v * v) * (-0.72134752044f);
    f32x2 e; e.x = __builtin_amdgcn_exp2f(s.x); e.y = __builtin_amdgcn_exp2f(s.y);
    const f32x2 m = v * (q * e), r = v - m;
    f32x2 o; o.x = v.x < 0.f ? m.x : r.x; o.y = v.y < 0.f ? m.y : r.y; return o;
}

template <int ACT  > struct EpiBf16 {
    static constexpr bool PERM = true, AFTER_DRAIN = false; static_assert(ACT == 0 || ACT == 1, "EpiBf16: ACT is 0 (none) or 1 (gelu_pk)");
    bf16_t* O; int ldc; const float* bias; int split_cols; size_t split_stride; float scale0;
    __device__ __forceinline__ void operator()(const f32x4 (&acc)[2][2][4][2], const Unit& u, int wr, int wc, int fr, int fq) const {
        const int row0 = u.pm * BM + wr * 64 + fr; int colt = u.pn * BM; bf16_t* base = O;
        float sc = 1.f; if (split_cols) { const int t = colt / split_cols; base += (size_t)t * split_stride; colt -= t * split_cols; if (t == 0) sc = scale0; }
        const int col0 = colt + wc * 32 + 8 * fq, bcol0 = u.pn * BM + wc * 32 + 8 * fq;
        f32x4 bv[2][2];
#pragma unroll
        for (int bj = 0; bj < 2; ++bj)
#pragma unroll
            for (int n = 0; n < 2; ++n) bv[bj][n] = bias ? *(const f32x4*)(bias + bcol0 + bj * HALF + 4 * n) : (f32x4){0.f, 0.f, 0.f, 0.f};
#pragma unroll
        for (int ai = 0; ai < 2; ++ai)
#pragma unroll
            for (int m = 0; m < 4; ++m) { bf16_t* rowp = base + (size_t)(row0 + ai * HALF + m * 16) * ldc + col0;
#pragma unroll
                for (int bj = 0; bj < 2; ++bj) { f32x4 v0 = acc[ai][bj][m][0] + bv[bj][0], v1 = acc[ai][bj][m][1] + bv[bj][1];
                    if (ACT == 1) { f32x2 a = gelu_pk((f32x2){v0[0], v0[1]}), b = gelu_pk((f32x2){v0[2], v0[3]}), c = gelu_pk((f32x2){v1[0], v1[1]}), d = gelu_pk((f32x2){v1[2], v1[3]});
                        v0 = (f32x4){a.x, a.y, b.x, b.y}; v1 = (f32x4){c.x, c.y, d.x, d.y}; }
                    v0 = v0 * sc; v1 = v1 * sc; u32x4 w; w.x = cvt_pk_bf16(v0[0], v0[1]); w.y = cvt_pk_bf16(v0[2], v0[3]); w.z = cvt_pk_bf16(v1[0], v1[1]); w.w = cvt_pk_bf16(v1[2], v1[3]);
                    *(u32x4*)(rowp + bj * HALF) = w; } }
    }
};

__device__ __forceinline__ float bf_lo(unsigned w) { return __uint_as_float(w << 16); }
__device__ __forceinline__ float bf_hi(unsigned w) { return __uint_as_float(w & 0xffff0000u); }
__device__ __forceinline__ float fast_sigmoid(float v) { return __builtin_amdgcn_rcpf(1.0f + __builtin_amdgcn_exp2f(-1.4426950408889634f * v)); }

struct EpiIn {
    static constexpr bool PERM = true, AFTER_DRAIN = false;
    bf16_t* O; int ldc; int gate_pn0; bf16_t* QKV; const float* gq; const float* gk; const float* gsq; const float* gsk; PG8_LAS float* xq; float qscale, eps;
    struct Pre {}; __device__ __forceinline__ void prefetch(Pre&, const Unit&, int, int, int, int) const {}
    __device__ __forceinline__ void operator()(const f32x4 (&acc)[2][2][4][2], const Unit& u, int wr, int wc, int fr, int fq, const Pre&) const {
        const int pn = u.pn, row0 = u.pm * BM + wr * 64 + fr, col0 = pn * BM + wc * 32 + 8 * fq; const bool gate = pn >= gate_pn0;
        const bool nrm = (pn >= 4 && pn <= 7) || (pn >= 10 && pn <= 12);
        if (!nrm) {
#pragma unroll
            for (int ai = 0; ai < 2; ++ai)
#pragma unroll
                for (int m = 0; m < 4; ++m) { const size_t rr = (size_t)(row0 + ai * HALF + m * 16); bf16_t* rowp = (pn == 8 || pn == 9) ? QKV + (size_t)2 * 16384 * 512 + rr * 512 + (col0 - 2048) : O + rr * ldc + col0;
#pragma unroll
                    for (int bj = 0; bj < 2; ++bj) { f32x4 v0 = acc[ai][bj][m][0], v1 = acc[ai][bj][m][1];
                        if (gate) {
#pragma unroll
                            for (int e = 0; e < 4; ++e) { v0[e] = fast_sigmoid(v0[e]); v1[e] = fast_sigmoid(v1[e]); } }
                        u32x4 w; w.x = cvt_pk_bf16(v0[0], v0[1]); w.y = cvt_pk_bf16(v0[2], v0[3]); w.z = cvt_pk_bf16(v1[0], v1[1]); w.w = cvt_pk_bf16(v1[2], v1[3]);
                        *(u32x4*)(rowp + bj * HALF) = w; } }
            return;
        }
        const int wid = wr * 4 + wc;
#pragma unroll
        for (int ai = 0; ai < 2; ++ai)
#pragma unroll
            for (int m = 0; m < 4; ++m)
#pragma unroll
                for (int bj = 0; bj < 2; ++bj) { const f32x4 v0 = acc[ai][bj][m][0], v1 = acc[ai][bj][m][1];
                    float s = (v0[0] * v0[0] + v0[1] * v0[1]) + (v0[2] * v0[2] + v0[3] * v0[3]) + (v1[0] * v1[0] + v1[1] * v1[1]) + (v1[2] * v1[2] + v1[3] * v1[3]);
                    s += __shfl_xor(s, 16); s += __shfl_xor(s, 32);
                    if (fq == 0) xq[(((wid * 2 + ai) * 4 + m) * 2 + bj) * 16 + fr] = s; }
        asm volatile("s_waitcnt lgkmcnt(0)" ::: "memory"); __builtin_amdgcn_s_barrier(); asm volatile("" ::: "memory");
        const float sc = (pn <= 5 || pn == 10 || pn == 11) ? qscale : 1.0f; const int go = 32 * (wc & 1) + 8 * fq;
        const float* gp;
        { const float* p0 = gq; const float* p1 = gk; const float* p2 = gsq; const float* p3 = gsk;
          asm volatile("" : "+s"(p0)); asm volatile("" : "+s"(p1)); asm volatile("" : "+s"(p2)); asm volatile("" : "+s"(p3));
          gp = pn <= 5 ? p0 : (pn <= 7 ? p1 : (pn <= 11 ? p2 : p3)); }
        const f32x4 g0 = *(const f32x4*)(gp + go), g1 = *(const f32x4*)(gp + go + 4);
#pragma unroll
        for (int ai = 0; ai < 2; ++ai)
#pragma unroll
            for (int m = 0; m < 4; ++m) { const size_t rr = (size_t)(row0 + ai * HALF + m * 16);
                bf16_t* rowp = pn <= 5 ? QKV + rr * 512 + (col0 - 1024) : (pn <= 7 ? QKV + (size_t)16384 * 512 + rr * 512 + (col0 - 1536) : O + rr * ldc + col0);
#pragma unroll
                for (int bj = 0; bj < 2; ++bj) { f32x4 v0 = acc[ai][bj][m][0], v1 = acc[ai][bj][m][1];
                    if (!(pn == 12 && bj == 1)) { const float tot = xq[(((wid * 2 + ai) * 4 + m) * 2 + bj) * 16 + fr] + xq[((((wid ^ 1) * 2 + ai) * 4 + m) * 2 + bj) * 16 + fr];
                        const float r = sc / sqrtf(tot * (1.0f / 64.0f) + eps); v0 = v0 * r * g0; v1 = v1 * r * g1; }
                    u32x4 w; w.x = cvt_pk_bf16(v0[0], v0[1]); w.y = cvt_pk_bf16(v0[2], v0[3]); w.z = cvt_pk_bf16(v1[0], v1[1]); w.w = cvt_pk_bf16(v1[2], v1[3]);
                    *(u32x4*)(rowp + bj * HALF) = w; } }
    }
};
struct EpiBranch {
    static constexpr bool PERM = true, AFTER_DRAIN = false;
    bf16_t* MG; const bf16_t* PROJ; int ldp;
    struct Pre {}; __device__ __forceinline__ void prefetch(Pre&, const Unit&, int, int, int, int) const {}
    __device__ __forceinline__ void operator()(const f32x4 (&acc)[2][2][4][2], const Unit& u, int wr, int wc, int fr, int fq, const Pre&) const {
        const int n = u.pm >> 6, pm = u.pm & 63, pn = u.pn & 3;
        const int row0 = pm * BM + wr * 64 + fr, col0 = pn * BM + wc * 32 + 8 * fq;
#pragma unroll
        for (int ai = 0; ai < 2; ++ai) {
            u32x4 gq[4][2], oq[4][2];
#pragma unroll
            for (int m = 0; m < 4; ++m) { const size_t row = (size_t)(row0 + ai * HALF + m * 16);
#pragma unroll
                for (int bj = 0; bj < 2; ++bj) { gq[m][bj] = *(const u32x4*)(PROJ + row * ldp + 3328 + n * 1024 + col0 + bj * HALF);
                    if (n > 0) oq[m][bj] = *(const u32x4*)(MG + row * 1024 + col0 + bj * HALF); } }
#pragma unroll
            for (int m = 0; m < 4; ++m) { const size_t row = (size_t)(row0 + ai * HALF + m * 16);
#pragma unroll
                for (int bj = 0; bj < 2; ++bj) {
                    const u32x4 g = gq[m][bj];
                    bf16_t* mp = MG + row * 1024 + col0 + bj * HALF;
                    f32x4 v0 = acc[ai][bj][m][0], v1 = acc[ai][bj][m][1];
                    v0[0] *= bf_lo(g.x); v0[1] *= bf_hi(g.x); v0[2] *= bf_lo(g.y); v0[3] *= bf_hi(g.y);
                    v1[0] *= bf_lo(g.z); v1[1] *= bf_hi(g.z); v1[2] *= bf_lo(g.w); v1[3] *= bf_hi(g.w);
                    if (n > 0) { const u32x4 o = oq[m][bj];
                        v0[0] += bf_lo(o.x); v0[1] += bf_hi(o.x); v0[2] += bf_lo(o.y); v0[3] += bf_hi(o.y);
                        v1[0] += bf_lo(o.z); v1[1] += bf_hi(o.z); v1[2] += bf_lo(o.w); v1[3] += bf_hi(o.w); }
                    u32x4 w; w.x = cvt_pk_bf16(v0[0], v0[1]); w.y = cvt_pk_bf16(v0[2], v0[3]); w.z = cvt_pk_bf16(v1[0], v1[1]); w.w = cvt_pk_bf16(v1[2], v1[3]);
                    *(u32x4*)mp = w; } } }
    }
};
template <bool IN_BF16> struct EpiOutT {
    static constexpr bool PERM = true, AFTER_DRAIN = false;
    const void* xin; bf16_t* xout; const float* gm;
    struct Pre { f32x4 gv[2][2]; };
    __device__ __forceinline__ void prefetch(Pre& P, const Unit& u, int wr, int wc, int fr, int fq) const { const int col0 = u.pn * BM + wc * 32 + 8 * fq; const int b = (u.pm * BM) >> 13;
#pragma unroll
        for (int bj = 0; bj < 2; ++bj)
#pragma unroll
            for (int n = 0; n < 2; ++n) P.gv[bj][n] = *(const f32x4*)(gm + (size_t)b * 6144 + col0 + bj * HALF + 4 * n); }
    __device__ __forceinline__ void operator()(const f32x4 (&acc)[2][2][4][2], const Unit& u, int wr, int wc, int fr, int fq, const Pre& P) const {
        const int row0 = u.pm * BM + wr * 64 + fr, col0 = u.pn * BM + wc * 32 + 8 * fq;
        const f32x4 (&gv)[2][2] = P.gv;
#pragma unroll
        for (int ai = 0; ai < 2; ++ai) {
            f32x4 xq[4][2][2]; u32x4 xb[4][2];
#pragma unroll
            for (int m = 0; m < 4; ++m) { const size_t off = (size_t)(row0 + ai * HALF + m * 16) * 1024 + col0;
#pragma unroll
                for (int bj = 0; bj < 2; ++bj) {
                    if constexpr (IN_BF16) xb[m][bj] = *(const u32x4*)((const bf16_t*)xin + off + bj * HALF);
                    else { xq[m][bj][0] = *(const f32x4*)((const float*)xin + off + bj * HALF); xq[m][bj][1] = *(const f32x4*)((const float*)xin + off + bj * HALF + 4); } } }
#pragma unroll
            for (int m = 0; m < 4; ++m) { const size_t off = (size_t)(row0 + ai * HALF + m * 16) * 1024 + col0;
#pragma unroll
                for (int bj = 0; bj < 2; ++bj) { f32x4 x0, x1;
                    if constexpr (IN_BF16) { const u32x4 w = xb[m][bj]; x0 = (f32x4){bf_lo(w.x), bf_hi(w.x), bf_lo(w.y), bf_hi(w.y)}; x1 = (f32x4){bf_lo(w.z), bf_hi(w.z), bf_lo(w.w), bf_hi(w.w)}; }
                    else { x0 = xq[m][bj][0]; x1 = xq[m][bj][1]; }
                    const f32x4 v0 = x0 + gv[bj][0] * acc[ai][bj][m][0], v1 = x1 + gv[bj][1] * acc[ai][bj][m][1];
                    u32x4 w; w.x = cvt_pk_bf16(v0[0], v0[1]); w.y = cvt_pk_bf16(v0[2], v0[3]); w.z = cvt_pk_bf16(v1[0], v1[1]); w.w = cvt_pk_bf16(v1[2], v1[3]);
                    *(u32x4*)(xout + off + bj * HALF) = w; } } }
    }
};
template <bool WT> struct EpiGluT {
    static constexpr bool PERM = true, AFTER_DRAIN = false;
    bf16_t* ACT; const float* b1;
    struct Pre { f32x4 bv[2][2]; };
    __device__ __forceinline__ void prefetch(Pre& P, const Unit& u, int wr, int wc, int fr, int fq) const { const int e = u.pn >> 3, pn = u.pn & 7, hc0 = pn * BM + wc * 32 + 8 * fq;
#pragma unroll
        for (int bj = 0; bj < 2; ++bj)
#pragma unroll
            for (int n = 0; n < 2; ++n) P.bv[bj][n] = *(const f32x4*)(b1 + (size_t)e * 2048 + hc0 + bj * HALF + 4 * n); }
    __device__ __forceinline__ void operator()(const f32x4 (&acc)[2][2][4][2], const Unit& u, int wr, int wc, int fr, int fq, const Pre& P) const {
        const int pn = u.pn & 7;
        const int row0 = u.pm * BM + wr * 64 + fr, ac0 = pn * 128 + wc * 16 + 4 * fq;
        const f32x4 (&bv)[2][2] = P.bv;
#pragma unroll
        for (int ai = 0; ai < 2; ++ai)
#pragma unroll
            for (int m = 0; m < 4; ++m) { bf16_t* rowp = ACT + (size_t)(row0 + ai * HALF + m * 16) * 1024 + ac0;
#pragma unroll
                for (int bj = 0; bj < 2; ++bj) { const f32x4 v0 = acc[ai][bj][m][0] + bv[bj][0], v1 = acc[ai][bj][m][1] + bv[bj][1];
                    float a[4];
#pragma unroll
                    for (int p = 0; p < 4; ++p) { const float gl = p < 2 ? v0[2 * p] : v1[2 * p - 4], ln = p < 2 ? v0[2 * p + 1] : v1[2 * p - 3];
                        const float xg = fminf(gl, 7.0f), xl = fminf(fmaxf(ln, -7.0f), 7.0f);
                        a[p] = xg * fast_sigmoid(1.702f * xg) * (xl + 1.0f); }
                    typedef unsigned u32x2 __attribute__((ext_vector_type(2)));
                    u32x2 w; w.x = cvt_pk_bf16(a[0], a[1]); w.y = cvt_pk_bf16(a[2], a[3]);
                    if constexpr (WT) __hip_atomic_store((unsigned long long*)(rowp + bj * 64), (unsigned long long)w.x | ((unsigned long long)w.y << 32), __ATOMIC_RELAXED, __HIP_MEMORY_SCOPE_AGENT);
                    else *(u32x2*)(rowp + bj * 64) = w; } }
    }
};
using EpiGlu = EpiGluT<false>;
struct EpiY {
    static constexpr bool PERM = true, AFTER_DRAIN = false;
    bf16_t* Y; const float* b2;
    struct Pre { f32x4 bv[2][2]; };
    __device__ __forceinline__ void prefetch(Pre& P, const Unit& u, int wr, int wc, int fr, int fq) const { const int e = u.pn >> 2, pn = u.pn & 3, col0 = pn * BM + wc * 32 + 8 * fq;
#pragma unroll
        for (int bj = 0; bj < 2; ++bj)
#pragma unroll
            for (int n = 0; n < 2; ++n) P.bv[bj][n] = *(const f32x4*)(b2 + (size_t)e * 1024 + col0 + bj * HALF + 4 * n); }
    __device__ __forceinline__ void operator()(const f32x4 (&acc)[2][2][4][2], const Unit& u, int wr, int wc, int fr, int fq, const Pre& P) const {
        const int pn = u.pn & 3;
        const int row0 = u.pm * BM + wr * 64 + fr, col0 = pn * BM + wc * 32 + 8 * fq;
        const f32x4 (&bv)[2][2] = P.bv;
#pragma unroll
        for (int ai = 0; ai < 2; ++ai)
#pragma unroll
            for (int m = 0; m < 4; ++m) { bf16_t* rowp = Y + (size_t)(row0 + ai * HALF + m * 16) * 1024 + col0;
#pragma unroll
                for (int bj = 0; bj < 2; ++bj) { const f32x4 v0 = acc[ai][bj][m][0] + bv[bj][0], v1 = acc[ai][bj][m][1] + bv[bj][1];
                    u32x4 w; w.x = cvt_pk_bf16(v0[0], v0[1]); w.y = cvt_pk_bf16(v0[2], v0[3]); w.z = cvt_pk_bf16(v1[0], v1[1]); w.w = cvt_pk_bf16(v1[2], v1[3]);
                    *(u32x4*)(rowp + bj * HALF) = w; } }
    }
};
struct BranchOrder {
    StaticOrder so;
    __device__ void init(int M, int G_, int c_) { so.init(M, 1024, G_, c_); }
    __device__ bool next(int i, Unit& u) const { const int r = i / 3, n = i - 3 * r; Unit t; if (!so.next(r, t)) return false; u.pm = n * 64 + t.pm; u.pn = n * 4 + t.pn; return true; }
    __device__ __forceinline__ void a_ready(const Unit&) const {}
    __device__ __forceinline__ void done(const Unit&) const {}
};
struct MoeOrder {
    const PG8_LAS int* tmap; int ntiles, npn, G, c;
    __device__ bool next(int i, Unit& u) const {
        const int L = i * G + c; if (L >= ntiles * npn) return false;
        const int j = L / npn, pn = L - j * npn; const int e = __builtin_amdgcn_readfirstlane(tmap[j]);
        u.pm = j; u.pn = e * npn + pn; return true; }
    __device__ __forceinline__ void a_ready(const Unit&) const {}
    __device__ __forceinline__ void done(const Unit&) const {}
};
struct MoeOrderSig : MoeOrder { unsigned* cnt;
    __device__ __forceinline__ void done(const Unit& u) const {
        asm volatile("s_waitcnt vmcnt(0)" ::: "memory");
        if (__builtin_amdgcn_mbcnt_hi(~0u, __builtin_amdgcn_mbcnt_lo(~0u, 0u)) == 0u) __hip_atomic_fetch_add(cnt + u.pm, 1u, __ATOMIC_RELAXED, __HIP_MEMORY_SCOPE_AGENT); } };
struct MoeOrderWait : MoeOrder { unsigned* cnt;
    __device__ __forceinline__ void a_ready(const Unit& u) const {
        while (__hip_atomic_load(cnt + u.pm, __ATOMIC_RELAXED, __HIP_MEMORY_SCOPE_AGENT) < 64u) __builtin_amdgcn_s_sleep(8);
        asm volatile("" ::: "memory"); } };
struct MoeOrderX {
    const PG8_LAS int* tm; int npn, xcd, cx;
    __device__ bool next(int i, Unit& u) const {
        int L = i * 32 + cx; const int cnt = __builtin_amdgcn_readfirstlane(tm[448 + xcd]);
        for (int q = 0; q < cnt; ++q) { const int e = __builtin_amdgcn_readfirstlane(tm[384 + xcd * 8 + q]); const int n = __builtin_amdgcn_readfirstlane(tm[352 + e]) * npn;
            if (L < n) { const int jt = L / npn, pn = L - jt * npn; u.pm = __builtin_amdgcn_readfirstlane(tm[320 + e]) + jt; u.pn = e * npn + pn; return true; }
            L -= n; }
        return false; }
    __device__ __forceinline__ void a_ready(const Unit&) const {}
    __device__ __forceinline__ void done(const Unit&) const {}
};

template <class Epi, class Sched, bool ALIGN_EPI = false, bool SP2 = false, bool GATHER = false>
__device__ __forceinline__ void gemm_phase(PG8_LAS unsigned char* lds, const Gemm g, const Sched& S, const Epi& E, const int tid, const PG8_LAS unsigned* rowoff = nullptr) {
    static_assert(!GATHER || SP2, "GATHER is implemented for the SP2 loop");
    const int wid = __builtin_amdgcn_readfirstlane(tid >> 6), lane = tid & 63, wr = wid >> 2, wc = wid & 3, fr = lane & 15, fq = lane >> 4;
    const int K = g.K, nt = K / BK;
    unsigned voffA[2], voffB[2];
#pragma unroll
    for (int i = 0; i < 2; ++i) { int R, C; stage_rc(tid * 16 + i * 8192, R, C); const int Rb = Epi::PERM ? ((R & ~31) + perm32(R & 31)) : R;
        voffA[i] = (unsigned)(R * K + C) * 2u; voffB[i] = (unsigned)(Rb * K + C) * 2u; }
    unsigned vAc[2][2], vAn[2][2]; int gR[2]; unsigned gC[2];
    if constexpr (GATHER) {
#pragma unroll
        for (int i = 0; i < 2; ++i) { int R, C; stage_rc(tid * 16 + i * 8192, R, C); gR[i] = R; gC[i] = (unsigned)C * 2u; }
#pragma unroll
        for (int h = 0; h < 2; ++h)
#pragma unroll
            for (int i = 0; i < 2; ++i) { vAc[h][i] = rowoff[h * HALF + gR[i]] + gC[i]; vAn[h][i] = vAc[h][i]; } }
    const size_t kstep = (size_t)(BK * 2);
    const size_t hstep = (size_t)HALF * K * 2;
    const size_t tstep = 2 * hstep;
    const unsigned ldsw = (unsigned)wid * 1024u;
    const int aoff = lds_byte(wr * 64 + fr, fq * 8), boff = lds_byte(wc * 32 + fr, fq * 8);
#define PG8_SA(b, h) (((b) * 2 + (h)) * HTB)
#define PG8_SB(b, h) ((4 + (b) * 2 + (h)) * HTB)
#define PG8_STAGE(bufoff, gbase, voff) do { _Pragma("unroll") for (int _i = 0; _i < 2; ++_i) \
        __builtin_amdgcn_global_load_lds((const unsigned*)((const char*)(gbase) + (voff)[_i]), (PG8_LAS unsigned*)(lds + (bufoff) + ldsw + _i * 8192), 16, 0, 0); } while (0)
#define PG8_LDA(dst, b, h) do { _Pragma("unroll") for (int m = 0; m < 4; ++m) _Pragma("unroll") for (int k = 0; k < 2; ++k) dst[m][k] = *(const PG8_LAS bf16x8*)(lds + PG8_SA(b, h) + aoff + m * 2048 + k * 1024); } while (0)
#define PG8_LDB(dst, b, h) do { _Pragma("unroll") for (int n = 0; n < 2; ++n) _Pragma("unroll") for (int k = 0; k < 2; ++k) dst[n][k] = *(const PG8_LAS bf16x8*)(lds + PG8_SB(b, h) + boff + n * 2048 + k * 1024); } while (0)
#define PG8_MMA(ai, bj, At, Bt) do { __builtin_amdgcn_s_setprio(1); _Pragma("unroll") for (int m = 0; m < 4; ++m) _Pragma("unroll") for (int n = 0; n < 2; ++n) _Pragma("unroll") for (int k = 0; k < 2; ++k) \
        acc[ai][bj][m][n] = __builtin_amdgcn_mfma_f32_16x16x32_bf16(Bt[n][k], At[m][k], acc[ai][bj][m][n], 0, 0, 0); __builtin_amdgcn_s_setprio(0); } while (0)
#define PG8_WAIT_V(n) asm volatile("s_waitcnt vmcnt(" #n ")" ::: "memory")
#define PG8_WAIT_L(n) asm volatile("s_waitcnt lgkmcnt(" #n ")" ::: "memory")
#define PG8_BAR __builtin_amdgcn_s_barrier()
#define PG8_SCHED __builtin_amdgcn_sched_barrier(0)
    Unit cur, nxt; int ui = 0;
    if (!S.next(0, cur)) return;
    f32x4 acc[2][2][4][2];
#pragma unroll
    for (int a = 0; a < 2; ++a)
#pragma unroll
        for (int b = 0; b < 2; ++b)
#pragma unroll
            for (int m = 0; m < 4; ++m)
#pragma unroll
                for (int n = 0; n < 2; ++n) acc[a][b][m][n] = (f32x4){0.f, 0.f, 0.f, 0.f};
    bf16x8 At[4][2], B0[2][2], B1[2][2];
    const char* cA = (const char*)g.A + (GATHER ? (size_t)0 : (size_t)cur.pm * tstep); const char* cB = (const char*)g.Bt + (size_t)cur.pn * tstep;
    S.a_ready(cur);
    if constexpr (SP2) {
        PG8_STAGE(PG8_SB(0, 0), cB, voffB); PG8_STAGE(PG8_SB(0, 1), cB + hstep, voffB);
        if constexpr (GATHER) { PG8_STAGE(PG8_SA(0, 0), cA, vAc[0]); PG8_STAGE(PG8_SA(0, 1), cA, vAc[1]); } else { PG8_STAGE(PG8_SA(0, 0), cA, voffA); PG8_STAGE(PG8_SA(0, 1), cA + hstep, voffA); }
        if (wr == 1) PG8_BAR;
        PG8_WAIT_V(2); PG8_BAR;
        PG8_STAGE(PG8_SB(1, 0), cB + kstep, voffB); if constexpr (GATHER) { PG8_STAGE(PG8_SA(1, 0), cA + kstep, vAc[0]); } else { PG8_STAGE(PG8_SA(1, 0), cA + kstep, voffA); } PG8_STAGE(PG8_SB(1, 1), cB + hstep + kstep, voffB);
        PG8_WAIT_V(6); PG8_BAR;
    } else {
        PG8_STAGE(PG8_SB(0, 0), cB, voffB); PG8_STAGE(PG8_SA(0, 0), cA, voffA); PG8_STAGE(PG8_SB(0, 1), cB + hstep, voffB); PG8_STAGE(PG8_SA(0, 1), cA + hstep, voffA);
        if (wr == 1) PG8_BAR;
        PG8_WAIT_V(4); PG8_BAR;
        PG8_STAGE(PG8_SB(1, 0), cB + kstep, voffB); PG8_STAGE(PG8_SA(1, 0), cA + kstep, voffA); PG8_STAGE(PG8_SB(1, 1), cB + hstep + kstep, voffB);
        PG8_WAIT_V(6); PG8_BAR;
    }
    for (;;) {
        const bool has_next = S.next(ui + 1, nxt);
        typename Epi::Pre epre; E.prefetch(epre, cur, wr, wc, fr, fq);
        const char* nA = (has_next && !GATHER) ? (const char*)g.A + (size_t)nxt.pm * tstep : cA;
        if constexpr (GATHER) { if (has_next) {
#pragma unroll
            for (int h = 0; h < 2; ++h)
#pragma unroll
                for (int i = 0; i < 2; ++i) vAn[h][i] = rowoff[(ui + 1) * BM + h * HALF + gR[i]] + gC[i]; } } const char* nB = has_next ? (const char*)g.Bt + (size_t)nxt.pn * tstep : cB;
        for (int t = 0; t < nt; t += 2) {
            const bool last = (t == nt - 2);
            const char* a1 = cA + (size_t)(t + 1) * kstep;
            const char* a2 = last ? nA : cA + (size_t)(t + 2) * kstep; const char* b2 = last ? nB : cB + (size_t)(t + 2) * kstep;
            const char* a3 = a2 + kstep; const char* b3 = b2 + kstep;
            if (last && has_next) S.a_ready(nxt);
            if constexpr (SP2) {
            unsigned s0_[2], s1_[2];
            if constexpr (GATHER) { s0_[0] = last ? vAn[0][0] : vAc[0][0]; s0_[1] = last ? vAn[0][1] : vAc[0][1]; s1_[0] = last ? vAn[1][0] : vAc[1][0]; s1_[1] = last ? vAn[1][1] : vAc[1][1]; }
            PG8_LDB(B0, 0, 0); PG8_LDB(B1, 0, 1); PG8_SCHED; PG8_LDA(At, 0, 0); if constexpr (GATHER) { PG8_STAGE(PG8_SA(1, 1), a1, vAc[1]); } else { PG8_STAGE(PG8_SA(1, 1), a1 + hstep, voffA); }
            PG8_WAIT_V(8); PG8_WAIT_L(0); PG8_BAR; PG8_MMA(0, 0, At, B0); PG8_MMA(0, 1, At, B1); PG8_BAR; PG8_SCHED;
            PG8_LDA(At, 0, 1); PG8_STAGE(PG8_SB(0, 0), b2, voffB); PG8_STAGE(PG8_SB(0, 1), b2 + hstep, voffB); if constexpr (GATHER) { PG8_STAGE(PG8_SA(0, 0), a2, s0_); } else { PG8_STAGE(PG8_SA(0, 0), a2, voffA); }
            PG8_WAIT_V(8); PG8_WAIT_L(0); PG8_BAR; PG8_MMA(1, 0, At, B0); PG8_MMA(1, 1, At, B1); PG8_BAR; PG8_SCHED;
            PG8_LDB(B0, 1, 0); PG8_LDB(B1, 1, 1); PG8_SCHED; PG8_LDA(At, 1, 0); if constexpr (GATHER) { PG8_STAGE(PG8_SA(0, 1), a2, s1_); } else { PG8_STAGE(PG8_SA(0, 1), a2 + hstep, voffA); }
            PG8_WAIT_V(8); PG8_WAIT_L(0); PG8_BAR; PG8_MMA(0, 0, At, B0); PG8_MMA(0, 1, At, B1); PG8_BAR; PG8_SCHED;
            PG8_LDA(At, 1, 1); PG8_STAGE(PG8_SB(1, 0), b3, voffB); PG8_STAGE(PG8_SB(1, 1), b3 + hstep, voffB); if constexpr (GATHER) { PG8_STAGE(PG8_SA(1, 0), a3, s0_); } else { PG8_STAGE(PG8_SA(1, 0), a3, voffA); }
            PG8_WAIT_V(8); PG8_WAIT_L(0); PG8_BAR; PG8_MMA(1, 0, At, B0); PG8_MMA(1, 1, At, B1); PG8_BAR; PG8_SCHED;
            } else {
            PG8_LDB(B0, 0, 0); PG8_SCHED; PG8_LDA(At, 0, 0); PG8_STAGE(PG8_SA(1, 1), a1 + hstep, voffA);
            PG8_WAIT_L(8); PG8_BAR; PG8_WAIT_L(0); PG8_MMA(0, 0, At, B0); PG8_BAR; PG8_SCHED;
            PG8_LDB(B1, 0, 1); PG8_STAGE(PG8_SB(0, 0), b2, voffB);
            PG8_BAR; PG8_WAIT_L(0); PG8_MMA(0, 1, At, B1); PG8_BAR;
            PG8_LDA(At, 0, 1); PG8_STAGE(PG8_SA(0, 0), a2, voffA);
            PG8_BAR; PG8_WAIT_L(0); PG8_MMA(1, 0, At, B0); PG8_BAR; PG8_SCHED;
            PG8_STAGE(PG8_SB(0, 1), b2 + hstep, voffB);
            PG8_WAIT_V(6); PG8_BAR; PG8_MMA(1, 1, At, B1); PG8_BAR;
            PG8_LDB(B0, 1, 0); PG8_SCHED; PG8_LDA(At, 1, 0); PG8_STAGE(PG8_SA(0, 1), a2 + hstep, voffA);
            PG8_WAIT_L(8); PG8_BAR; PG8_WAIT_L(0); PG8_MMA(0, 0, At, B0); PG8_BAR; PG8_SCHED;
            PG8_LDB(B1, 1, 1); PG8_STAGE(PG8_SB(1, 0), b3, voffB);
            PG8_BAR; PG8_WAIT_L(0); PG8_MMA(0, 1, At, B1); PG8_BAR;
            PG8_LDA(At, 1, 1); PG8_STAGE(PG8_SA(1, 0), a3, voffA);
            PG8_BAR; PG8_WAIT_L(0); PG8_MMA(1, 0, At, B0); PG8_BAR; PG8_SCHED;
            PG8_STAGE(PG8_SB(1, 1), b3 + hstep, voffB);
            PG8_WAIT_V(6); PG8_BAR; PG8_MMA(1, 1, At, B1); PG8_BAR;
            }
        }
        if constexpr (ALIGN_EPI) { if (wr == 0) PG8_BAR; }
        if constexpr (!Epi::AFTER_DRAIN) { E(acc, cur, wr, wc, fr, fq, epre); S.done(cur); }
        if (!has_next) break;
#pragma unroll
        for (int a = 0; a < 2; ++a)
#pragma unroll
            for (int b = 0; b < 2; ++b)
#pragma unroll
                for (int m = 0; m < 4; ++m)
#pragma unroll
                    for (int n = 0; n < 2; ++n) acc[a][b][m][n] = (f32x4){0.f, 0.f, 0.f, 0.f};
        cur = nxt; cA = nA; cB = nB; ++ui;
        if constexpr (GATHER) {
#pragma unroll
            for (int h = 0; h < 2; ++h)
#pragma unroll
                for (int i = 0; i < 2; ++i) vAc[h][i] = vAn[h][i]; }
        if constexpr (ALIGN_EPI) { if (wr == 1) PG8_BAR; }
    }
    PG8_WAIT_V(0);
    if constexpr (!ALIGN_EPI) { if (wr == 0) PG8_BAR; }
    PG8_BAR;
    if constexpr (Epi::AFTER_DRAIN) { E.fused(acc, cur, wr, wc, fr, fq, lds, wid, lane); S.done(cur); }
#undef PG8_SA
#undef PG8_SB
#undef PG8_STAGE
#undef PG8_LDA
#undef PG8_LDB
#undef PG8_MMA
#undef PG8_WAIT_V
#undef PG8_WAIT_L
#undef PG8_BAR
#undef PG8_SCHED
}
}

#ifndef PG8_SP2
#define PG8_SP2 true
#endif
#ifndef PG8_ALIGN
#define PG8_ALIGN true
#endif
#include <hip/hip_bf16.h>
#include <cmath>
namespace attn2 {
using bf16=__hip_bfloat16;
using bf16x8=__attribute__((ext_vector_type(8)))short;
using s16x4=__attribute__((ext_vector_type(4)))short;
using f32x16=__attribute__((ext_vector_type(16)))float;
using u32x4=__attribute__((ext_vector_type(4)))unsigned;
constexpr int BATCH=2,NHEAD=16,SEQ=8192,D=64,KVP=512,OP=1024;
constexpr int NW=8,QBLK=32,QB=QBLK*NW,KVBLK=64,NQB=SEQ/QB;
constexpr int ATTN_UNIT_ROWS=QB;
__device__ __forceinline__ int crow(int r,int hi){return (r&3)+8*(r>>2)+4*hi;}
#define SBAR() __builtin_amdgcn_sched_barrier(0)
__device__ __forceinline__ void cmask(f32x16&p0,f32x16&p1,int jb,int qrel,int hi,const float*tab){
  const float NEG=-INFINITY; int kb=64*jb+4*hi;
  #pragma unroll
  for(int r=0;r<16;++r){int kv=kb+(r&3)+8*(r>>2); const int d0=qrel-kv,d1=d0-32;
    const float b0=tab[d0<0?0:(d0>127?127:d0)],b1=tab[d1<0?0:(d1>127?127:d1)];
    p0[r]=(d0<0)?NEG:(p0[r]+b0); p1[r]=(d1<0)?NEG:(p1[r]+b1); if((r&1)==1){asm volatile("":"+v"(p0),"+v"(p1)::"memory");}}
}

constexpr int NSLOT=3, SLOTB=8192;
constexpr int LDS_K=0, LDS_V=NSLOT*SLOTB, LDS_WS=3*NSLOT*SLOTB, LDS_OST=LDS_WS+NW*64*4, LDS_BYTES=LDS_OST+NW*4096;
constexpr float C2=0.125f*1.4426950408889634f;
__device__ __forceinline__ void glds16(const void*gsrc,unsigned lds_dst){unsigned keep;
  asm volatile("s_mov_b32 %0, m0\n\ts_mov_b32 m0, %2\n\ts_nop 0\n\tglobal_load_lds_dwordx4 %1, off\n\ts_mov_b32 m0, %0":"=&s"(keep):"v"(gsrc),"s"(lds_dst):"memory");}
__device__ __forceinline__ float max3f(float a,float b,float c){float r;asm("v_max3_f32 %0, %1, %2, %3":"=v"(r):"v"(a),"v"(b),"v"(c));return r;}
__device__ __forceinline__ float max2f(float a,float b){float r;asm("v_max_f32_e32 %0, %1, %2":"=v"(r):"v"(a),"v"(b));return r;}
__device__ __forceinline__ float fadd_s(float a,float b){float r;asm("v_add_f32_e32 %0, %1, %2":"=v"(r):"v"(a),"v"(b));return r;}
__device__ __forceinline__ float fsub_s(float a,float b){float r;asm("v_sub_f32_e32 %0, %1, %2":"=v"(r):"v"(a),"v"(b));return r;}
typedef float f32x2_t __attribute__((ext_vector_type(2))); typedef __bf16 bf16x2_t __attribute__((ext_vector_type(2)));
__device__ __forceinline__ unsigned cvtpk_s(float lo,float hi){f32x2_t v={lo,hi};bf16x2_t b=__builtin_convertvector(v,bf16x2_t);return __builtin_bit_cast(unsigned,b);}
#define WAIT_BAR(N) asm volatile("s_waitcnt vmcnt(" #N ") lgkmcnt(0)\n\ts_barrier":::"memory")

__device__ __forceinline__ void qkt(f32x16&p0,f32x16&p1,const char*Kslot,const bf16x8*qr,int r32,int hi){ const f32x16 negm=f32x16{};
  const char*kb=Kslot+hi*1024+r32*16;
  #pragma unroll
  for(int d0=0;d0<4;++d0){
    const bf16x8 b0=*reinterpret_cast<const bf16x8*>(kb+d0*2048);
    const bf16x8 b1=*reinterpret_cast<const bf16x8*>(kb+d0*2048+512);
    if(d0==0){p0=__builtin_amdgcn_mfma_f32_32x32x16_bf16(b0,qr[0],negm,0,0,0);p1=__builtin_amdgcn_mfma_f32_32x32x16_bf16(b1,qr[0],negm,0,0,0);}
    else{p0=__builtin_amdgcn_mfma_f32_32x32x16_bf16(b0,qr[d0],p0,0,0,0);p1=__builtin_amdgcn_mfma_f32_32x32x16_bf16(b1,qr[d0],p1,0,0,0);}}
}
typedef __attribute__((address_space(3))) const char* lds_cptr;
typedef short v4i16_t __attribute__((ext_vector_type(4)));
__device__ __forceinline__ void kload8(bf16x8*kf,lds_cptr kp){
  kf[0]=*(const __attribute__((address_space(3))) bf16x8*)(kp);      kf[1]=*(const __attribute__((address_space(3))) bf16x8*)(kp+512);
  kf[2]=*(const __attribute__((address_space(3))) bf16x8*)(kp+2048); kf[3]=*(const __attribute__((address_space(3))) bf16x8*)(kp+2560);
  kf[4]=*(const __attribute__((address_space(3))) bf16x8*)(kp+4096); kf[5]=*(const __attribute__((address_space(3))) bf16x8*)(kp+4608);
  kf[6]=*(const __attribute__((address_space(3))) bf16x8*)(kp+6144); kf[7]=*(const __attribute__((address_space(3))) bf16x8*)(kp+6656);
}
__device__ __forceinline__ void kload2(bf16x8*kf,lds_cptr kp,int j){ kf[2*j]=*(const __attribute__((address_space(3))) bf16x8*)(kp+j*2048); kf[2*j+1]=*(const __attribute__((address_space(3))) bf16x8*)(kp+j*2048+512); }
__device__ __forceinline__ s16x4 vtr(lds_cptr p){ return __builtin_bit_cast(s16x4,__builtin_amdgcn_ds_read_tr16_b64_v4i16((__attribute__((address_space(3))) v4i16_t*)p)); }
__device__ __forceinline__ float rowmax(const f32x16&p0,const f32x16&p1){
  float a=max3f(p0[0],p0[1],p1[0]),b=max3f(p0[2],p0[3],p1[1]);a=max3f(a,p1[2],p1[3]);
  #pragma unroll
  for(int r=4;r<16;r+=4){a=max3f(a,p0[r],p0[r+1]);b=max3f(b,p0[r+2],p0[r+3]);a=max3f(a,p1[r],p1[r+1]);b=max3f(b,p1[r+2],p1[r+3]);}
  const float m=max2f(a,b);
  auto rr=__builtin_amdgcn_permlane32_swap(__float_as_uint(m),__float_as_uint(m),false,false);
  return max2f(__uint_as_float(rr[0]),__uint_as_float(rr[1]));
}
__device__ __forceinline__ void pv(f32x16*o,int vb,bf16x8 pa0,bf16x8 pa1,bf16x8 pa2,bf16x8 pa3){
  #pragma unroll
  for(int d0=0;d0<4;++d0){s16x4 lo[4],hi[4];
    #pragma unroll
    for(int ks=0;ks<4;++ks){
      asm volatile("ds_read_b64_tr_b16 %0,%1 offset:%c2":"=&v"(lo[ks]):"v"(vb),"i"(d0*4096+ks*1024):"memory");
      asm volatile("ds_read_b64_tr_b16 %0,%1 offset:%c2":"=&v"(hi[ks]):"v"(vb),"i"(d0*4096+ks*1024+512):"memory");}
    asm volatile("s_waitcnt lgkmcnt(0)":::"memory");SBAR();
    #define PK(k) (bf16x8){lo[k][0],lo[k][1],lo[k][2],lo[k][3],hi[k][0],hi[k][1],hi[k][2],hi[k][3]}
    o[d0]=__builtin_amdgcn_mfma_f32_32x32x16_bf16(pa0,PK(0),o[d0],0,0,0);
    o[d0]=__builtin_amdgcn_mfma_f32_32x32x16_bf16(pa1,PK(1),o[d0],0,0,0);
    o[d0]=__builtin_amdgcn_mfma_f32_32x32x16_bf16(pa2,PK(2),o[d0],0,0,0);
    o[d0]=__builtin_amdgcn_mfma_f32_32x32x16_bf16(pa3,PK(3),o[d0],0,0,0);
    #undef PK
  }
}

#ifndef ATTN_STORE16
#define ATTN_STORE16(p,v) (*(u32x4*)(p)=(v))
#endif
template<int THRL,bool FAST> __device__ __forceinline__ void attn_unit(int b,int hm,int qb,const bf16*PROJ,bf16*O,char*shm,const float*tab,const int tid){
  const int lane=tid&63,r32=lane&31,hi=lane>>5; const int wid=__builtin_amdgcn_readfirstlane(tid>>6);
  const long rowbase=(long)b*SEQ; const int q0=qb*QB;
  const bf16*Qw=PROJ+(rowbase+q0+wid*QBLK)*KVP+hm*64;
  const bf16*Kh=PROJ+(long)16384*512+rowbase*KVP+hm*64,*Vh=PROJ+(long)2*16384*512+rowbase*KVP+(hm>>1)*128;
  const unsigned lds0=(unsigned)(uintptr_t)shm;
  float*wsf=(float*)(shm+LDS_WS)+wid*64;
  const bf16*ksrc=Kh+(long)lane*KVP+wid*8;
  const bf16*vsrc=Vh+(long)(16*(wid&3)+(lane>>2))*KVP+(wid>>2)*32+(lane&3)*8;
  const unsigned kdst=lds0+LDS_K+wid*1024, vdst=lds0+LDS_V+wid*1024;
  #define DMA_K(t,slot) glds16(ksrc+(long)(t)*KVBLK*KVP,(unsigned)__builtin_amdgcn_readfirstlane(kdst+(slot)))
  #define DMA_V(t,slot) do{ glds16(vsrc+(long)(t)*KVBLK*KVP,(unsigned)__builtin_amdgcn_readfirstlane(vdst+2*(slot))); glds16(vsrc+64+(long)(t)*KVBLK*KVP,(unsigned)__builtin_amdgcn_readfirstlane(vdst+8192+2*(slot))); }while(0)
  const int vb0=(int)(lds0+LDS_V)+((lane>>4)&1)*32+(lane&3)*8+(4*hi+((lane&15)>>2))*64;
  const char*Kbase=shm+LDS_K; bf16x8 kf[8];
  const lds_cptr shm3=(lds_cptr)shm; const lds_cptr kp0=shm3+LDS_K+hi*1024+r32*16; const lds_cptr vp0=shm3+LDS_V+((lane>>4)&1)*32+(lane&3)*8+(4*hi+((lane&15)>>2))*64;
  const int NT=(q0+QB)/KVBLK;
  DMA_K(0,0);DMA_V(0,0);DMA_K(1,SLOTB);
  bf16x8 qr[4];
  #pragma unroll
  for(int d0=0;d0<4;++d0)qr[d0]=*reinterpret_cast<const bf16x8*>(&Qw[(long)r32*KVP+d0*16+hi*8]);
  float mhat=0.f,l_reg=0.f;f32x16 o[4];o[0]=f32x16{};o[1]=f32x16{};o[2]=f32x16{};o[3]=f32x16{};
  const int qrel=wid*QBLK+r32;
  #define CMASK(P0,P1,t) do{int jb_=(t)-(NT-4); if(jb_>=-3)cmask(P0,P1,jb_,qrel,hi,tab);}while(0)
  bool resc=false;
  #define START(P0,P1) do{ if constexpr(!FAST){ const float rm=rowmax(P0,P1); resc=false; \
    { const float dl=rm; mhat=fadd_s(mhat,dl); \
      _Pragma("unroll") for(int r=0;r<16;++r){P0[r]=fsub_s(P0[r],dl);P1[r]=fsub_s(P1[r],dl);} } } \
    _Pragma("unroll") for(int r=0;r<16;++r)P0[r]=__builtin_amdgcn_exp2f(P0[r]); }while(0)
  #define RESC() do{ if constexpr(!FAST) if(resc){ asm volatile("s_waitcnt lgkmcnt(0)":::"memory"); \
      _Pragma("unroll") for(int d_=0;d_<4;++d_) _Pragma("unroll") for(int r=0;r<16;++r)o[d_][r]*=wsf[crow(r,hi)]; } }while(0)
  f32x16 pA0,pA1,pB0,pB1;
  int sl_prev=0,sl_cur=0,sl_next=SLOTB;
  #define ROT() do{sl_prev=sl_cur;sl_cur=sl_next;sl_next=(sl_next==(NSLOT-1)*SLOTB)?0:sl_next+SLOTB;}while(0)
  DMA_K(2,2*SLOTB);
  WAIT_BAR(4);
  qkt(pA0,pA1,Kbase,qr,r32,hi);asm volatile("s_nop 15\n\ts_nop 7":"+v"(pA0),"+v"(pA1));CMASK(pA0,pA1,0);
  START(pA0,pA1);
  _Pragma("unroll") for(int r=0;r<16;++r)pA1[r]=__builtin_amdgcn_exp2f(pA1[r]);
  WAIT_BAR(0);
  DMA_K(3,0);DMA_V(1,SLOTB);
  ROT();
  kload8(kf,kp0+sl_cur);
  WAIT_BAR(3);
  s16x4 vlo[4],vhi[4]; u32x4 pw0,pw1,pw2,pw3;
  #define PKW(P,B) cvtpk_s(P[B],P[B+1])
  #define PAF(k) __builtin_bit_cast(bf16x8,pw##k)
  #define VFR(i) (bf16x8){vlo[i][0],vlo[i][1],vlo[i][2],vlo[i][3],vhi[i][0],vhi[i][1],vhi[i][2],vhi[i][3]}
  #define PIN(x) asm volatile("":"+v"(x))
  #define MX3(a,b,c) __builtin_fmaxf(__builtin_fmaxf((a),(b)),(c))
  #define GAPA(MF,A0,A1,A2,A3,W0,W1,PW) do{ MF; sacc+=A0; sacc+=A1; sacc+=A2; sacc+=A3; PIN(sacc); W0; W1; PIN(PW); SBAR(); }while(0)
  #define EX(v) __builtin_amdgcn_exp2f(v)
  #define GAPB(MF,X,B) do{ MF; X[B]=EX(X[B]); X[B+1]=EX(X[B+1]); X[B+2]=EX(X[B+2]); X[B+3]=EX(X[B+3]); PIN(X); SBAR(); }while(0)
  #define GAPB2(MF,X,B) do{ MF; X[B]=EX(X[B]); X[B+1]=EX(X[B+1]); PIN(X); SBAR(); }while(0)
  #define VRDN(k,db) do{ vlo[k]=vtr(vp_+((db)*4096+(k)*1024)); vhi[k]=vtr(vp_+((db)*4096+(k)*1024+512)); }while(0)
  #define VRD(i) do{ vlo[i]=vtr(vp_+(((i)>>2)*4096+((i)&3)*1024)); vhi[i]=vtr(vp_+(((i)>>2)*4096+((i)&3)*1024+512)); }while(0)
  #define KRD(G,j) do{ if(G){ kload2(kf,kp0+sl_next,j); SBAR(); } }while(0)
  #define STEP(C0,C1,P0,P1,t,GK,GV,GL) do{ SBAR(); \
    const lds_cptr vp_=vp0+2*sl_prev; const f32x16 zc_=f32x16{}; \
    VRDN(0,0); SBAR(); float sacc=(P0[0]+P0[1]); \
    GAPA(C0=__builtin_amdgcn_mfma_f32_32x32x16_bf16(kf[0],qr[0],zc_,0,0,0), P0[2],P0[3],P0[4],P0[5],     pw0[0]=PKW(P0,0), pw0[1]=PKW(P0,2), pw0); \
    GAPA(C1=__builtin_amdgcn_mfma_f32_32x32x16_bf16(kf[1],qr[0],zc_,0,0,0), P0[6],P0[7],P0[8],P0[9],     pw0[2]=PKW(P0,4), pw0[3]=PKW(P0,6), pw0); \
    VRDN(1,0); SBAR(); GAPA(C0=__builtin_amdgcn_mfma_f32_32x32x16_bf16(kf[2],qr[1],C0,0,0,0),   P0[10],P0[11],P0[12],P0[13], pw1[0]=PKW(P0,8), pw1[1]=PKW(P0,10), pw1); \
    GAPA(C1=__builtin_amdgcn_mfma_f32_32x32x16_bf16(kf[3],qr[1],C1,0,0,0),   P0[14],P0[15],P1[0],P1[1],   pw1[2]=PKW(P0,12),pw1[3]=PKW(P0,14), pw1); \
    VRDN(2,0); SBAR(); GAPA(C0=__builtin_amdgcn_mfma_f32_32x32x16_bf16(kf[4],qr[2],C0,0,0,0),   P1[2],P1[3],P1[4],P1[5],     pw2[0]=PKW(P1,0), pw2[1]=PKW(P1,2), pw2); \
    GAPA(C1=__builtin_amdgcn_mfma_f32_32x32x16_bf16(kf[5],qr[2],C1,0,0,0),   P1[6],P1[7],P1[8],P1[9],     pw2[2]=PKW(P1,4), pw2[3]=PKW(P1,6), pw2); \
    VRDN(3,0); SBAR(); GAPA(C0=__builtin_amdgcn_mfma_f32_32x32x16_bf16(kf[6],qr[3],C0,0,0,0),   P1[10],P1[11],P1[12],P1[13], pw3[0]=PKW(P1,8), pw3[1]=PKW(P1,10), pw3); \
    GAPA(C1=__builtin_amdgcn_mfma_f32_32x32x16_bf16(kf[7],qr[3],C1,0,0,0),   P1[14],P1[15],0.f,0.f,       pw3[2]=PKW(P1,12),pw3[3]=PKW(P1,14), pw3); \
    l_reg+=sacc; \
    if(GK){DMA_K((t)+3,sl_cur);} if(GV){DMA_V((t)+1,sl_next);} \
    if constexpr(!FAST){ _Pragma("unroll") for(int r=0;r<16;++r){C0[r]-=mhat;C1[r]-=mhat;} } \
    CMASK(C0,C1,t); \
    if constexpr(!FAST){ float a=MX3(C0[0],C0[1],C1[0]),b=MX3(C0[2],C0[3],C1[1]); a=MX3(a,C1[2],C1[3]); \
      _Pragma("unroll") for(int r=4;r<16;r+=4){a=MX3(a,C0[r],C0[r+1]);b=MX3(b,C0[r+2],C0[r+3]);a=MX3(a,C1[r],C1[r+1]);b=MX3(b,C1[r+2],C1[r+3]);} \
      float rm=__builtin_fmaxf(a,b); { auto rr=__builtin_amdgcn_permlane32_swap(__float_as_uint(rm),__float_as_uint(rm),false,false); rm=__builtin_fmaxf(__uint_as_float(rr[0]),__uint_as_float(rr[1])); } \
      resc=false; \
      if(__builtin_expect(__any(rm>(float)THRL),0)){ const float dl=__builtin_fmaxf(rm,0.f); mhat+=dl; \
        _Pragma("unroll") for(int r=0;r<16;++r){C0[r]-=dl;C1[r]-=dl;} \
        const float f=__builtin_amdgcn_exp2f(-dl); l_reg*=f; if(hi==0)wsf[r32]=f; resc=true; } } \
    SBAR(); \
    GAPB2(o[0]=__builtin_amdgcn_mfma_f32_32x32x16_bf16(PAF(0),VFR(0),o[0],0,0,0), C0,0); VRDN(0,1); SBAR(); \
    GAPB2(o[0]=__builtin_amdgcn_mfma_f32_32x32x16_bf16(PAF(1),VFR(1),o[0],0,0,0), C0,2); VRDN(1,1); SBAR(); \
    KRD(GL,0); GAPB2(o[0]=__builtin_amdgcn_mfma_f32_32x32x16_bf16(PAF(2),VFR(2),o[0],0,0,0), C0,4); VRDN(2,1); SBAR(); \
    KRD(GL,1); GAPB2(o[0]=__builtin_amdgcn_mfma_f32_32x32x16_bf16(PAF(3),VFR(3),o[0],0,0,0), C0,6); VRDN(3,1); SBAR(); \
    KRD(GL,2); GAPB2(o[1]=__builtin_amdgcn_mfma_f32_32x32x16_bf16(PAF(0),VFR(0),o[1],0,0,0), C0,8); VRDN(0,2); SBAR(); \
    KRD(GL,3); GAPB2(o[1]=__builtin_amdgcn_mfma_f32_32x32x16_bf16(PAF(1),VFR(1),o[1],0,0,0), C0,10); VRDN(1,2); SBAR(); \
    GAPB2(o[1]=__builtin_amdgcn_mfma_f32_32x32x16_bf16(PAF(2),VFR(2),o[1],0,0,0), C0,12); VRDN(2,2); SBAR(); \
    GAPB2(o[1]=__builtin_amdgcn_mfma_f32_32x32x16_bf16(PAF(3),VFR(3),o[1],0,0,0), C0,14); VRDN(3,2); SBAR(); \
    GAPB2(o[2]=__builtin_amdgcn_mfma_f32_32x32x16_bf16(PAF(0),VFR(0),o[2],0,0,0), C1,0); VRDN(0,3); SBAR(); \
    GAPB2(o[2]=__builtin_amdgcn_mfma_f32_32x32x16_bf16(PAF(1),VFR(1),o[2],0,0,0), C1,2); VRDN(1,3); SBAR(); \
    GAPB2(o[2]=__builtin_amdgcn_mfma_f32_32x32x16_bf16(PAF(2),VFR(2),o[2],0,0,0), C1,4); VRDN(2,3); SBAR(); \
    GAPB2(o[2]=__builtin_amdgcn_mfma_f32_32x32x16_bf16(PAF(3),VFR(3),o[2],0,0,0), C1,6); VRDN(3,3); SBAR(); \
    GAPB2(o[3]=__builtin_amdgcn_mfma_f32_32x32x16_bf16(PAF(0),VFR(0),o[3],0,0,0), C1,8); \
    GAPB2(o[3]=__builtin_amdgcn_mfma_f32_32x32x16_bf16(PAF(1),VFR(1),o[3],0,0,0), C1,10); \
    GAPB2(o[3]=__builtin_amdgcn_mfma_f32_32x32x16_bf16(PAF(2),VFR(2),o[3],0,0,0), C1,12); \
    GAPB2(o[3]=__builtin_amdgcn_mfma_f32_32x32x16_bf16(PAF(3),VFR(3),o[3],0,0,0), C1,14); \
    }while(0)
  int t=1;
  #undef CMASK
  #define CMASK(P0,P1,t) do{}while(0)
  for(;t+7<NT;t+=2){
    STEP(pB0,pB1,pA0,pA1,t,true,true,true);     WAIT_BAR(3); RESC(); ROT();
    STEP(pA0,pA1,pB0,pB1,t+1,true,true,true);   WAIT_BAR(3); RESC(); ROT();
  }
  #undef CMASK
  #define CMASK(P0,P1,t) do{int jb_=(t)-(NT-4); if(jb_>=-3)cmask(P0,P1,jb_,qrel,hi,tab);}while(0)
  #define ENDW(tt) do{ if((tt)+3<NT){WAIT_BAR(3);} else if((tt)+2<NT){WAIT_BAR(2);} else {WAIT_BAR(0);} }while(0)
  for(;t+1<NT;t+=2){
    STEP(pB0,pB1,pA0,pA1,t,(t+3<NT),(t+1<NT),(t+1<NT));       ENDW(t);   RESC(); ROT();
    STEP(pA0,pA1,pB0,pB1,t+1,(t+4<NT),(t+2<NT),(t+2<NT));     ENDW(t+1); RESC(); ROT();
  }
  STEP(pB0,pB1,pA0,pA1,NT-1,false,false,false); RESC();
  { float sacc=pB0[0]+pB0[1]; _Pragma("unroll") for(int r=2;r<16;++r)sacc+=pB0[r]; _Pragma("unroll") for(int r=0;r<16;++r)sacc+=pB1[r]; l_reg+=sacc;
    pw0=(u32x4){PKW(pB0,0),PKW(pB0,2),PKW(pB0,4),PKW(pB0,6)};pw1=(u32x4){PKW(pB0,8),PKW(pB0,10),PKW(pB0,12),PKW(pB0,14)};pw2=(u32x4){PKW(pB1,0),PKW(pB1,2),PKW(pB1,4),PKW(pB1,6)};pw3=(u32x4){PKW(pB1,8),PKW(pB1,10),PKW(pB1,12),PKW(pB1,14)};
    SBAR(); pv(o,vb0+2*sl_cur,PAF(0),PAF(1),PAF(2),PAF(3)); }
  #undef PKW
  #undef PAF
  #undef VFR
  #undef PIN
  #undef MX3
  #undef GAPA
  #undef GAPB
  #undef EX
  #undef VRD
  #undef VRDN
  #undef GAPB2
  #undef KRD
  #undef STEP
  #undef ENDW
  {auto rr=__builtin_amdgcn_permlane32_swap(__float_as_uint(l_reg),__float_as_uint(l_reg),false,false);l_reg=__uint_as_float(rr[0])+__uint_as_float(rr[1]);}
  if(hi==0)wsf[32+r32]=l_reg;asm volatile("s_waitcnt lgkmcnt(0)":::"memory");
  float rli[16];
  #pragma unroll
  for(int r=0;r<16;++r)rli[r]=__builtin_amdgcn_rcpf(wsf[32+crow(r,hi)]);
  bf16*Ow=O+(rowbase+q0+wid*QBLK)*OP+hm*128;
  { bf16*stg=(bf16*)(shm+LDS_OST)+wid*2048;
    #pragma unroll
    for(int pp=0;pp<2;++pp){
      #pragma unroll
      for(int r=0;r<16;++r){const int orow=crow(r,hi);
        #pragma unroll
        for(int d0=0;d0<2;++d0)stg[orow*64+d0*32+r32]=__float2bfloat16(o[2*pp+d0][r]*rli[r]);}
      asm volatile("s_waitcnt lgkmcnt(0)":::"memory");
      #pragma unroll
      for(int i=0;i<4;++i){const int row=i*8+(lane>>3),ch=lane&7; const u32x4 v=*(const u32x4*)(stg+row*64+ch*8); ATTN_STORE16(Ow+(long)row*OP+pp*64+ch*8,v);}
      asm volatile("s_waitcnt lgkmcnt(0)":::"memory"); } }
  asm volatile("s_waitcnt lgkmcnt(0)\n\ts_barrier":::"memory");
  #undef DMA_K
  #undef DMA_V
  #undef CMASK
  #undef START
  #undef RESC
  #undef ROT
}
constexpr int ATTN_LDS_BYTES=LDS_BYTES;
template<int THRL=8> __device__ __forceinline__ void attn_phase(char*lds,const bf16*QKV,bf16*ODT,const float*tab4,int vcu,const int tid,const int fast){
  const int bm=vcu>>4,x=vcu&15; const float*tab=tab4+((bm&7)>>1)*128;
  if(fast){ attn_unit<THRL,true>(bm>>3,bm&7,x,QKV,ODT,lds,tab,tid); attn_unit<THRL,true>(bm>>3,bm&7,31-x,QKV,ODT,lds,tab,tid); }
  else { attn_unit<THRL,false>(bm>>3,bm&7,x,QKV,ODT,lds,tab,tid); attn_unit<THRL,false>(bm>>3,bm&7,31-x,QKV,ODT,lds,tab,tid); }
}
#undef SBAR
#undef WAIT_BAR
}
namespace da {
typedef unsigned short bf16;
typedef short bf16x8 __attribute__((ext_vector_type(8)));
typedef short s16x4 __attribute__((ext_vector_type(4)));
typedef float f32x16 __attribute__((ext_vector_type(16)));
typedef unsigned u32x4 __attribute__((ext_vector_type(4)));
constexpr int NW = 8, QBLK = 32, KVBLK = 64, QB = NW * QBLK, DQ = 64, DV = 128;
constexpr int SHM_V = KVBLK * DV * 2, SHM_K = KVBLK * DQ * 2;
constexpr int LDS_BYTES = 2 * SHM_V + 2 * SHM_K + NW * 64 * 4;
constexpr float SCALE = 0.6931471805599453f;
constexpr float THR = 8.f;
#define DA_KSWZ(row, colB) ((row) * 128 + ((colB) ^ (((row) & 7) << 4)))
#define DA_SBAR() __builtin_amdgcn_sched_barrier(0)
__device__ __forceinline__ int v_st(int k, int c) { const int kk = (k & ~0xC) | ((k & 4) << 1) | ((k & 8) >> 1); return ((kk >> 3) * 4 + (c >> 5)) * 512 + ((kk & 7) * 32 + (c & 31)) * 2; }
__device__ __forceinline__ int v_rd_base(int lane) { return ((lane & 3) << 3) | (((lane >> 2) & 3) << 6) | (((lane >> 4) & 1) << 5) | (((lane >> 5) & 1) << 8); }
constexpr int v_rd_off(int d0, int ks, int half) { return d0 * 512 + ks * 4096 + half * 2048; }
__device__ __forceinline__ int crow(int r, int hi) { return (r & 3) + 8 * (r >> 2) + 4 * hi; }
__device__ __forceinline__ unsigned cvtpk(float lo, float hi) { unsigned r; asm volatile("v_cvt_pk_bf16_f32 %0, %1, %2" : "=v"(r) : "v"(lo), "v"(hi)); return r; }
__device__ __forceinline__ bf16x8 load8(const bf16* p) { return *reinterpret_cast<const bf16x8*>(p); }
__device__ __forceinline__ void mask_bias_tile(f32x16& p0, f32x16& p1, int dq, const float* tab) {
    const float NEG = -__builtin_inff();
#pragma unroll
    for (int r = 0; r < 16; ++r) { const int c = (r & 3) + 8 * (r >> 2); const int d0 = dq - c, d1 = d0 - 32;
        const float b0 = tab[d0 < 0 ? 0 : (d0 > 127 ? 127 : d0)], b1 = tab[d1 < 0 ? 0 : (d1 > 127 ? 127 : d1)];
        p0[r] = d0 < 0 ? NEG : p0[r] + b0; p1[r] = d1 < 0 ? NEG : p1[r] + b1;
        if ((r & 1) == 1) { asm volatile("" : "+v"(p0), "+v"(p1) :: "memory"); } }
}
__device__ __forceinline__ void partialSM(f32x16& p0, f32x16& p1, float& m_reg, float& mn, float& alpha) {
    float pmax = p0[0]; for (int r = 1; r < 16; ++r) pmax = fmaxf(pmax, p0[r]); for (int r = 0; r < 16; ++r) pmax = fmaxf(pmax, p1[r]);
    { auto rr = __builtin_amdgcn_permlane32_swap(__float_as_uint(pmax), __float_as_uint(pmax), false, false);
      pmax = fmaxf(__uint_as_float(rr[0]), __uint_as_float(rr[1])); }
    constexpr float C2 = 1.4426950408889634f * SCALE;
    if (__builtin_expect(__all((pmax - m_reg) * SCALE <= THR), 1)) { mn = m_reg; alpha = 1.f; }
    else { mn = fmaxf(m_reg, pmax); alpha = __builtin_amdgcn_exp2f((m_reg - mn) * C2); m_reg = mn; }
    const float mnL = -mn * C2;
    for (int r = 0; r < 16; ++r) p0[r] = fmaf(p0[r], C2, mnL); for (int r = 0; r < 16; ++r) p1[r] = fmaf(p1[r], C2, mnL);
    for (int r = 0; r < 16; ++r) p0[r] = __builtin_amdgcn_exp2f(p0[r]);
}
__device__ __forceinline__ void finishSM(f32x16& p0, f32x16& p1, float alpha, float& l_reg, bf16x8& pa0, bf16x8& pa1, bf16x8& pa2, bf16x8& pa3) {
    for (int r = 0; r < 16; ++r) p1[r] = __builtin_amdgcn_exp2f(p1[r]);
    float ps = 0; for (int r = 0; r < 16; ++r) ps += p0[r]; for (int r = 0; r < 16; ++r) ps += p1[r];
    { auto rr = __builtin_amdgcn_permlane32_swap(__float_as_uint(ps), __float_as_uint(ps), false, false);
      ps = __uint_as_float(rr[0]) + __uint_as_float(rr[1]); }
    l_reg = l_reg * alpha + ps;
#define DA_PK4(P, B_, OUT) do { unsigned a0 = cvtpk(P[B_+0], P[B_+1]), a1 = cvtpk(P[B_+2], P[B_+3]);                          \
        unsigned b0 = cvtpk(P[B_+4], P[B_+5]), b1 = cvtpk(P[B_+6], P[B_+7]);                                             \
        auto r0 = __builtin_amdgcn_permlane32_swap(a0, b0, false, false); auto r1 = __builtin_amdgcn_permlane32_swap(a1, b1, false, false); \
        u32x4 w = {r0[0], r1[0], r0[1], r1[1]}; OUT = *reinterpret_cast<bf16x8*>(&w); } while (0)
    DA_PK4(p0, 0, pa0); DA_PK4(p0, 8, pa1); DA_PK4(p1, 0, pa2); DA_PK4(p1, 8, pa3);
#undef DA_PK4
}
template <int KB>
__device__ __forceinline__ void qkt(f32x16& p0, f32x16& p1, const char* K_lds, int r32, int hi, const bf16x8* qr) {
    p0 = f32x16{}; p1 = f32x16{};
#pragma unroll
    for (int d0 = 0; d0 < 4; ++d0) { const char* a = K_lds + KB * SHM_K + DA_KSWZ(r32, (d0 * 16 + hi * 8) * 2);
        bf16x8 b0 = *reinterpret_cast<const bf16x8*>(a);
        bf16x8 b1 = *reinterpret_cast<const bf16x8*>(a + 32 * 128);
        p0 = __builtin_amdgcn_mfma_f32_32x32x16_bf16(b0, qr[d0], p0, 0, 0, 0);
        p1 = __builtin_amdgcn_mfma_f32_32x32x16_bf16(b1, qr[d0], p1, 0, 0, 0); }
}
template <int VB>
__device__ __forceinline__ void pv_tile(f32x16* o, int vb0, bf16x8 pa0, bf16x8 pa1, bf16x8 pa2, bf16x8 pa3) {
#define DA_TRRD(dst, off) asm volatile("ds_read_b64_tr_b16 %0, %1 offset:%2" : "=&v"(dst) : "v"(vb0), "i"(off) : "memory")
#define DA_PV_D0(d0) do { s16x4 l0, l1, l2, l3, h0, h1, h2, h3; constexpr int b_ = VB * SHM_V + v_rd_off(d0, 0, 0); \
        DA_TRRD(l0, b_); DA_TRRD(h0, b_ + 2048); DA_TRRD(l1, b_ + 4096); DA_TRRD(h1, b_ + 6144); DA_TRRD(l2, b_ + 8192); DA_TRRD(h2, b_ + 10240); DA_TRRD(l3, b_ + 12288); DA_TRRD(h3, b_ + 14336); \
        asm volatile("s_waitcnt lgkmcnt(0)" ::: "memory"); DA_SBAR();   \
        o[d0] = __builtin_amdgcn_mfma_f32_32x32x16_bf16(pa0, (bf16x8){l0[0], l0[1], l0[2], l0[3], h0[0], h0[1], h0[2], h0[3]}, o[d0], 0, 0, 0);   \
        o[d0] = __builtin_amdgcn_mfma_f32_32x32x16_bf16(pa1, (bf16x8){l1[0], l1[1], l1[2], l1[3], h1[0], h1[1], h1[2], h1[3]}, o[d0], 0, 0, 0);   \
        o[d0] = __builtin_amdgcn_mfma_f32_32x32x16_bf16(pa2, (bf16x8){l2[0], l2[1], l2[2], l2[3], h2[0], h2[1], h2[2], h2[3]}, o[d0], 0, 0, 0);   \
        o[d0] = __builtin_amdgcn_mfma_f32_32x32x16_bf16(pa3, (bf16x8){l3[0], l3[1], l3[2], l3[3], h3[0], h3[1], h3[2], h3[3]}, o[d0], 0, 0, 0); } while (0)
    DA_PV_D0(0); DA_PV_D0(1); DA_PV_D0(2); DA_PV_D0(3);
#undef DA_PV_D0
#undef DA_TRRD
}
constexpr int QP = 512, KP = 512, VP = 512, OP = 1024;
struct BlockRef { const bf16* Q; const bf16* K; const bf16* V; bf16* O; int P0; };
struct Seam { bf16x8 qr[4]; bf16x8 st_v0, st_v1, st_k; };
#define DA_VROW(p, k0, rr) ((p) + (size_t)((k0) + (rr)) * VP + sc)
#define DA_KROW(p, k0) ((p) + (size_t)((k0) + kr) * KP + kc)
#define DA_VMW() asm volatile("s_waitcnt vmcnt(0)" ::: "memory")
#define DA_VMWN(n) asm volatile("s_waitcnt vmcnt(%0)" :: "i"(n) : "memory")
#define DA_SLOAD(Kp, Vp, k0) do { S.st_v0 = load8(DA_VROW(Vp, k0, sr)); S.st_v1 = load8(DA_VROW(Vp, k0, 32 + sr)); S.st_k = load8(DA_KROW(Kp, k0)); } while (0)
#define DA_SWRITE_K(bf) do { *(bf16x8*)(K_lds + (bf) * SHM_K + kws) = S.st_k; } while (0)
#define DA_SWRITE_V(bf) do { *(bf16x8*)(V_lds + (bf) * SHM_V + vst0) = S.st_v0; *(bf16x8*)(V_lds + (bf) * SHM_V + vst1) = S.st_v1; } while (0)
#define DA_SWRITE(bf) do { DA_SWRITE_V(bf); DA_SWRITE_K(bf); } while (0)
__device__ __forceinline__ void prime(const BlockRef& cur, char* lds, Seam& S, const int tid) {
    const int wid = __builtin_amdgcn_readfirstlane(tid >> 6), lane = tid & 63, r32 = lane & 31, hi = lane >> 5;
    const int sr = tid >> 4, sc = (tid & 15) * 8, kr = tid >> 3, kc = (tid & 7) * 8, kws = DA_KSWZ(kr, kc * 2); char* K_lds = lds + 2 * SHM_V;
#pragma unroll
    for (int d0 = 0; d0 < 4; ++d0) S.qr[d0] = load8(cur.Q + (size_t)(wid * QBLK + r32) * QP + d0 * 16 + hi * 8);
    DA_SLOAD(cur.K, cur.V, 0); DA_VMW(); DA_SWRITE_K(0);
    __syncthreads();
}
__device__ __forceinline__ void block(const BlockRef& cur, const BlockRef& nxt, char* lds, Seam& S, const float* tab, const int tid) {
    const int wid = __builtin_amdgcn_readfirstlane(tid >> 6), lane = tid & 63, r32 = lane & 31, hi = lane >> 5;
    const int NT = (cur.P0 + QB - 1) / KVBLK + 1;
    const int qlo = cur.P0 + wid * QBLK, qm = qlo + r32 - 4 * hi;
    char* V_lds = lds; char* K_lds = lds + 2 * SHM_V;
    float* ws = (float*)(lds + 2 * SHM_V + 2 * SHM_K) + wid * 64; float* li_l = ws, * al_l = ws + 32;
    float m_reg = -1e30f, l_reg = 0; f32x16 o[4] = {};
    const int sr = tid >> 4, sc = (tid & 15) * 8, vst0 = v_st(sr, sc), vst1 = v_st(32 + sr, sc), kr = tid >> 3, kc = (tid & 7) * 8, kws = DA_KSWZ(kr, kc * 2);
    const int vb0 = (int)(uintptr_t)V_lds + v_rd_base(lane);
    const bf16* Kh = cur.K; const bf16* Vh = cur.V;
#define DA_RESC(a) do { if (__any((a) < 1.f)) { if (hi == 0) al_l[r32] = (a); asm volatile("s_waitcnt lgkmcnt(0)" ::: "memory");              \
                     for (int d_ = 0; d_ < 4; ++d_) for (int r = 0; r < 16; ++r) o[d_][r] *= al_l[crow(r, hi)]; } } while (0)
#define DA_KBASE(t) ((t) * KVBLK)
#define DA_MASKT(P0_, P1_, t) do { const int kb_ = DA_KBASE(t); if (kb_ + KVBLK - 1 + 113 > qlo) mask_bias_tile(P0_, P1_, qm - kb_, tab); } while (0)
    constexpr int NQL = 4;
#define DA_SEAM_K0() do { DA_VMWN(NQL); DA_SWRITE_K(0); DA_SBAR(); } while (0)
    f32x16 pA0, pA1, pB0, pB1; float mnA, mnB, alA, alB; bf16x8 pa0, pa1, pa2, pa3;
    DA_SWRITE_V(0); DA_SBAR();
    if (NT > 1) { DA_SLOAD(Kh, Vh, DA_KBASE(1)); }
    DA_SBAR(); qkt<0>(pA0, pA1, K_lds, r32, hi, S.qr);
    DA_MASKT(pA0, pA1, 0); partialSM(pA0, pA1, m_reg, mnA, alA);
    if (NT > 1) { DA_VMW(); DA_SWRITE(1); }
    __syncthreads();
#define DA_HALF_STEP(PX0, PX1, mnX, alX, PY0, PY1, alY, t, KB, VB, SB) do {                                                      \
        DA_SBAR(); qkt<KB>(PX0, PX1, K_lds, r32, hi, S.qr);                                             \
        finishSM(PY0, PY1, alY, l_reg, pa0, pa1, pa2, pa3); DA_SBAR();                                                           \
        if ((t) + 1 < NT) { DA_SLOAD(Kh, Vh, DA_KBASE((t) + 1)); DA_SBAR(); }                                               \
        pv_tile<VB>(o, vb0, pa0, pa1, pa2, pa3); DA_MASKT(PX0, PX1, (t)); partialSM(PX0, PX1, m_reg, mnX, alX);                                        \
        __syncthreads();                                                                                                      \
        if ((t) + 1 < NT) { DA_VMW(); DA_SWRITE(SB); }                                                                          \
        DA_RESC(alX); __syncthreads(); } while (0)
    for (int t = 1; t + 1 < NT; t += 2) {
        DA_HALF_STEP(pB0, pB1, mnB, alB, pA0, pA1, alA, t, 1, 0, 0);
        DA_HALF_STEP(pA0, pA1, mnA, alA, pB0, pB1, alB, t + 1, 0, 1, 1);
    }
    const bool even = (NT & 1) == 0;
    if (even) { DA_SBAR(); qkt<1>(pB0, pB1, K_lds, r32, hi, S.qr); DA_SBAR(); }
    DA_SLOAD(nxt.K, nxt.V, 0); DA_SBAR();
#pragma unroll
    for (int d0 = 0; d0 < 4; ++d0) S.qr[d0] = load8(nxt.Q + (size_t)(wid * QBLK + r32) * QP + d0 * 16 + hi * 8);
    DA_SBAR();
    finishSM(pA0, pA1, alA, l_reg, pa0, pa1, pa2, pa3); DA_SBAR();
    pv_tile<0>(o, vb0, pa0, pa1, pa2, pa3);
    if (even) { DA_MASKT(pB0, pB1, NT - 1); partialSM(pB0, pB1, m_reg, mnB, alB); __syncthreads(); DA_RESC(alB);
        finishSM(pB0, pB1, alB, l_reg, pa0, pa1, pa2, pa3); DA_SBAR(); pv_tile<1>(o, vb0, pa0, pa1, pa2, pa3); }
    DA_SBAR(); DA_SEAM_K0();
    if (hi == 0) li_l[r32] = l_reg; asm volatile("s_waitcnt lgkmcnt(0)" ::: "memory");
    float rli[16];
#pragma unroll
    for (int r = 0; r < 16; ++r) rli[r] = __builtin_amdgcn_rcpf(li_l[crow(r, hi)]);
    bf16* Ow = cur.O + (size_t)(wid * QBLK) * OP;
#pragma unroll
    for (int r = 0; r < 16; ++r) { const int orow = crow(r, hi);
#pragma unroll
        for (int d0 = 0; d0 < 4; ++d0) { const float v = o[d0][r] * rli[r];
            const float vn = __shfl_xor(v, 1);
            if ((r32 & 1) == 0) *(unsigned*)(Ow + (size_t)orow * OP + d0 * 32 + r32) = cvtpk(v, vn); } }
    __syncthreads();
#undef DA_RESC
#undef DA_KBASE
#undef DA_MASKT
#undef DA_SEAM_K0
#undef DA_HALF_STEP
}
#undef DA_VROW
#undef DA_KROW
#undef DA_VMW
#undef DA_VMWN
#undef DA_SLOAD
#undef DA_SWRITE_K
#undef DA_SWRITE_V
#undef DA_SWRITE
__device__ __forceinline__ BlockRef ref(const bf16* QKV, bf16* ODT, int bm, int qb) {
    const int b = bm >> 3, hm = bm & 7; BlockRef r; const size_t rowb = (size_t)b * 8192;
    r.Q = QKV + (rowb + (size_t)qb * QB) * QP + hm * 64; r.K = QKV + (size_t)16384 * 512 + rowb * KP + hm * 64; r.V = QKV + (size_t)2 * 16384 * 512 + rowb * VP + (hm >> 1) * 128;
    r.O = ODT + (rowb + (size_t)qb * QB) * OP + hm * 128; r.P0 = qb * QB; return r;
}
__device__ __forceinline__ void phase(char* lds, const bf16* QKV, bf16* ODT, const float* tab4, int vcu, const int tid) {
    const int bm = vcu >> 4, x = vcu & 15; const float* tab = tab4 + ((bm & 7) >> 1) * 128;
    const BlockRef b0 = ref(QKV, ODT, bm, x), b1 = ref(QKV, ODT, bm, 31 - x);
    Seam S;
    prime(b0, lds, S, tid);
    block(b0, b1, lds, S, tab, tid);
    block(b1, b1, lds, S, tab, tid);
}
}
constexpr int NWAVES = 8;
#ifndef MK_ONE_LAUNCH
#define MK_ONE_LAUNCH 1
#endif
constexpr int T = 16384, SEQ = 8192, D = 1024, INW = 6400, NL = 2, NEXP = 32, DFF = 1024;
constexpr int NR_MAX = 73728;
constexpr float NORM_EPS = 1e-6f;
constexpr float LOG2E = 1.4426950408889634f;
constexpr float QSCALE = 0.125f * LOG2E;
constexpr size_t MiB = 1u << 20;
constexpr size_t WS_CTL = 0, CTL_ZERO_BYTES = 65536;
constexpr size_t WS_MOD = 1 * MiB;
constexpr size_t WS_SUMM = 2 * MiB;
constexpr size_t WS_BLKCNT = 3 * MiB;
constexpr size_t WS_TILEMAP = 3 * MiB + 65536;
constexpr size_t WS_TOPW = 4 * MiB;
constexpr size_t WS_ERANK = 4 * MiB + 512 * 1024;
constexpr size_t WS_DEST = 5 * MiB;
constexpr size_t WS_ROWTOK = 5 * MiB + 512 * 1024;
constexpr size_t WS_WIN = 8 * MiB;
constexpr size_t WS_WBR = 34 * MiB;
constexpr size_t WS_WOUT = 40 * MiB;
constexpr size_t WS_W1 = 48 * MiB;
constexpr size_t WS_W2 = 304 * MiB;
constexpr size_t WS_H = 432 * MiB;
constexpr size_t WS_PROJ = 464 * MiB;
constexpr size_t WS_BR = 664 * MiB;
constexpr size_t WS_ODT = 712 * MiB;
constexpr size_t WS_MERGED = 744 * MiB;
constexpr size_t WS_XS = 776 * MiB;
constexpr size_t WS_ACT = 920 * MiB;
constexpr size_t WS_Y = 1064 * MiB;
constexpr size_t WS_END = 1208 * MiB;
constexpr int CW_BAR = 4096;
constexpr int CW_TILE = 8192;
constexpr int RING_OFF = 0, RING_BYTES = 131072;
constexpr int TAB_OFF = 110592;
constexpr int LDSCTL_OFF = RING_BYTES, MISC_OFF = LDSCTL_OFF + 320;
constexpr int TMAP_OFF = LDSCTL_OFF + 1024;
constexpr int LDS_BYTES = 147456;

#define GAS __attribute__((address_space(1)))
#define LAS __attribute__((address_space(3)))
typedef unsigned short bf16;
typedef unsigned v4u __attribute__((ext_vector_type(4)));
typedef unsigned v2u __attribute__((ext_vector_type(2)));
typedef float f32x4 __attribute__((ext_vector_type(4)));
typedef GAS unsigned gu32;
#define RLX_AGENT __ATOMIC_RELAXED, __HIP_MEMORY_SCOPE_AGENT
#define LDS_WAIT() asm volatile("s_waitcnt lgkmcnt(0)" ::: "memory")
#define VM_WAIT() asm volatile("s_waitcnt vmcnt(0)" ::: "memory")
__device__ __forceinline__ unsigned pk2(float lo, float hi) { typedef float f2_t_ __attribute__((ext_vector_type(2))); typedef __bf16 b2_t_ __attribute__((ext_vector_type(2))); f2_t_ v = {lo, hi}; b2_t_ b = __builtin_convertvector(v, b2_t_); return __builtin_bit_cast(unsigned, b); }
__device__ __forceinline__ unsigned f2bf(float f) { return pk2(f, 0.f) & 0xffffu; }
__device__ __forceinline__ float bflo(unsigned w) { return __uint_as_float(w << 16); }
__device__ __forceinline__ float bfhi(unsigned w) { return __uint_as_float(w & 0xffff0000u); }
__device__ __forceinline__ float bf1(bf16 h) { return __uint_as_float((unsigned)h << 16); }
#define XB_TMO      128
#define XB_XCNT(j)  (256  + 64 * (j))
#define XB_XSUB(j)  (1280 + 64 * (j))
#define XB_XGEN(j)  (2304 + 64 * (j))
#define XB_TOP      3328
#define XB_TOPGEN   3392
#define XCD_BAR_WORDS 3456
#define XB_SPIN_CAP (1u << 18)

__device__ __forceinline__ unsigned xb_ld(unsigned* p)              { return __hip_atomic_load(p, __ATOMIC_RELAXED, __HIP_MEMORY_SCOPE_AGENT); }
__device__ __forceinline__ unsigned xb_add(unsigned* p, unsigned v) { return __hip_atomic_fetch_add(p, v, __ATOMIC_RELAXED, __HIP_MEMORY_SCOPE_AGENT); }
__device__ __forceinline__ unsigned xb_xcc_id() { return (unsigned)__builtin_amdgcn_s_getreg((3 << 11) | 20) & 0xFu; }
#define XB_SPIN(cond, bar) do { unsigned _sp = 0; while (cond) { __builtin_amdgcn_s_sleep(1); \
    if ((++_sp & 255u) == 0u) { if (xb_ld(&(bar)[XB_TMO])) break; if (_sp > XB_SPIN_CAP) { atomicAdd(&(bar)[XB_TMO], 1u); break; } } } } while (0)

struct XcdBarrier {
    unsigned* bar; unsigned x;
    volatile LAS unsigned* st;
};

__device__ __forceinline__ XcdBarrier xcd_barrier_post(unsigned* bar, volatile LAS unsigned* st) {
    XcdBarrier b; b.bar = bar; b.x = xb_xcc_id(); b.st = st;
    if (threadIdx.x == 0) (void)xb_add(&bar[XB_XCNT(b.x)], 1u);
    return b;
}
__device__ __forceinline__ void xcd_barrier_complete(unsigned* bar, unsigned x, unsigned& nloc, unsigned& nx) {
    const unsigned G = gridDim.x * gridDim.y * gridDim.z;
    unsigned sum, cnt, mine, sp = 0u;
    for (;;) {
        sum = 0u; cnt = 0u; mine = 0u;
#pragma unroll
        for (unsigned j = 0; j < 16; ++j) { const unsigned c = xb_ld(&bar[XB_XCNT(j)]); sum += c; cnt += (c > 0u) ? 1u : 0u; mine = (j == x) ? c : mine; }
        if (sum == G) break;
        __builtin_amdgcn_s_sleep(1);
        if ((++sp & 255u) == 0u) { if (xb_ld(&bar[XB_TMO])) break; if (sp > XB_SPIN_CAP) { atomicAdd(&bar[XB_TMO], 1u); break; } }
    }
    nloc = mine > 0u ? mine : 1u; nx = cnt > 0u ? cnt : 1u;
}

__device__ __forceinline__ void xcd_barrier(const XcdBarrier& b) {
    asm volatile("s_waitcnt vmcnt(0)" ::: "memory");
    __syncthreads();
    if (threadIdx.x == 0) {
        unsigned* bar = b.bar;
        __builtin_amdgcn_s_waitcnt(0);
        unsigned nloc = b.st[0], nx = b.st[1];
        if (nloc == 0u) { xcd_barrier_complete(bar, b.x, nloc, nx); b.st[0] = nloc; b.st[1] = nx; }
        const unsigned old = xb_add(&bar[XB_XSUB(b.x)], 1u);
        const unsigned gen = old / nloc;
        if (old + 1u == (gen + 1u) * nloc) {
            __builtin_amdgcn_fence(__ATOMIC_RELEASE, "agent");
            asm volatile("s_waitcnt vmcnt(0)" ::: "memory");
            const unsigned og = xb_add(&bar[XB_TOP], 1u);
            const unsigned tg = og / nx;
            if (og + 1u == (tg + 1u) * nx) xb_add(&bar[XB_TOPGEN], 1u);
            else XB_SPIN(xb_ld(&bar[XB_TOPGEN]) == tg, bar);
            __builtin_amdgcn_fence(__ATOMIC_ACQUIRE, "agent");
            xb_add(&bar[XB_XGEN(b.x)], 1u);
            asm volatile("s_waitcnt vmcnt(0)" ::: "memory");
        } else {
            XB_SPIN(xb_ld(&bar[XB_XGEN(b.x)]) == gen, bar);
            __builtin_amdgcn_fence(__ATOMIC_ACQUIRE, "agent");
            asm volatile("s_waitcnt vmcnt(0)" ::: "memory");
        }
    }
    __syncthreads();
}
struct Frame {
    LAS unsigned char* lds;
    volatile LAS unsigned* MISC;
    gu32* ctl;
    int tid, lane, wave, vcu, G;
    float* out; unsigned char* ws;
};
__device__ __forceinline__ const float* inp(int i) { typedef __attribute__((address_space(4))) const unsigned long long* kap_t; kap_t ka = (kap_t)__builtin_amdgcn_kernarg_segment_ptr(); asm volatile("" : "+s"(ka)); return (const float*)(const GAS float*)ka[i]; }
enum { I_X = 0, I_C, I_WADA, I_BADA, I_NMIX, I_NFFN, I_WIN, I_CONVW, I_CONVB, I_LWA, I_LBA, I_LWX, I_LBX, I_LLAM, I_DQN, I_DKN, I_DLAM, I_DSUB, I_SQN, I_SKN, I_SINK, I_RELB, I_WBR, I_WOUT, I_WR, I_BR, I_W1, I_B1, I_W2, I_B2 };

__device__ __forceinline__ float wave_sum(float v) {
#pragma unroll
    for (int o = 1; o < 64; o <<= 1) v += __shfl_xor(v, o);
    return v;
}
struct TrItem { const float* src; bf16* dst; int N, K; };
__device__ __forceinline__ void p0_item_load(const TrItem& t, float (&v)[32], int lane) {
#pragma unroll
    for (int i = 0; i < 32; ++i) v[i] = __builtin_nontemporal_load(t.src + (size_t)(2 * i + (lane >> 5)) * t.N + (lane & 31));
}
__device__ __forceinline__ void p0_item_store(const TrItem& t, const float (&v)[32], LAS float* scr, int lane) {
#pragma unroll
    for (int i = 0; i < 32; ++i) scr[(2 * i + (lane >> 5)) * 33 + (lane & 31)] = v[i];
    LDS_WAIT(); asm volatile("" ::: "memory");
    const int c = lane & 7;
#pragma unroll
    for (int j = 0; j < 4; ++j) { const int n = (lane >> 3) + 8 * j; const LAS float* s = scr + (8 * c) * 33 + n;
        v4u o; o.x = pk2(s[0 * 33], s[1 * 33]); o.y = pk2(s[2 * 33], s[3 * 33]); o.z = pk2(s[4 * 33], s[5 * 33]); o.w = pk2(s[6 * 33], s[7 * 33]);
        __builtin_nontemporal_store(o, (GAS v4u*)(t.dst + (size_t)n * t.K + 8 * c)); }
    LDS_WAIT(); asm volatile("" ::: "memory");
}
constexpr int TI_IN = (1024 / 64) * (INW / 32), TI_BRN = (512 / 64) * (1024 / 32), TI_OUT = (1024 / 64) * (1024 / 32), TI_E1 = (1024 / 64) * (2048 / 32), TI_E2 = (1024 / 64) * (1024 / 32);
constexpr int TI_PER_LAYER = TI_IN + 3 * TI_BRN + TI_OUT + NEXP * TI_E1 + NEXP * TI_E2;
constexpr int TI_DENSE = TI_IN + 3 * TI_BRN + TI_OUT, TI_MOE = NEXP * TI_E1 + NEXP * TI_E2;
#ifndef CQ_X1
#define CQ_X1 32768
#endif
constexpr int CQ_W2L0 = NEXP * TI_E2;
constexpr int CQ_Q0 = TI_DENSE + NEXP * TI_E1 - CQ_X1;
constexpr int CQ_TOTAL = 2 * TI_PER_LAYER - CQ_Q0;
static_assert(CQ_X1 % 16 == 0 && CQ_X1 >= 0 && CQ_X1 <= NEXP * TI_E1, "conversion-queue head");
static_assert(TI_DENSE % 16 == 0 && TI_PER_LAYER % 16 == 0 && CQ_W2L0 % 16 == 0, "conversion-queue batches");
constexpr int CW_CQ = 2048;
__device__ __forceinline__ TrItem p0_item_decode(Frame& F, int it) {
    const int l = it / TI_PER_LAYER; int r = it - l * TI_PER_LAYER; const float* W; bf16* WT; int K, N;
    if (r < TI_IN) { W = inp(I_WIN) + (size_t)l * 1024 * INW; WT = (bf16*)(F.ws + WS_WIN) + (size_t)l * INW * 1024; K = 1024; N = INW; }
    else if ((r -= TI_IN) < 3 * TI_BRN) { const int n = r / TI_BRN; r -= n * TI_BRN; W = inp(I_WBR) + (size_t)(l * 3 + n) * 512 * 1024; WT = (bf16*)(F.ws + WS_WBR) + (size_t)(l * 3 + n) * 1024 * 512; K = 512; N = 1024; }
    else if ((r -= 3 * TI_BRN) < TI_OUT) { W = inp(I_WOUT) + (size_t)l * 1024 * 1024; WT = (bf16*)(F.ws + WS_WOUT) + (size_t)l * 1024 * 1024; K = 1024; N = 1024; }
    else if ((r -= TI_OUT) < NEXP * TI_E1) { const int e = r / TI_E1; r -= e * TI_E1; W = inp(I_W1) + (size_t)(l * NEXP + e) * 1024 * 2048; WT = (bf16*)(F.ws + WS_W1) + (size_t)(l * NEXP + e) * 2048 * 1024; K = 1024; N = 2048; }
    else { r -= NEXP * TI_E1; const int e = r / TI_E2; r -= e * TI_E2; W = inp(I_W2) + (size_t)(l * NEXP + e) * 1024 * 1024; WT = (bf16*)(F.ws + WS_W2) + (size_t)(l * NEXP + e) * 1024 * 1024; K = 1024; N = 1024; }
    const int nblk = N / 32, kb = r / nblk, nb = r - kb * nblk;
    TrItem t; t.src = W + (size_t)(64 * kb) * N + 32 * nb; t.dst = WT + (size_t)(32 * nb) * K + 64 * kb; t.N = N; t.K = K; return t;
}
__device__ __forceinline__ TrItem cq_decode(Frame& F, int q) { return p0_item_decode(F, CQ_Q0 + q); }
__device__ __forceinline__ void cq_run(Frame& F, int max_batches, int until = CQ_TOTAL) {
    LAS float* scr = (LAS float*)(F.lds + RING_OFF + F.wave * 16384);
    volatile LAS int* slot = (volatile LAS int*)(F.lds + LDSCTL_OFF + 64);
    for (int bt = 0; bt < max_batches; ++bt) {
        if (F.tid == 0) { int v = -1;
            if (until >= CQ_TOTAL || __hip_atomic_load((unsigned*)(F.ctl + CW_CQ), __ATOMIC_RELAXED, __HIP_MEMORY_SCOPE_AGENT) < (unsigned)until) v = (int)__hip_atomic_fetch_add((unsigned*)(F.ctl + CW_CQ), 16u, __ATOMIC_RELAXED, __HIP_MEMORY_SCOPE_AGENT);
            *slot = v; }
        __syncthreads();
        const int base = __builtin_amdgcn_readfirstlane(*slot);
        __syncthreads();
        if (base < 0 || base >= CQ_TOTAL) break;
        const int q0 = base + F.wave, q1 = (base + 8 < CQ_TOTAL) ? q0 + 8 : q0;
        const TrItem t0 = cq_decode(F, q0), t1 = cq_decode(F, q1);
        float v0[32], v1[32]; p0_item_load(t0, v0, F.lane); p0_item_load(t1, v1, F.lane);
        p0_item_store(t0, v0, scr, F.lane); p0_item_store(t1, v1, scr, F.lane);
    }
    __syncthreads();
}
__device__ __forceinline__ bool cq_batch8(Frame& F) {
    LAS float* scr = (LAS float*)(F.lds + RING_OFF + F.wave * 16384);
    volatile LAS int* slot = (volatile LAS int*)(F.lds + LDSCTL_OFF + 64);
    if (F.tid == 0) *slot = (int)__hip_atomic_fetch_add((unsigned*)(F.ctl + CW_CQ), 8u, __ATOMIC_RELAXED, __HIP_MEMORY_SCOPE_AGENT);
    __syncthreads();
    const int base = __builtin_amdgcn_readfirstlane(*slot);
    __syncthreads();
    if (base >= CQ_TOTAL) return false;
    const TrItem t0 = cq_decode(F, base + F.wave);
    float v0[32]; p0_item_load(t0, v0, F.lane); p0_item_store(t0, v0, scr, F.lane);
    return true;
}
__device__ __forceinline__ void xcd_barrier_host(Frame& F, const XcdBarrier& b) {
    asm volatile("s_waitcnt vmcnt(0)" ::: "memory");
    __syncthreads();
    volatile LAS unsigned* hw = (volatile LAS unsigned*)(F.lds + LDSCTL_OFF + 68);
    unsigned gen = 0u, tg = 0u; bool leader = false, last = false;
    if (threadIdx.x == 0) {
        unsigned* bar = b.bar;
        __builtin_amdgcn_s_waitcnt(0);
        unsigned nloc = b.st[0], nx = b.st[1];
        if (nloc == 0u) { xcd_barrier_complete(bar, b.x, nloc, nx); b.st[0] = nloc; b.st[1] = nx; }
        const unsigned old = xb_add(&bar[XB_XSUB(b.x)], 1u);
        gen = old / nloc; leader = (old + 1u == (gen + 1u) * nloc);
        if (leader) {
            __builtin_amdgcn_fence(__ATOMIC_RELEASE, "agent");
            asm volatile("s_waitcnt vmcnt(0)" ::: "memory");
            const unsigned og = xb_add(&bar[XB_TOP], 1u);
            tg = og / nx; last = (og + 1u == (tg + 1u) * nx);
            if (last) xb_add(&bar[XB_TOPGEN], 1u);
        }
        hw[0] = leader ? 1u : 0u;
    }
    __syncthreads();
    if (hw[0] == 0u) {
        for (;;) {
            if (hw[1] != 0u) break;
            if (!cq_batch8(F)) { if (threadIdx.x == 0) hw[1] = 1u; break; }
            asm volatile("s_waitcnt vmcnt(0)" ::: "memory");
            if (threadIdx.x == 0) hw[2] = (xb_ld(&b.bar[XB_XGEN(b.x)]) == gen) ? 0u : 1u;
            __syncthreads();
            const unsigned rel = hw[2];
            __syncthreads();
            if (rel != 0u) break;
        }
    }
    if (threadIdx.x == 0) {
        unsigned* bar = b.bar;
        if (leader) {
            if (!last) XB_SPIN(xb_ld(&bar[XB_TOPGEN]) == tg, bar);
            __builtin_amdgcn_fence(__ATOMIC_ACQUIRE, "agent");
            xb_add(&bar[XB_XGEN(b.x)], 1u);
            asm volatile("s_waitcnt vmcnt(0)" ::: "memory");
        } else {
            XB_SPIN(xb_ld(&bar[XB_XGEN(b.x)]) == gen, bar);
            __builtin_amdgcn_fence(__ATOMIC_ACQUIRE, "agent");
            asm volatile("s_waitcnt vmcnt(0)" ::: "memory");
        }
    }
    __syncthreads();
}
__device__ __forceinline__ void p0_prologue(Frame& F) {
    LAS float* scr = (LAS float*)(F.lds + RING_OFF + F.wave * 16384);
    const int gw = F.vcu * NWAVES + F.wave, NGW = F.G * NWAVES;
    {   constexpr int NIT = CQ_Q0;
        float va[32], vb[32]; int it = gw;
        TrItem ta = p0_item_decode(F, it < NIT ? it : NIT - 1), tb = ta;
        p0_item_load(ta, va, F.lane);
        while (it < NIT) {
            const int i1 = it + NGW; tb = p0_item_decode(F, i1 < NIT ? i1 : NIT - 1); p0_item_load(tb, vb, F.lane);
            p0_item_store(ta, va, scr, F.lane);
            if (i1 >= NIT) break;
            const int i2 = i1 + NGW; ta = p0_item_decode(F, i2 < NIT ? i2 : NIT - 1); p0_item_load(ta, va, F.lane);
            p0_item_store(tb, vb, scr, F.lane);
            it = i2;
        }
    }
    __syncthreads();
    LAS float* red = (LAS float*)(F.lds + RING_OFF);
    LAS float* sil = red + 1024;
    for (int i = F.tid; i < 2048; i += NWAVES * 64) { const float c = inp(I_C)[i]; sil[i] = c / (1.0f + __expf(-c)); }
    __syncthreads();
    const int ks = F.tid >> 5, cl = F.tid & 31;
    for (int it = F.vcu; it < NL * 192; it += F.G) {
        const int l = it / 192, cg = it - l * 192; const float* W = inp(I_WADA) + (size_t)l * 1024 * 6144 + cg * 32 + cl + (size_t)(ks * 64) * 6144;
        float wv[64];
#pragma unroll
        for (int k = 0; k < 64; ++k) wv[k] = __builtin_nontemporal_load(W + (size_t)k * 6144);
        float a0 = 0.f, a1 = 0.f;
#pragma unroll
        for (int k = 0; k < 64; k += 4) { const f32x4 s0 = *(const LAS f32x4*)(sil + ks * 64 + k), s1 = *(const LAS f32x4*)(sil + 1024 + ks * 64 + k);
            a0 += s0.x * wv[k] + s0.y * wv[k + 1] + s0.z * wv[k + 2] + s0.w * wv[k + 3]; a1 += s1.x * wv[k] + s1.y * wv[k + 1] + s1.z * wv[k + 2] + s1.w * wv[k + 3]; }
        red[(ks * 2 + 0) * 32 + cl] = a0; red[(ks * 2 + 1) * 32 + cl] = a1;
        __syncthreads();
        if (F.tid < 64) { const int b = F.tid >> 5; float s = inp(I_BADA)[l * 6144 + cg * 32 + cl];
#pragma unroll
            for (int q = 0; q < 16; ++q) s += red[(q * 2 + b) * 32 + cl];
            ((float*)(F.ws + WS_MOD))[(size_t)(l * 2 + b) * 6144 + cg * 32 + cl] = s; }
        __syncthreads();
    }
}
__device__ __forceinline__ const float* modv(Frame& F, int l, int b, int which) { return (const float*)(F.ws + WS_MOD) + (size_t)(l * 2 + b) * 6144 + which * 1024; }

__device__ __forceinline__ void p_norm_in(Frame& F, int l, const float* x) {
    const int gw = F.vcu * NWAVES + F.wave;
    const int r0 = gw * 8, b = r0 >> 13;
    const float* nm = inp(I_NMIX) + l * 1024; const float* sc = modv(F, l, b, 1); const float* sh = modv(F, l, b, 0);
    f32x4 g1[4], g2[4];
#pragma unroll
    for (int j = 0; j < 4; ++j) { const int c = 4 * F.lane + 256 * j; const f32x4 n4 = *(const f32x4*)(nm + c), s4 = *(const f32x4*)(sc + c); g1[j] = n4 * (s4 + 1.0f); g2[j] = *(const f32x4*)(sh + c); }
    for (int rq = r0; rq < r0 + 8; rq += 4) {
        f32x4 v[4][4];
#pragma unroll
        for (int i = 0; i < 4; ++i) { const f32x4* xr = (const f32x4*)(x + (size_t)(rq + i) * D) + F.lane;
#pragma unroll
            for (int j = 0; j < 4; ++j) v[i][j] = __builtin_nontemporal_load(xr + 64 * j); }
#pragma unroll
        for (int i = 0; i < 4; ++i) { float s = 0.f;
#pragma unroll
            for (int j = 0; j < 4; ++j) s += (v[i][j].x * v[i][j].x + v[i][j].y * v[i][j].y) + (v[i][j].z * v[i][j].z + v[i][j].w * v[i][j].w);
            const float rstd = 1.0f / sqrtf(wave_sum(s) * (1.0f / D) + NORM_EPS);
            unsigned long long* o8 = (unsigned long long*)((bf16*)(F.ws + WS_H) + (size_t)(rq + i) * D) + F.lane;
#pragma unroll
            for (int j = 0; j < 4; ++j) { const f32x4 o = v[i][j] * rstd * g1[j] + g2[j]; o8[64 * j] = (unsigned long long)pk2(o.x, o.y) | ((unsigned long long)pk2(o.z, o.w) << 32); } }
    }
}
__device__ __forceinline__ void qknorm_seg(const bf16* p, bf16* dst, const float* gain, float scale, int lane, bool active) {
    v4u w = active ? *(const v4u*)p : (v4u){0u, 0u, 0u, 0u};
    float x[8] = {bflo(w.x), bfhi(w.x), bflo(w.y), bfhi(w.y), bflo(w.z), bfhi(w.z), bflo(w.w), bfhi(w.w)};
    float s = 0.f;
#pragma unroll
    for (int i = 0; i < 8; ++i) s += x[i] * x[i];
    s += __shfl_xor(s, 1); s += __shfl_xor(s, 2); s += __shfl_xor(s, 4);
    const float r = scale / sqrtf(s * (1.0f / 64.0f) + NORM_EPS);
    const int g0 = (lane & 7) * 8;
    const f32x4 ga = *(const f32x4*)(gain + g0), gb = *(const f32x4*)(gain + g0 + 4);
    v4u o; o.x = pk2(x[0] * r * ga.x, x[1] * r * ga.y); o.y = pk2(x[2] * r * ga.z, x[3] * r * ga.w); o.z = pk2(x[4] * r * gb.x, x[5] * r * gb.y); o.w = pk2(x[6] * r * gb.z, x[7] * r * gb.w);
    if (active) *(v4u*)dst = o;
}
__device__ __forceinline__ void p_qknorm(Frame& F, int l) {
    const int gw = F.vcu * NWAVES + F.wave, NGW = F.G * NWAVES;
    bf16* PROJ = (bf16*)(F.ws + WS_PROJ); bf16* QB = (bf16*)(F.ws + WS_XS);
    const float* gq = inp(I_DQN) + l * 64; const float* gk = inp(I_DKN) + l * 64; const float* sq = inp(I_SQN) + l * 64; const float* sk = inp(I_SKN) + l * 64;
    for (int r = gw; r < T; r += NGW) {
        bf16* row = PROJ + (size_t)r * INW + F.lane * 8;
        qknorm_seg(row + 1024, QB + (size_t)r * 512 + F.lane * 8, gq, QSCALE, F.lane, true);
        qknorm_seg(row + 1536, QB + (size_t)T * 512 + (size_t)r * 512 + F.lane * 8, gk, 1.0f, F.lane, true);
        qknorm_seg(row + 2560, row + 2560, sq, QSCALE, F.lane, true);
        qknorm_seg(row + 3072, row + 3072, sk, 1.0f, F.lane, F.lane < 16);
    }
}
constexpr int LRU_LC = 64, LRU_NCH = SEQ / LRU_LC;
struct LruW { float wa[64], wx[64]; float ba, bx, sp8, cw0, cw1, cw2, cw3, cb; };
template <int PASS> __device__ __forceinline__ void lru_unit(Frame& F, const LruW& W, int b, int chunk) {
    const int ch = F.tid; const bf16* PROJ = (const bf16*)(F.ws + WS_PROJ);
    LAS float* xcw = (LAS float*)(F.lds + RING_OFF) + F.wave * 1024;
    float* SA = (float*)(F.ws + WS_SUMM); float* SB = SA + 2 * LRU_NCH * 512;
    const int t0 = chunk * LRU_LC; const size_t rowb = (size_t)b * SEQ;
    float hst = 0.f, aprod = 1.f;
    if (PASS == 2) {
        const float* a = SA + (size_t)(b * LRU_NCH) * 512 + ch; const float* bb = SB + (size_t)(b * LRU_NCH) * 512 + ch;
        for (int c = 0; c < chunk; ++c) hst = a[(size_t)c * 512] * hst + bb[(size_t)c * 512];
    }
    float xm3 = 0.f, xm2 = 0.f, xm1 = 0.f;
    if (t0 > 0) { const bf16* p = PROJ + (rowb + t0 - 3) * INW + ch; xm3 = bf1(p[0]); xm2 = bf1(p[INW]); xm1 = bf1(p[2 * INW]); }
    for (int sub = 0; sub < LRU_LC / 16; ++sub) {
        const int ts = t0 + sub * 16;
        float xr[16], xc[16];
#pragma unroll
        for (int i = 0; i < 16; ++i) xr[i] = bf1(PROJ[(rowb + ts + i) * INW + ch]);
#pragma unroll
        for (int i = 0; i < 16; ++i) { xc[i] = W.cb + W.cw0 * xm3 + W.cw1 * xm2 + W.cw2 * xm1 + W.cw3 * xr[i]; xm3 = xm2; xm2 = xm1; xm1 = xr[i]; xcw[i * 64 + F.lane] = xc[i]; }
        float gr[16];
        if (PASS == 2) {
#pragma unroll
            for (int i = 0; i < 16; ++i) gr[i] = bf1(PROJ[(rowb + ts + i) * INW + 512 + ch]);
        }
        LDS_WAIT(); asm volatile("" ::: "memory");
#pragma unroll
        for (int i = 0; i < 16; ++i) {
            float ga = W.ba, gx = W.bx;
#pragma unroll
            for (int q = 0; q < 16; ++q) { const f32x4 v = *(const LAS f32x4*)(xcw + i * 64 + 4 * q);
                ga += v.x * W.wa[4 * q] + v.y * W.wa[4 * q + 1] + v.z * W.wa[4 * q + 2] + v.w * W.wa[4 * q + 3];
                gx += v.x * W.wx[4 * q] + v.y * W.wx[4 * q + 1] + v.z * W.wx[4 * q + 2] + v.w * W.wx[4 * q + 3]; }
            const float rg = 1.0f / (1.0f + __expf(-ga)), ig = 1.0f / (1.0f + __expf(-gx));
            const float la = -W.sp8 * rg; const float a = __expf(la); const float mult = sqrtf(-expm1f(2.0f * la));
            const float bv = xc[i] * ig * mult;
            hst = a * hst + bv;
            if (PASS == 1) aprod *= a;
            if (PASS == 2) { const float g = gr[i]; const float u = 0.7978845608028654f * (g + 0.044715f * g * g * g); const float th = 1.0f - 2.0f / (1.0f + __expf(2.0f * u));
                ((bf16*)(F.ws + WS_BR))[(rowb + ts + i) * 512 + ch] = (bf16)f2bf(hst * 0.5f * g * (1.0f + th)); }
        }
        LDS_WAIT(); asm volatile("" ::: "memory");
    }
    if (PASS == 1) { SA[(size_t)(b * LRU_NCH + chunk) * 512 + ch] = aprod; SB[(size_t)(b * LRU_NCH + chunk) * 512 + ch] = hst; }
}
__device__ __forceinline__ void lru_load_w(Frame& F, int l, LruW& W) {
    const int ch = F.tid, h = F.wave;
    const float* WA = inp(I_LWA) + (size_t)(l * 8 + h) * 4096 + F.lane; const float* WX = inp(I_LWX) + (size_t)(l * 8 + h) * 4096 + F.lane;
#pragma unroll
    for (int i = 0; i < 64; ++i) { W.wa[i] = WA[i * 64]; W.wx[i] = WX[i * 64]; }
    W.ba = inp(I_LBA)[l * 512 + ch]; W.bx = inp(I_LBX)[l * 512 + ch];
    const float lam = inp(I_LLAM)[l * 512 + ch]; W.sp8 = 8.0f * log1pf(__expf(-lam));
    const float* cw = inp(I_CONVW) + (size_t)l * 4 * 512 + ch; W.cw0 = cw[0]; W.cw1 = cw[512]; W.cw2 = cw[1024]; W.cw3 = cw[1536]; W.cb = inp(I_CONVB)[l * 512 + ch];
}
__device__ __forceinline__ int t5_bucket(int d) {
    if (d < 16) return d;
    const float lr = logf((float)d / 16.0f) / logf(8.0f);
    const int v = 16 + (int)(lr * 16.0f);
    return v < 31 ? v : 31;
}
__device__ __forceinline__ void build_tabs(Frame& F) {
    LAS float* tab = (LAS float*)(F.lds + TAB_OFF);
    const float* rb = inp(I_RELB);
    for (int i = F.tid; i < 12 * 128; i += NWAVES * 64) { const int hd = i >> 7, d = i & 127; const int bk = t5_bucket(d);
        float v = rb[bk * 12 + hd]; if (hd < 4) v -= rb[31 * 12 + hd];
        tab[i] = v * LOG2E;
        if (hd >= 4) tab[12 * 128 + (hd - 4) * 192 + 32 + d] = v * LOG2E; }
    for (int i = F.tid; i < 8 * 64; i += NWAVES * 64) { const int hd = i >> 6, g = i & 63; tab[12 * 128 + hd * 192 + (g < 32 ? g : 128 + g)] = -INFINITY; }
    __syncthreads();
}
constexpr int SWA_ROWB = 144;
__device__ __forceinline__ void swa_unit(Frame& F, int l, int b, int kvh, int qblk) {
    const bf16* PROJ = (const bf16*)(F.ws + WS_PROJ);
    LAS unsigned char* Kl = F.lds + RING_OFF; LAS unsigned char* Vl = Kl + 256 * SWA_ROWB;
    const LAS float* tab = (const LAS float*)(F.lds + TAB_OFF) + 4 * 128;
    const size_t rowb = (size_t)b * SEQ; const int tb = qblk * 128;
    for (int i = F.tid; i < 2 * 256 * 8; i += NWAVES * 64) {
        const int tsr = i >> 11, rem = i & 2047, r = rem >> 3, c = rem & 7; const int tpos = tb - 128 + r;
        v4u v = (v4u){0u, 0u, 0u, 0u};
        if (tpos >= 0) v = *(const v4u*)(PROJ + (rowb + tpos) * INW + (tsr ? 3200 : 3072) + kvh * 64 + c * 8);
        *(LAS v4u*)((tsr ? Vl : Kl) + r * SWA_ROWB + c * 16) = v;
    }
    __syncthreads();
    const int g = F.tid >> 7, r = F.tid & 127; const int head = kvh * 4 + g; const int tq = tb + r;
    float q[64];
    { const bf16* qp = PROJ + (rowb + tq) * INW + 2560 + head * 64;
#pragma unroll
      for (int c = 0; c < 8; ++c) { const v4u w = *(const v4u*)(qp + c * 8); q[8 * c] = bflo(w.x); q[8 * c + 1] = bfhi(w.x); q[8 * c + 2] = bflo(w.y); q[8 * c + 3] = bfhi(w.y); q[8 * c + 4] = bflo(w.z); q[8 * c + 5] = bfhi(w.z); q[8 * c + 6] = bflo(w.w); q[8 * c + 7] = bfhi(w.w); } }
    const float sink2 = inp(I_SINK)[l * 8 + head] * LOG2E;
    float mx = sink2, lsum = 1.0f; float o[64];
#pragma unroll
    for (int d = 0; d < 64; ++d) o[d] = 0.f;
    const LAS float* tb_h = tab + head * 128;
    for (int dist = 127; dist >= 0; --dist) {
        if (tq - dist < 0) continue;
        const int br = 128 + r - dist;
        const LAS unsigned char* kr = Kl + br * SWA_ROWB; float s = 0.f;
#pragma unroll
        for (int c = 0; c < 8; ++c) { const v4u w = *(const LAS v4u*)(kr + c * 16);
            s += q[8 * c] * bflo(w.x) + q[8 * c + 1] * bfhi(w.x) + q[8 * c + 2] * bflo(w.y) + q[8 * c + 3] * bfhi(w.y) + q[8 * c + 4] * bflo(w.z) + q[8 * c + 5] * bfhi(w.z) + q[8 * c + 6] * bflo(w.w) + q[8 * c + 7] * bfhi(w.w); }
        s += tb_h[dist];
        const float mn = fmaxf(mx, s); const float f = __builtin_amdgcn_exp2f(mx - mn), p = __builtin_amdgcn_exp2f(s - mn);
        lsum = lsum * f + p; mx = mn;
        const LAS unsigned char* vr = Vl + br * SWA_ROWB;
#pragma unroll
        for (int c = 0; c < 8; ++c) { const v4u w = *(const LAS v4u*)(vr + c * 16);
            o[8 * c] = o[8 * c] * f + p * bflo(w.x); o[8 * c + 1] = o[8 * c + 1] * f + p * bfhi(w.x); o[8 * c + 2] = o[8 * c + 2] * f + p * bflo(w.y); o[8 * c + 3] = o[8 * c + 3] * f + p * bfhi(w.y);
            o[8 * c + 4] = o[8 * c + 4] * f + p * bflo(w.z); o[8 * c + 5] = o[8 * c + 5] * f + p * bfhi(w.z); o[8 * c + 6] = o[8 * c + 6] * f + p * bflo(w.w); o[8 * c + 7] = o[8 * c + 7] * f + p * bfhi(w.w); }
    }
    const float inv = 1.0f / lsum;
    bf16* op = (bf16*)(F.ws + WS_BR) + (size_t)2 * T * 512 + (rowb + tq) * 512 + head * 64;
#pragma unroll
    for (int c = 0; c < 8; ++c) { v4u w; w.x = pk2(o[8 * c] * inv, o[8 * c + 1] * inv); w.y = pk2(o[8 * c + 2] * inv, o[8 * c + 3] * inv); w.z = pk2(o[8 * c + 4] * inv, o[8 * c + 5] * inv); w.w = pk2(o[8 * c + 6] * inv, o[8 * c + 7] * inv); *(v4u*)(op + c * 8) = w; }
    __syncthreads();
}
__device__ __forceinline__ void p_diffpost(Frame& F, int l) {
    const int gw = F.vcu * NWAVES + F.wave, NGW = F.G * NWAVES;
    const float* lv = inp(I_DLAM) + l * 256;
    const float s1 = wave_sum(lv[F.lane] * lv[64 + F.lane]), s2 = wave_sum(lv[128 + F.lane] * lv[192 + F.lane]);
    const float lam_init = 0.8f - 0.6f * expf(-0.3f * (float)l);
    const float lam = expf(s1) - expf(s2) + lam_init;
    const int h = F.lane >> 4, e0 = (F.lane & 15) * 8;
    const float* sg = inp(I_DSUB) + l * 128 + e0; const f32x4 ga = *(const f32x4*)sg, gb = *(const f32x4*)(sg + 4);
    const float post = 1.0f - lam_init;
    const bf16* ODT = (const bf16*)(F.ws + WS_ODT); bf16* BR1 = (bf16*)(F.ws + WS_BR) + (size_t)T * 512;
    for (int rb = gw; rb < T; rb += 8 * NGW) {
        v4u w0[8], w1[8];
#pragma unroll
        for (int i = 0; i < 8; ++i) { const int r = rb + i * NGW, rc = r < T ? r : rb; w0[i] = __builtin_nontemporal_load((const v4u*)(ODT + (size_t)rc * 1024 + h * 256 + e0)); w1[i] = __builtin_nontemporal_load((const v4u*)(ODT + (size_t)rc * 1024 + h * 256 + 128 + e0)); }
#pragma unroll
        for (int i = 0; i < 8; ++i) { const int r = rb + i * NGW;
            float x[8] = {bflo(w0[i].x) - lam * bflo(w1[i].x), bfhi(w0[i].x) - lam * bfhi(w1[i].x), bflo(w0[i].y) - lam * bflo(w1[i].y), bfhi(w0[i].y) - lam * bfhi(w1[i].y),
                          bflo(w0[i].z) - lam * bflo(w1[i].z), bfhi(w0[i].z) - lam * bfhi(w1[i].z), bflo(w0[i].w) - lam * bflo(w1[i].w), bfhi(w0[i].w) - lam * bfhi(w1[i].w)};
            float s = 0.f;
#pragma unroll
            for (int k = 0; k < 8; ++k) s += x[k] * x[k];
            s += __shfl_xor(s, 1); s += __shfl_xor(s, 2); s += __shfl_xor(s, 4); s += __shfl_xor(s, 8);
            const float rs = post / sqrtf(s * (1.0f / 128.0f) + NORM_EPS);
            v4u o; o.x = pk2(x[0] * rs * ga.x, x[1] * rs * ga.y); o.y = pk2(x[2] * rs * ga.z, x[3] * rs * ga.w); o.z = pk2(x[4] * rs * gb.x, x[5] * rs * gb.y); o.w = pk2(x[6] * rs * gb.z, x[7] * rs * gb.w);
            if (r < T) *(v4u*)(BR1 + (size_t)r * 512 + h * 128 + e0) = o; }
    }
}
typedef short mbf16x8 __attribute__((ext_vector_type(8)));
typedef float mf32x16 __attribute__((ext_vector_type(16)));
__device__ __forceinline__ int crow16(int r, int hi) { return (r & 3) + 8 * (r >> 2) + 4 * hi; }
__device__ __forceinline__ unsigned cvtpk(float lo, float hi) { typedef float f2_t __attribute__((ext_vector_type(2))); typedef __bf16 b2_t __attribute__((ext_vector_type(2))); f2_t v = {lo, hi}; b2_t b = __builtin_convertvector(v, b2_t); return __builtin_bit_cast(unsigned, b); }
#define MFMA32(a, b, c) __builtin_amdgcn_mfma_f32_32x32x16_bf16(a, b, c, 0, 0, 0)
constexpr int SWK_ROWB = 144, SWV_ROWB = 528;
__device__ __forceinline__ void swa_unit_mfma(Frame& F, int l, int b, int kvh, int qblk) {
    const bf16* PROJ = (const bf16*)(F.ws + WS_PROJ);
    LAS unsigned char* Kl = F.lds + RING_OFF; LAS unsigned char* Vt = Kl + 256 * SWK_ROWB;
    const size_t rowb = (size_t)b * SEQ; const int tb = qblk * 128;
    mbf16x8 qall[2][4];
    { const int g_ = F.wave >> 1, qh_ = F.wave & 1, head_ = kvh * 4 + g_, r32_ = F.lane & 31, hi_ = F.lane >> 5;
#pragma unroll
      for (int sb = 0; sb < 2; ++sb) { const bf16* qp = PROJ + (rowb + tb + 64 * qh_ + 32 * sb + r32_) * INW + 2560 + head_ * 64 + 8 * hi_;
#pragma unroll
          for (int ks = 0; ks < 4; ++ks) qall[sb][ks] = *(const mbf16x8*)(qp + 16 * ks); } }
#pragma unroll
    for (int it = 0; it < 4; ++it) { const int i = F.tid + 512 * it, r = i & 255, c = i >> 8; const int tpos = tb - 128 + r;
        v4u kv = (v4u){0u, 0u, 0u, 0u}, vv = kv;
        if (tpos >= 0) { const bf16* p = PROJ + (rowb + tpos) * INW + kvh * 64 + c * 8; kv = *(const v4u*)(p + 3072); vv = *(const v4u*)(p + 3200); }
        *(LAS v4u*)(Kl + r * SWK_ROWB + c * 16) = kv;
        LAS unsigned short* vt = (LAS unsigned short*)(Vt + (8 * c) * SWV_ROWB + 2 * r);
        vt[0 * (SWV_ROWB / 2)] = (unsigned short)(vv.x & 0xffffu); vt[1 * (SWV_ROWB / 2)] = (unsigned short)(vv.x >> 16);
        vt[2 * (SWV_ROWB / 2)] = (unsigned short)(vv.y & 0xffffu); vt[3 * (SWV_ROWB / 2)] = (unsigned short)(vv.y >> 16);
        vt[4 * (SWV_ROWB / 2)] = (unsigned short)(vv.z & 0xffffu); vt[5 * (SWV_ROWB / 2)] = (unsigned short)(vv.z >> 16);
        vt[6 * (SWV_ROWB / 2)] = (unsigned short)(vv.w & 0xffffu); vt[7 * (SWV_ROWB / 2)] = (unsigned short)(vv.w >> 16); }
    __syncthreads();
    const int g = F.wave >> 1, qh = F.wave & 1, head = kvh * 4 + g, r32 = F.lane & 31, hi = F.lane >> 5;
    const LAS float* tabh = (const LAS float*)(F.lds + TAB_OFF) + (4 + head) * 128;
    const float sink2 = inp(I_SINK)[l * 8 + head] * LOG2E;
    bf16* OUT = (bf16*)(F.ws + WS_BR) + (size_t)2 * T * 512;
#pragma unroll 1
    for (int sb = 0; sb < 2; ++sb) {
        const int r0 = 64 * qh + 32 * sb, kb0 = r0 >> 5;
        mbf16x8 qr[4];
#pragma unroll
        for (int ks = 0; ks < 4; ++ks) qr[ks] = sb == 0 ? qall[0][ks] : qall[1][ks];
        mf32x16 p[5];
#pragma unroll
        for (int kk = 0; kk < 5; ++kk) { p[kk] = (mf32x16){};
            const LAS unsigned char* kp = Kl + (32 * (kb0 + kk) + r32) * SWK_ROWB + 16 * hi;
#pragma unroll
            for (int ks = 0; ks < 4; ++ks) { const mbf16x8 kf = *(const LAS mbf16x8*)(kp + 32 * ks); p[kk] = MFMA32(kf, qr[ks], p[kk]); } }
        const int qpos = 128 + r0 + r32; float mx = -INFINITY;
        {
            const LAS float* tl = (const LAS float*)(F.lds + TAB_OFF) + 12 * 128 + head * 192 + (32 + 128 + r32 - 4 * hi - 159);
            const int lim = (qblk > 0 ? 0 : 128) - 32 * kb0 - 4 * hi;
#pragma unroll
            for (int kk = 0; kk < 5; ++kk) {
#pragma unroll
                for (int r = 0; r < 16; ++r) { const int c = 32 * kk + (r & 3) + 8 * (r >> 2); float s = p[kk][r] + tl[159 - c]; s = c < lim ? -INFINITY : s; p[kk][r] = s; mx = fmaxf(mx, s); }
                asm volatile("" ::: "memory"); }
        }
        mx = fmaxf(mx, __shfl_xor(mx, 32)); mx = fmaxf(mx, sink2);
        float lsum = 0.f;
#pragma unroll
        for (int kk = 0; kk < 5; ++kk)
#pragma unroll
            for (int r = 0; r < 16; ++r) { const float e = __builtin_amdgcn_exp2f(p[kk][r] - mx); p[kk][r] = e; lsum += e; }
        lsum += __shfl_xor(lsum, 32); lsum += __builtin_amdgcn_exp2f(sink2 - mx);
        mf32x16 o[2]; o[0] = (mf32x16){}; o[1] = (mf32x16){};
#pragma unroll
        for (int kk = 0; kk < 5; ++kk)
#pragma unroll
            for (int s = 0; s < 2; ++s) {
                v4u pw; pw.x = cvtpk(p[kk][8 * s], p[kk][8 * s + 1]); pw.y = cvtpk(p[kk][8 * s + 2], p[kk][8 * s + 3]); pw.z = cvtpk(p[kk][8 * s + 4], p[kk][8 * s + 5]); pw.w = cvtpk(p[kk][8 * s + 6], p[kk][8 * s + 7]);
                const mbf16x8 pa = __builtin_bit_cast(mbf16x8, pw);
#pragma unroll
                for (int db = 0; db < 2; ++db) { const LAS unsigned char* vp = Vt + (32 * db + r32) * SWV_ROWB + (32 * (kb0 + kk) + 16 * s + 4 * hi) * 2;
                    const v2u lo = *(const LAS v2u*)vp, hi2 = *(const LAS v2u*)(vp + 16);
                    const v4u vw = (v4u){lo.x, lo.y, hi2.x, hi2.y};
                    o[db] = MFMA32(pa, __builtin_bit_cast(mbf16x8, vw), o[db]); } }
        const float linv = 1.0f / lsum;
#pragma unroll
        for (int r = 0; r < 16; ++r) { const int q = crow16(r, hi); const float li = __shfl(linv, q);
            bf16* op = OUT + (rowb + tb + r0 + q) * 512 + head * 64 + r32;
            op[0] = (bf16)f2bf(o[0][r] * li); op[32] = (bf16)f2bf(o[1][r] * li); }
    }
    __syncthreads();
}
__device__ __forceinline__ float xhalf(float x, int hi) { const unsigned u = __float_as_uint(x); auto rr = __builtin_amdgcn_permlane32_swap(u, u, false, false); return __uint_as_float(hi ? rr[0] : rr[1]); }
constexpr int LRX_ROWB = 144;
struct LruM { mbf16x8 wb[2][2][4]; float ba[2], bx[2], sp8[2]; float cw0, cw1, cw2, cw3, cb; };
__device__ __forceinline__ void lru_load_m(Frame& F, int l, LruM& W) {
    const int h = F.wave, r32 = F.lane & 31, hi = F.lane >> 5;
#pragma unroll
    for (int g = 0; g < 2; ++g) { const float* Wg = inp(g == 0 ? I_LWA : I_LWX) + (size_t)(l * 8 + h) * 4096;
        { float wf[2][4][8];
#pragma unroll
          for (int n = 0; n < 2; ++n)
#pragma unroll
            for (int ks = 0; ks < 4; ++ks) { const float* p = Wg + (size_t)(16 * ks + 8 * hi) * 64 + 32 * n + r32;
#pragma unroll
                for (int i = 0; i < 8; ++i) wf[n][ks][i] = p[64 * i]; }
#pragma unroll
          for (int n = 0; n < 2; ++n)
#pragma unroll
            for (int ks = 0; ks < 4; ++ks) { v4u w; w.x = cvtpk(wf[n][ks][0], wf[n][ks][1]); w.y = cvtpk(wf[n][ks][2], wf[n][ks][3]); w.z = cvtpk(wf[n][ks][4], wf[n][ks][5]); w.w = cvtpk(wf[n][ks][6], wf[n][ks][7]);
                asm volatile("" : "+v"(w));
                W.wb[g][n][ks] = __builtin_bit_cast(mbf16x8, w); }
          asm volatile("" ::: "memory"); } }
#pragma unroll
    for (int n = 0; n < 2; ++n) { const int ch = l * 512 + 64 * h + 32 * n + r32; W.ba[n] = inp(I_LBA)[ch]; W.bx[n] = inp(I_LBX)[ch]; W.sp8[n] = 8.0f * LOG2E * log1pf(__expf(-inp(I_LLAM)[ch])); }
    const int chc = 64 * h + F.lane; const float* cw = inp(I_CONVW) + (size_t)l * 4 * 512 + chc; W.cw0 = cw[0]; W.cw1 = cw[512]; W.cw2 = cw[1024]; W.cw3 = cw[1536]; W.cb = inp(I_CONVB)[l * 512 + chc];
}
template <int PASS> __device__ __forceinline__ void lru_unit_m(Frame& F, LruM& W, const int l, const bool loadw, int b, int chunk) {
    const bf16* PROJ = (const bf16*)(F.ws + WS_PROJ);
    LAS unsigned char* xcb = F.lds + RING_OFF + F.wave * (64 * LRX_ROWB);
    float* SA = (float*)(F.ws + WS_SUMM); float* SB = SA + 2 * LRU_NCH * 512;
    const int h = F.wave, r32 = F.lane & 31, hi = F.lane >> 5;
    const int t0 = chunk * LRU_LC; const size_t rowb = (size_t)b * SEQ;
    unsigned* const LBW = (unsigned*)(F.ws + WS_ACT) + ((size_t)((b * LRU_NCH + chunk) * 8 + h) * 64) * 64 + F.lane;
    const int chv = 64 * h + F.lane; unsigned short xraw[64], xh3 = 0, xh2 = 0, xh1 = 0;
    if (t0 > 0) { const bf16* p = PROJ + (rowb + t0 - 3) * INW + chv; xh3 = p[0]; xh2 = p[INW]; xh1 = p[2 * INW]; }
#pragma unroll
    for (int i = 0; i < 64; ++i) xraw[i] = PROJ[(rowb + t0 + i) * INW + chv];
    asm volatile("" ::: "memory");
    if (loadw) lru_load_m(F, l, W);
    float hc[2] = {0.f, 0.f}, ap[2] = {1.f, 1.f};
    if (PASS == 2 && chunk > 0) {
        const int c1 = chunk >> 1, lo = hi ? c1 : 0, cnt = hi ? chunk - c1 : c1, cmax = chunk - c1;
        const float* a = SA + (size_t)(b * LRU_NCH) * 512 + 64 * h + r32; const float* bb = SB + (size_t)(b * LRU_NCH) * 512 + 64 * h + r32;
        float Ac[2] = {1.f, 1.f}, Bc[2] = {0.f, 0.f};
#pragma unroll 1
        for (int c = 0; c < cmax; c += 16) { float ta[2][16], tb[2][16];
#pragma unroll
            for (int n = 0; n < 2; ++n)
#pragma unroll
                for (int i = 0; i < 16; ++i) { const int ci = c + i; const bool ok = ci < cnt; const int idx = lo + (ok ? ci : 0); const float va = a[(size_t)idx * 512 + 32 * n], vb = bb[(size_t)idx * 512 + 32 * n]; ta[n][i] = ok ? va : 1.f; tb[n][i] = ok ? vb : 0.f; }
#pragma unroll
            for (int n = 0; n < 2; ++n)
#pragma unroll
                for (int i = 0; i < 16; ++i) { Bc[n] = ta[n][i] * Bc[n] + tb[n][i]; Ac[n] *= ta[n][i]; } }
#pragma unroll
        for (int n = 0; n < 2; ++n) { const float Ap = __shfl_xor(Ac[n], 32), Bp = __shfl_xor(Bc[n], 32);
            hc[n] = hi ? (Ac[n] * Bp + Bc[n]) : (Ap * Bc[n] + Bp); }
    }
    { float xm3 = bf1(xh3), xm2 = bf1(xh2), xm1 = bf1(xh1);
#pragma unroll
      for (int i = 0; i < 64; ++i) { const float xv = bf1(xraw[i]); const float xc = W.cb + W.cw0 * xm3 + W.cw1 * xm2 + W.cw2 * xm1 + W.cw3 * xv; xm3 = xm2; xm2 = xm1; xm1 = xv;
          *(LAS unsigned short*)(xcb + i * LRX_ROWB + 2 * F.lane) = (unsigned short)f2bf(xc); } }
    LDS_WAIT(); asm volatile("" ::: "memory");
#pragma unroll 1
    for (int mt = 0; mt < 2; ++mt) {
        mbf16x8 af[4];
#pragma unroll
        for (int ks = 0; ks < 4; ++ks) af[ks] = *(const LAS mbf16x8*)(xcb + (32 * mt + r32) * LRX_ROWB + 32 * ks + 16 * hi);
#pragma unroll
        for (int n = 0; n < 2; ++n) {
            unsigned short gqr[16];
            if (PASS == 2) {
#pragma unroll
                for (int r = 0; r < 16; ++r) gqr[r] = PROJ[(rowb + t0 + 32 * mt + crow16(r, hi)) * INW + 512 + 64 * h + 32 * n + r32];
                asm volatile("" ::: "memory"); }
            mf32x16 ga = (mf32x16){}, gx = (mf32x16){};
#pragma unroll
            for (int ks = 0; ks < 4; ++ks) { ga = MFMA32(af[ks], W.wb[0][n][ks], ga); gx = MFMA32(af[ks], W.wb[1][n][ks], gx); }
            float av[16], bv[16];
#pragma unroll
            for (int r = 0; r < 16; ++r) { const int tok = 32 * mt + crow16(r, hi);
                const float xc = bf1(*(const LAS unsigned short*)(xcb + tok * LRX_ROWB + 2 * (32 * n + r32)));
                const float rg = __builtin_amdgcn_rcpf(1.0f + __builtin_amdgcn_exp2f(-LOG2E * (ga[r] + W.ba[n])));
                const float ui = 1.0f + __builtin_amdgcn_exp2f(-LOG2E * (gx[r] + W.bx[n]));
                const float la = -W.sp8[n] * rg; const float a = __builtin_amdgcn_exp2f(la);
                const float tq = fmaxf(1.0f - a * a, 0.f);
                av[r] = a; bv[r] = xc * tq * __builtin_amdgcn_rsqf(fmaxf(tq, 1e-30f) * ui * ui);
                if (PASS == 1) LBW[(size_t)(((mt * 2 + n) * 16 + r) * 64)] = pk2(la, bv[r]); }
            float hh = hc[n], hs[16];
#pragma unroll
            for (int m = 0; m < 4; ++m) {
                const float t0_ = av[4 * m] * hh + bv[4 * m], t1_ = av[4 * m + 1] * t0_ + bv[4 * m + 1], t2_ = av[4 * m + 2] * t1_ + bv[4 * m + 2], t3_ = av[4 * m + 3] * t2_ + bv[4 * m + 3];
                const float hA = xhalf(t3_, hi);
                const float u0_ = av[4 * m] * hA + bv[4 * m], u1_ = av[4 * m + 1] * u0_ + bv[4 * m + 1], u2_ = av[4 * m + 2] * u1_ + bv[4 * m + 2], u3_ = av[4 * m + 3] * u2_ + bv[4 * m + 3];
                const float hB = xhalf(u3_, hi);
                hs[4 * m] = hi ? u0_ : t0_; hs[4 * m + 1] = hi ? u1_ : t1_; hs[4 * m + 2] = hi ? u2_ : t2_; hs[4 * m + 3] = hi ? u3_ : t3_;
                hh = hi ? u3_ : hB; }
            hc[n] = hh;
            if (PASS == 1) {
#pragma unroll
                for (int r = 0; r < 16; ++r) ap[n] *= av[r]; }
            if (PASS == 2) {
#pragma unroll
                for (int r = 0; r < 16; ++r) { const size_t row = rowb + t0 + 32 * mt + crow16(r, hi); const int ch = 64 * h + 32 * n + r32;
                    const float gq = bf1(gqr[r]); const float u2 = 2.0f * 0.7978845608028654f * (gq + 0.044715f * gq * gq * gq);
                    const float ge = gq * __builtin_amdgcn_rcpf(1.0f + __builtin_amdgcn_exp2f(-LOG2E * u2));
                    ((bf16*)(F.ws + WS_BR))[row * 512 + ch] = (bf16)f2bf(hs[r] * ge);
                    } }
        }
    }
    if (PASS == 1) {
#pragma unroll
        for (int n = 0; n < 2; ++n) { const float at = ap[n] * __shfl_xor(ap[n], 32);
            if (hi == 0) { const size_t o = (size_t)(b * LRU_NCH + chunk) * 512 + 64 * h + 32 * n + r32; SA[o] = at; SB[o] = hc[n]; } }
    }
    LDS_WAIT(); asm volatile("" ::: "memory");
}

__device__ __forceinline__ void lru_p2_block(Frame& F, const int mt, const unsigned (&lb)[2][16], const unsigned short (&gqv)[2][16], float (&hc)[2], const size_t rowb, const int t0, const int h, const int r32, const int hi) {
#pragma unroll
    for (int n = 0; n < 2; ++n) {
        float av[16], bv[16];
#pragma unroll
        for (int r = 0; r < 16; ++r) { av[r] = __builtin_amdgcn_exp2f(bflo(lb[n][r])); bv[r] = bfhi(lb[n][r]); }
        float hh = hc[n], hs[16];
#pragma unroll
        for (int m = 0; m < 4; ++m) {
            const float t0_ = av[4 * m] * hh + bv[4 * m], t1_ = av[4 * m + 1] * t0_ + bv[4 * m + 1], t2_ = av[4 * m + 2] * t1_ + bv[4 * m + 2], t3_ = av[4 * m + 3] * t2_ + bv[4 * m + 3];
            const float hA = xhalf(t3_, hi);
            const float u0_ = av[4 * m] * hA + bv[4 * m], u1_ = av[4 * m + 1] * u0_ + bv[4 * m + 1], u2_ = av[4 * m + 2] * u1_ + bv[4 * m + 2], u3_ = av[4 * m + 3] * u2_ + bv[4 * m + 3];
            const float hB = xhalf(u3_, hi);
            hs[4 * m] = hi ? u0_ : t0_; hs[4 * m + 1] = hi ? u1_ : t1_; hs[4 * m + 2] = hi ? u2_ : t2_; hs[4 * m + 3] = hi ? u3_ : t3_;
            hh = hi ? u3_ : hB; }
        hc[n] = hh;
#pragma unroll
        for (int r = 0; r < 16; ++r) { const size_t row = rowb + t0 + 32 * mt + crow16(r, hi); const int ch = 64 * h + 32 * n + r32;
            const float gq = bf1(gqv[n][r]); const float u2 = 2.0f * 0.7978845608028654f * (gq + 0.044715f * gq * gq * gq);
            const float ge = gq * __builtin_amdgcn_rcpf(1.0f + __builtin_amdgcn_exp2f(-LOG2E * u2));
            ((bf16*)(F.ws + WS_BR))[row * 512 + ch] = (bf16)f2bf(hs[r] * ge); }
    }
}
__device__ __forceinline__ void lru_unit_p2(Frame& F, int b, int chunk) {
    const bf16* PROJ = (const bf16*)(F.ws + WS_PROJ);
    float* SA = (float*)(F.ws + WS_SUMM); float* SB = SA + 2 * LRU_NCH * 512;
    const int h = F.wave, r32 = F.lane & 31, hi = F.lane >> 5;
    const int t0 = chunk * LRU_LC; const size_t rowb = (size_t)b * SEQ;
    const unsigned* const LB = (const unsigned*)(F.ws + WS_ACT) + ((size_t)((b * LRU_NCH + chunk) * 8 + h) * 64) * 64 + F.lane;
    unsigned lb0[2][16], lb1[2][16]; unsigned short gq0[2][16], gq1[2][16];
#pragma unroll
    for (int n = 0; n < 2; ++n)
#pragma unroll
        for (int r = 0; r < 16; ++r) { lb0[n][r] = LB[(size_t)((n * 16 + r) * 64)]; gq0[n][r] = PROJ[(rowb + t0 + crow16(r, hi)) * INW + 512 + 64 * h + 32 * n + r32]; }
    asm volatile("" ::: "memory");
    float hc[2] = {0.f, 0.f};
    if (chunk > 0) {
        const int c1 = chunk >> 1, lo = hi ? c1 : 0, cnt = hi ? chunk - c1 : c1, cmax = chunk - c1;
        const float* a = SA + (size_t)(b * LRU_NCH) * 512 + 64 * h + r32; const float* bb = SB + (size_t)(b * LRU_NCH) * 512 + 64 * h + r32;
        float Ac[2] = {1.f, 1.f}, Bc[2] = {0.f, 0.f};
#pragma unroll 1
        for (int c = 0; c < cmax; c += 16) { float ta[2][16], tb[2][16];
#pragma unroll
            for (int n = 0; n < 2; ++n)
#pragma unroll
                for (int i = 0; i < 16; ++i) { const int ci = c + i; const bool ok = ci < cnt; const int idx = lo + (ok ? ci : 0); const float va = a[(size_t)idx * 512 + 32 * n], vb = bb[(size_t)idx * 512 + 32 * n]; ta[n][i] = ok ? va : 1.f; tb[n][i] = ok ? vb : 0.f; }
#pragma unroll
            for (int n = 0; n < 2; ++n)
#pragma unroll
                for (int i = 0; i < 16; ++i) { Bc[n] = ta[n][i] * Bc[n] + tb[n][i]; Ac[n] *= ta[n][i]; } }
#pragma unroll
        for (int n = 0; n < 2; ++n) { const float Ap = __shfl_xor(Ac[n], 32), Bp = __shfl_xor(Bc[n], 32);
            hc[n] = hi ? (Ac[n] * Bp + Bc[n]) : (Ap * Bc[n] + Bp); }
    }
#pragma unroll
    for (int n = 0; n < 2; ++n)
#pragma unroll
        for (int r = 0; r < 16; ++r) { lb1[n][r] = LB[(size_t)(((2 + n) * 16 + r) * 64)]; gq1[n][r] = PROJ[(rowb + t0 + 32 + crow16(r, hi)) * INW + 512 + 64 * h + 32 * n + r32]; }
    asm volatile("" ::: "memory");
    lru_p2_block(F, 0, lb0, gq0, hc, rowb, t0, h, r32, hi);
    lru_p2_block(F, 1, lb1, gq1, hc, rowb, t0, h, r32, hi);
}
__device__ __forceinline__ void p_router(Frame& F, int l) {
    LAS float* PART = (LAS float*)(F.lds + RING_OFF);
    LAS float* RSTD = (LAS float*)(F.lds + RING_OFF + 65536);
    LAS float* CVEC = RSTD + 64;
    LAS int* CNT = (LAS int*)(CVEC + 256);
    const bf16* x = (const bf16*)(F.ws + WS_XS) + (size_t)64 * 1024 * 512;
    const int e = F.lane & 31, half = F.lane >> 5;
    const int rows0 = F.vcu * 64; const int b = rows0 >> 13;
    const float* nf = inp(I_NFFN) + l * 1024; const float* sc = modv(F, l, b, 4); const float* sh = modv(F, l, b, 3);
    if (F.tid < 32) CNT[F.tid] = 0;
    v2u xw[8][4];
#pragma unroll
    for (int q = 0; q < 8; ++q) { const v2u* xr = (const v2u*)(x + (size_t)(rows0 + 8 * F.wave + q) * D) + F.lane;
#pragma unroll
        for (int j = 0; j < 4; ++j) xw[q][j] = xr[64 * j]; }
    asm volatile("" ::: "memory");
    { f32x4 g1[4], g2[4];
#pragma unroll
      for (int j = 0; j < 4; ++j) { const int c = 4 * F.lane + 256 * j; const f32x4 n4 = *(const f32x4*)(nf + c), s4 = *(const f32x4*)(sc + c); g1[j] = n4 * (s4 + 1.0f); g2[j] = *(const f32x4*)(sh + c); }
#pragma unroll
      for (int q = 0; q < 8; ++q) { const int lr = 8 * F.wave + q, r = rows0 + lr; f32x4 v[4]; float s = 0.f;
#pragma unroll
          for (int j = 0; j < 4; ++j) { const v2u w = xw[q][j]; v[j] = (f32x4){bflo(w.x), bfhi(w.x), bflo(w.y), bfhi(w.y)}; s += (v[j].x * v[j].x + v[j].y * v[j].y) + (v[j].z * v[j].z + v[j].w * v[j].w); }
          const float rstd = 1.0f / sqrtf(wave_sum(s) * (1.0f / D) + NORM_EPS);
          if (F.lane == 0) RSTD[lr] = rstd;
          unsigned long long* o8 = (unsigned long long*)((bf16*)(F.ws + WS_H) + (size_t)r * D) + F.lane;
#pragma unroll
          for (int j = 0; j < 4; ++j) { const f32x4 o = v[j] * rstd * g1[j] + g2[j]; o8[64 * j] = (unsigned long long)pk2(o.x, o.y) | ((unsigned long long)pk2(o.z, o.w) << 32); } } }
    asm volatile("" ::: "memory");
    mbf16x8 Bh[8], Bl[8]; float cpart = 0.f;
    { const float* wr = inp(I_WR) + (size_t)l * 1024 * 32 + e; const int k0 = 128 * F.wave + 8 * half;
#pragma unroll
      for (int s = 0; s < 8; ++s) { const int kk = k0 + 16 * s;
          const f32x4 n0 = *(const f32x4*)(nf + kk), n1 = *(const f32x4*)(nf + kk + 4), s0 = *(const f32x4*)(sc + kk), s1 = *(const f32x4*)(sc + kk + 4), h0 = *(const f32x4*)(sh + kk), h1 = *(const f32x4*)(sh + kk + 4);
          const f32x4 ga = n0 * (s0 + 1.0f), gb = n1 * (s1 + 1.0f);
          float wp[8];
#pragma unroll
          for (int i = 0; i < 8; ++i) { const float wv = wr[(size_t)(kk + i) * 32]; wp[i] = wv * (i < 4 ? ga[i & 3] : gb[i & 3]); cpart += wv * (i < 4 ? h0[i & 3] : h1[i & 3]); }
          v4u ph, pl;
#pragma unroll
          for (int i = 0; i < 4; ++i) { const unsigned p = pk2(wp[2 * i], wp[2 * i + 1]); ph[i] = p; pl[i] = pk2(wp[2 * i] - bflo(p), wp[2 * i + 1] - bfhi(p)); }
          Bh[s] = __builtin_bit_cast(mbf16x8, ph); Bl[s] = __builtin_bit_cast(mbf16x8, pl);
          if ((s & 3) == 3) asm volatile("" ::: "memory"); } }
    cpart += __shfl_xor(cpart, 32);
    if (half == 0) CVEC[F.wave * 32 + e] = cpart;
    asm volatile("" ::: "memory");
    { const bf16* xa = x + (size_t)(rows0 + e) * D + 128 * F.wave + 8 * half;
      mbf16x8 A0[8], A1[8];
#pragma unroll
      for (int s = 0; s < 8; ++s) { A0[s] = *(const mbf16x8*)(xa + 16 * s); A1[s] = *(const mbf16x8*)(xa + (size_t)32 * D + 16 * s); }
      mf32x16 acc0 = {}, acc1 = {};
#pragma unroll
      for (int s = 0; s < 8; ++s) {
          acc0 = __builtin_amdgcn_mfma_f32_32x32x16_bf16(A0[s], Bh[s], acc0, 0, 0, 0); acc1 = __builtin_amdgcn_mfma_f32_32x32x16_bf16(A1[s], Bh[s], acc1, 0, 0, 0);
          acc0 = __builtin_amdgcn_mfma_f32_32x32x16_bf16(A0[s], Bl[s], acc0, 0, 0, 0); acc1 = __builtin_amdgcn_mfma_f32_32x32x16_bf16(A1[s], Bl[s], acc1, 0, 0, 0); }
#pragma unroll
      for (int r = 0; r < 16; ++r) { const int row = (r & 3) + 8 * (r >> 2) + 4 * half; PART[(F.wave * 64 + row) * 32 + e] = acc0[r]; PART[(F.wave * 64 + 32 + row) * 32 + e] = acc1[r]; } }
    __syncthreads();
    { float cv = inp(I_BR)[l * 32 + e];
#pragma unroll
      for (int w = 0; w < 8; ++w) cv += CVEC[w * 32 + e];
#pragma unroll
      for (int it = 0; it < 4; ++it) { const int lr = 8 * F.wave + 2 * it + half, r = rows0 + lr; float a = 0.f;
#pragma unroll
          for (int w = 0; w < 8; ++w) a += PART[(w * 64 + lr) * 32 + e];
          const float lg = a * RSTD[lr] + cv;
          int rk = 0;
#pragma unroll
          for (int o = 1; o < 32; ++o) { const float ov = __shfl_xor(lg, o); rk += (ov > lg || (ov == lg && (e ^ o) < e)) ? 1 : 0; }
          float tv[4]; int te[4];
#pragma unroll
          for (int k = 0; k < 4; ++k) { const unsigned long long m = __ballot(rk == k); const unsigned mh = (unsigned)(m >> (32 * half)); const int src = (mh ? __builtin_ctz(mh) : 0) + 32 * half; tv[k] = __shfl(lg, src); te[k] = src & 31; }
          const float p1 = __expf(tv[1] - tv[0]), p2 = __expf(tv[2] - tv[0]), p3 = __expf(tv[3] - tv[0]); const float inv = 1.0f / (1.0f + p1 + p2 + p3);
          if (e < 4) { const float pw = e == 0 ? 1.0f : (e == 1 ? p1 : (e == 2 ? p2 : p3)); const int ee = e == 0 ? te[0] : (e == 1 ? te[1] : (e == 2 ? te[2] : te[3]));
              const int rank = atomicAdd((int*)(CNT + ee), 1);
              ((float*)(F.ws + WS_TOPW))[(size_t)r * 4 + e] = pw * inv;
              ((unsigned*)(F.ws + WS_ERANK))[(size_t)r * 4 + e] = ((unsigned)ee << 20) | (unsigned)rank; } } }
    __syncthreads();
    if (F.tid < 32) ((int*)(F.ws + WS_BLKCNT))[F.vcu * 32 + F.tid] = CNT[F.tid];
}
__device__ __forceinline__ void p_scatter(Frame& F) {
    LAS int* S16 = (LAS int*)(F.lds + RING_OFF);
    LAS int* SLOTB = S16 + 512;
    LAS int* TOT = SLOTB + 32;
    const int* BC = (const int*)(F.ws + WS_BLKCNT);
    const int e = F.tid & 31, part = F.tid >> 5;
    const unsigned er_pre = F.tid < 256 ? ((const unsigned*)(F.ws + WS_ERANK))[(size_t)(F.vcu * 64 + (F.tid >> 2)) * 4 + (F.tid & 3)] : 0u;
    LAS int* PRE = TOT + 32;
    { int s = 0, pre = 0;
#pragma unroll
      for (int q = 0; q < 16; ++q) { const int bb = part * 16 + q; const int v = bb < F.G ? BC[bb * 32 + e] : 0; s += v; if (bb < F.vcu) pre += v; }
      S16[part * 32 + e] = s; if (part == (F.vcu >> 4)) PRE[e] = pre; }
    __syncthreads();
    if (F.tid < 32) { int tot = 0, base = 0; const int mp = F.vcu >> 4;
        for (int q = 0; q < 16; ++q) { tot += S16[q * 32 + e]; if (q < mp) base += S16[q * 32 + e]; }
        TOT[e] = tot; SLOTB[e] = base + PRE[e]; }
    __syncthreads();
    if (F.tid < 64) {
        const int ee = F.tid & 31; const int nt = (TOT[ee] + 255) >> 8; int inc = nt;
#pragma unroll
        for (int o = 1; o < 32; o <<= 1) { const int v = __shfl_up(inc, o, 32); if (ee >= o) inc += v; }
        const int t0 = inc - nt;
        if (F.tid < 32) { SLOTB[ee] += t0 << 8;
            if (F.vcu == 0) { int* tm = (int*)(F.ws + WS_TILEMAP); for (int j = 0; j < nt; ++j) tm[1 + t0 + j] = ee; if (ee == 31) tm[0] = inc; } } }
    __syncthreads();
    const unsigned* ER = (const unsigned*)(F.ws + WS_ERANK); int* DEST = (int*)(F.ws + WS_DEST); int* ROWTOK = (int*)(F.ws + WS_ROWTOK);
    const int rows0 = F.vcu * 64;
    if (F.tid < 256) {
        const int p = F.tid, r = rows0 + (p >> 2), k = p & 3; const unsigned er = er_pre; const int slot = SLOTB[er >> 20] + (int)(er & 0xfffffu);
        DEST[(size_t)r * 4 + k] = slot; ROWTOK[slot] = r; }
}
__device__ __forceinline__ void p_combine(Frame& F, int l, bool next_norm) {
    const int gw = F.vcu * NWAVES + F.wave; const int r0 = gw * 8, b = r0 >> 13;
    const float* gf = modv(F, l, b, 5);
    const int c0 = 8 * F.lane;
    f32x4 gfv[2][2], g1[2][2], g2[2][2];
#pragma unroll
    for (int j = 0; j < 2; ++j)
#pragma unroll
        for (int q = 0; q < 2; ++q) { const int c = c0 + 512 * j + 4 * q; gfv[j][q] = *(const f32x4*)(gf + c);
            if (next_norm) { const f32x4 n4 = *(const f32x4*)(inp(I_NMIX) + (l + 1) * 1024 + c), s4 = *(const f32x4*)(modv(F, l + 1, b, 1) + c); g1[j][q] = n4 * (s4 + 1.0f); g2[j][q] = *(const f32x4*)(modv(F, l + 1, b, 0) + c); }
            else { g1[j][q] = (f32x4){0.f, 0.f, 0.f, 0.f}; g2[j][q] = g1[j][q]; } }
    const float* TW = (const float*)(F.ws + WS_TOPW); const int* DEST = (const int*)(F.ws + WS_DEST); const bf16* Y = (const bf16*)(F.ws + WS_Y);
    const bf16* XR1 = (const bf16*)(F.ws + WS_XS) + (size_t)64 * 1024 * 512; bf16* XR2 = (bf16*)(F.ws + WS_XS) + (size_t)96 * 1024 * 512;
    float tws[8][4]; int dss[8][4];
#pragma unroll
    for (int i = 0; i < 8; ++i) { const f32x4 t4 = *(const f32x4*)(TW + (size_t)(r0 + i) * 4); const v4u d4 = *(const v4u*)(DEST + (size_t)(r0 + i) * 4);
#pragma unroll
        for (int k = 0; k < 4; ++k) { tws[i][k] = __uint_as_float(__builtin_amdgcn_readfirstlane(__float_as_uint(t4[k]))); dss[i][k] = __builtin_amdgcn_readfirstlane((int)d4[k]); } }
#pragma unroll
    for (int i = 0; i < 8; ++i) { const int r = r0 + i;
        const f32x4 tw = (f32x4){tws[i][0], tws[i][1], tws[i][2], tws[i][3]}; const int d0 = dss[i][0], d1 = dss[i][1], d2 = dss[i][2], d3 = dss[i][3];
        f32x4 xo[2][2]; float ss = 0.f;
#pragma unroll
        for (int j = 0; j < 2; ++j) {
            const v4u y0 = __builtin_nontemporal_load((const v4u*)(Y + (size_t)d0 * D + c0 + 512 * j)), y1 = __builtin_nontemporal_load((const v4u*)(Y + (size_t)d1 * D + c0 + 512 * j)), y2 = __builtin_nontemporal_load((const v4u*)(Y + (size_t)d2 * D + c0 + 512 * j)), y3 = __builtin_nontemporal_load((const v4u*)(Y + (size_t)d3 * D + c0 + 512 * j));
            f32x4 m0, m1;
            m0.x = tw.x * bflo(y0.x) + tw.y * bflo(y1.x) + tw.z * bflo(y2.x) + tw.w * bflo(y3.x); m0.y = tw.x * bfhi(y0.x) + tw.y * bfhi(y1.x) + tw.z * bfhi(y2.x) + tw.w * bfhi(y3.x);
            m0.z = tw.x * bflo(y0.y) + tw.y * bflo(y1.y) + tw.z * bflo(y2.y) + tw.w * bflo(y3.y); m0.w = tw.x * bfhi(y0.y) + tw.y * bfhi(y1.y) + tw.z * bfhi(y2.y) + tw.w * bfhi(y3.y);
            m1.x = tw.x * bflo(y0.z) + tw.y * bflo(y1.z) + tw.z * bflo(y2.z) + tw.w * bflo(y3.z); m1.y = tw.x * bfhi(y0.z) + tw.y * bfhi(y1.z) + tw.z * bfhi(y2.z) + tw.w * bfhi(y3.z);
            m1.z = tw.x * bflo(y0.w) + tw.y * bflo(y1.w) + tw.z * bflo(y2.w) + tw.w * bflo(y3.w); m1.w = tw.x * bfhi(y0.w) + tw.y * bfhi(y1.w) + tw.z * bfhi(y2.w) + tw.w * bfhi(y3.w);
            const size_t xo_ = (size_t)r * D + c0 + 512 * j; const v4u xw = __builtin_nontemporal_load((const v4u*)(XR1 + xo_));
            xo[j][0] = (f32x4){bflo(xw.x), bfhi(xw.x), bflo(xw.y), bfhi(xw.y)} + gfv[j][0] * m0; xo[j][1] = (f32x4){bflo(xw.z), bfhi(xw.z), bflo(xw.w), bfhi(xw.w)} + gfv[j][1] * m1;
            if (next_norm) { v4u ow; ow.x = pk2(xo[j][0].x, xo[j][0].y); ow.y = pk2(xo[j][0].z, xo[j][0].w); ow.z = pk2(xo[j][1].x, xo[j][1].y); ow.w = pk2(xo[j][1].z, xo[j][1].w); *(v4u*)(XR2 + xo_) = ow; }
            else { *(f32x4*)(F.out + xo_) = xo[j][0]; *(f32x4*)(F.out + xo_ + 4) = xo[j][1]; }
#pragma unroll
            for (int q = 0; q < 2; ++q) ss += (xo[j][q].x * xo[j][q].x + xo[j][q].y * xo[j][q].y) + (xo[j][q].z * xo[j][q].z + xo[j][q].w * xo[j][q].w);
        }
        if (next_norm) {
            const float rstd = 1.0f / sqrtf(wave_sum(ss) * (1.0f / D) + NORM_EPS);
#pragma unroll
            for (int j = 0; j < 2; ++j) { const f32x4 a = xo[j][0] * rstd * g1[j][0] + g2[j][0], c = xo[j][1] * rstd * g1[j][1] + g2[j][1];
                v4u w; w.x = pk2(a.x, a.y); w.y = pk2(a.z, a.w); w.z = pk2(c.x, c.y); w.w = pk2(c.z, c.w);
                *(v4u*)((bf16*)(F.ws + WS_H) + (size_t)r * D + c0 + 512 * j) = w; }
        }
    }
}
#ifndef CQ_PER_ROUND
#define CQ_PER_ROUND 3
#endif
#ifndef MOE_XCD_ROUNDS
#define MOE_XCD_ROUNDS 1
#endif
#if MOE_XCD_ROUNDS
#define MOE_C(b) ((((b) & 7) << 5) | ((b) >> 3))
#else
#define MOE_C(b) (b)
#endif
#ifndef GEMM_SP2
#define GEMM_SP2 true
#endif
#ifndef ATTN_HAND
#define ATTN_HAND 1
#endif
#if ATTN_HAND
#define ATTN_CALL(l_, q_, o_, t_, v_, i_) attn2::attn_phase<8>(l_, (const attn2::bf16*)(q_), (attn2::bf16*)(o_), t_, v_, i_, attn_fast)
#else
#define ATTN_CALL(l_, q_, o_, t_, v_, i_) (void)attn_fast; da::phase(l_, (const da::bf16*)(q_), (da::bf16*)(o_), t_, v_, i_)
#endif
#ifndef XCD_CHUNKED
#define XCD_CHUNKED 0
#endif
#if XCD_CHUNKED
#define XCDMAP_VCU(bx, G) (bx)
#define XCDMAP_C(b) (((b) % 32) * 8 + (b) / 32)
#else
#define XCDMAP_VCU(bx, G) (((G) % 8 == 0) ? ((bx) % 8) * ((G) / 8) + (bx) / 8 : (bx))
#define XCDMAP_C(b) (b)
#endif
constexpr int N_PHASES = 2 + 11 * NL;
__device__ __forceinline__ void RETID_(Frame& F) { int t_ = threadIdx.x; asm volatile("" : "+v"(t_)); F.tid = t_; F.lane = t_ & 63; F.wave = __builtin_amdgcn_readfirstlane(t_ >> 6); }
struct Args { const float* in[30]; float* out; unsigned char* ws; int ph_lo, ph_hi, li, pad; };
#ifndef PHMASK
#define PHMASK 0x1fff
#endif
#define EN(j) (((PHMASK) >> (j)) & 1)
#ifndef REPMASK
#define REPMASK 0
#endif
#define REPS(j) (1 + (((REPMASK) >> (j)) & 1))
#define RETID() do { int t_ = threadIdx.x; asm volatile("" : "+v"(t_)); F.tid = t_; F.lane = t_ & 63; F.wave = __builtin_amdgcn_readfirstlane(t_ >> 6); } while (0)
#define IN(k) (lo <= (k) && (k) < hi && (RETID_(F), true))
#ifndef MOE_MERGE
#define MOE_MERGE 2
#endif
#ifndef BAR_REPS
#define BAR_REPS 1
#endif
#ifndef BAR_HOST
#define BAR_HOST 1
#endif
#define SEAM(k) do { if (IN(k) && IN((k) + 1)) { if (BAR_HOST) { RETID_(F); xcd_barrier_host(F, bar); } else xcd_barrier(bar); } } while (0)
#define H ((bf16*)(F.ws + WS_H))
#define PROJ ((bf16*)(F.ws + WS_PROJ))
#define BRB ((bf16*)(F.ws + WS_BR))
#define MERGED ((bf16*)(F.ws + WS_MERGED))
#define XS ((bf16*)(F.ws + WS_XS))
#define ACT ((bf16*)(F.ws + WS_ACT))
#define YB ((bf16*)(F.ws + WS_Y))

template <int l> __device__ __forceinline__ void layer_phases(Frame& F, const XcdBarrier& bar, const int lo, const int hi, unsigned char* lds) {
        const int pb = 2 + 11 * l;
        if (lo >= pb + 11 || hi <= pb) return;
        if (EN(2) && IN(pb + 0)) {
            pg8::Gemm g{H, (const bf16*)(F.ws + WS_WIN) + (size_t)l * INW * 1024, T, INW, 1024}; pg8::StaticOrder S; S.init(T, INW, F.G, XCDMAP_C((int)blockIdx.x));
            pg8::EpiIn E{PROJ, INW, 13, (bf16*)(F.ws + WS_XS), inp(I_DQN) + l * 64, inp(I_DKN) + l * 64, inp(I_SQN) + l * 64, inp(I_SKN) + l * 64, (LAS float*)(F.lds + LDSCTL_OFF + 4096), QSCALE, NORM_EPS};
            for (int rep = 0; rep < REPS(2); ++rep) pg8::gemm_phase<pg8::EpiIn, pg8::StaticOrder, true, GEMM_SP2>(F.lds + RING_OFF, g, S, E, F.tid);
            { const int nU = (T / 256) * (INW / 256), c = (int)blockIdx.x; RETID_(F); cq_run(F, ((nU + F.G - 1) / F.G - (c < nU ? (nU - c + F.G - 1) / F.G : 0)) * CQ_PER_ROUND); }
        } SEAM(pb + 0);
        if (EN(4) && IN(pb + 2)) {
#ifndef NO_LRU2
            { LruM W; bool first = true;
              for (int rep = 0; rep < REPS(3); ++rep) for (int u = F.vcu; u < 2 * LRU_NCH; u += F.G) { lru_unit_m<1>(F, W, l, first, u >> 7, u & 127); first = false; } }
#endif
            __syncthreads();
            RETID_(F); build_tabs(F);
            RETID_(F);
#ifndef NO_SWA
            for (int rep = 0; rep < REPS(14); ++rep) for (int u = F.vcu; u < 256; u += F.G) swa_unit_mfma(F, l, u >> 7, (u >> 6) & 1, u & 63);
#endif
            __syncthreads();
#ifndef NO_ATTN
            RETID_(F);
            int attn_fast;
            { const float gqa = fabsf(inp(I_DQN)[l * 64 + F.lane]), gka = fabsf(inp(I_DKN)[l * 64 + F.lane]); float mq = gqa, mk = gka;
              const LAS float* tb = (const LAS float*)(F.lds + TAB_OFF); float mt = 0.f;
#pragma unroll
              for (int i = 0; i < 8; ++i) mt = fmaxf(mt, fabsf(tb[F.lane + 64 * i]));
#pragma unroll
              for (int o = 1; o < 64; o <<= 1) { mq = fmaxf(mq, __shfl_xor(mq, o)); mk = fmaxf(mk, __shfl_xor(mk, o)); mt = fmaxf(mt, __shfl_xor(mt, o)); }
              const float bound = 11.5416f * mq * mk + mt;
              attn_fast = __builtin_amdgcn_readfirstlane((bound <= 100.0f) ? 1 : 0); }
            for (int rep = 0; rep < REPS(4); ++rep) ATTN_CALL((char*)lds + RING_OFF, F.ws + WS_XS, F.ws + WS_ODT, (const float*)(lds + TAB_OFF), F.vcu, F.tid);
#endif
        } SEAM(pb + 2);
        if (EN(5) && IN(pb + 3)) {
            for (int rep = 0; rep < REPS(13); ++rep) for (int u = F.vcu; u < 2 * LRU_NCH; u += F.G) lru_unit_p2(F, u >> 7, u & 127);
            __syncthreads(); RETID_(F);
            for (int rep = 0; rep < REPS(5); ++rep) p_diffpost(F, l);
        } SEAM(pb + 3);
        if (EN(6) && IN(pb + 4)) {
            pg8::Gemm g{BRB, (const bf16*)(F.ws + WS_WBR) + (size_t)l * 3 * 1024 * 512, 3 * T, 1024, 512}; pg8::BranchOrder S; S.init(T, F.G, XCDMAP_C((int)blockIdx.x));
            pg8::EpiBranch E{MERGED, PROJ, INW};
            for (int rep = 0; rep < REPS(6); ++rep) pg8::gemm_phase<pg8::EpiBranch, pg8::BranchOrder, true, GEMM_SP2>(F.lds + RING_OFF, g, S, E, F.tid);
        } SEAM(pb + 4);
        if (EN(7) && IN(pb + 5)) {
            pg8::Gemm g{MERGED, (const bf16*)(F.ws + WS_WOUT) + (size_t)l * 1024 * 1024, T, 1024, 1024}; pg8::StaticOrder S; S.init(T, 1024, F.G, XCDMAP_C((int)blockIdx.x));
            bf16* const XR1 = (bf16*)(F.ws + WS_XS) + (size_t)64 * 1024 * 512; bf16* const XR2 = (bf16*)(F.ws + WS_XS) + (size_t)96 * 1024 * 512;
            if (l == 0) { pg8::EpiOutT<false> E{(const void*)inp(I_X), XR1, modv(F, l, 0, 2)}; pg8::gemm_phase<pg8::EpiOutT<false>, pg8::StaticOrder, true, GEMM_SP2>(F.lds + RING_OFF, g, S, E, F.tid); }
            else { pg8::EpiOutT<true> E{(const void*)XR2, XR1, modv(F, l, 0, 2)}; pg8::gemm_phase<pg8::EpiOutT<true>, pg8::StaticOrder, true, GEMM_SP2>(F.lds + RING_OFF, g, S, E, F.tid); }
        } SEAM(pb + 5);
        if (EN(8) && IN(pb + 6)) { for (int rep = 0; rep < REPS(8); ++rep) { p_router(F, l); __syncthreads(); } } SEAM(pb + 6);
        if (EN(9) && IN(pb + 7)) { for (int rep = 0; rep < REPS(9); ++rep) { p_scatter(F); __syncthreads(); } if (l == 1 || CQ_X1 > 0) { RETID_(F); cq_run(F, 1 << 30, l == 1 ? CQ_TOTAL : CQ_X1); } } SEAM(pb + 7);
        if ((EN(10) || EN(11)) && (IN(pb + 8) || IN(pb + 9))) {
            constexpr bool MERGE = ((MOE_MERGE) >> l) & 1;
            LAS int* TM = (LAS int*)(F.lds + TMAP_OFF); const int* tmg = (const int*)(F.ws + WS_TILEMAP);
            if (F.tid < 512) TM[F.tid] = tmg[F.tid];
            LAS unsigned* RO = (LAS unsigned*)(F.lds + LDSCTL_OFF + 4096);
            if (EN(10) && IN(pb + 8)) { const int* ROWTOK = (const int*)(F.ws + WS_ROWTOK); const int c = MOE_C((int)blockIdx.x);
                for (int i = F.tid; i < 9 * 256; i += NWAVES * 64) { const int u = i >> 8, L = u * F.G + c;
                    const int tok = ROWTOK[(L >> 3) * 256 + (i & 255)]; RO[i] = ((unsigned)tok < (unsigned)T ? (unsigned)tok : 0u) * 2048u; } }
            __syncthreads();
            const int ntiles = __builtin_amdgcn_readfirstlane(TM[0]);
            if (EN(10) && IN(pb + 8)) {
                pg8::Gemm g{H, (const bf16*)(F.ws + WS_W1) + (size_t)l * NEXP * 2048 * 1024, NR_MAX, 2048, 1024}; pg8::MoeOrder S{TM + 1, ntiles, 8, F.G, MOE_C((int)blockIdx.x)};
                pg8::EpiGlu E{ACT, inp(I_B1) + (size_t)l * NEXP * 2048};
                if constexpr (MERGE) { pg8::MoeOrderSig SS{{TM + 1, ntiles, 8, F.G, MOE_C((int)blockIdx.x)}, (unsigned*)(F.ctl + CW_TILE + l * 512)}; pg8::EpiGluT<true> EW{ACT, inp(I_B1) + (size_t)l * NEXP * 2048};
                    pg8::gemm_phase<pg8::EpiGluT<true>, pg8::MoeOrderSig, true, true, true>(F.lds + RING_OFF, g, SS, EW, F.tid, RO); }
                else for (int rep = 0; rep < REPS(10); ++rep) pg8::gemm_phase<pg8::EpiGlu, pg8::MoeOrder, true, true, true>(F.lds + RING_OFF, g, S, E, F.tid, RO);
                if (l == 0) { const int nU = ntiles * 8, c = MOE_C((int)blockIdx.x); RETID_(F); cq_run(F, ((nU + F.G - 1) / F.G - (c < nU ? (nU - c + F.G - 1) / F.G : 0)) * CQ_PER_ROUND); }
                if (l == 0) { RETID_(F); cq_run(F, 1 << 30, CQ_X1 + CQ_W2L0); }
            }
            if constexpr (!MERGE) SEAM(pb + 8);
            if (EN(11) && IN(pb + 9)) {
                pg8::Gemm g{ACT, (const bf16*)(F.ws + WS_W2) + (size_t)l * NEXP * 1024 * 1024, NR_MAX, 1024, 1024}; const int c2 = MERGE ? (MOE_C((int)blockIdx.x) + F.G - (ntiles * 8) % F.G) % F.G : MOE_C((int)blockIdx.x);
                pg8::MoeOrder S{TM + 1, ntiles, 4, F.G, c2};
                pg8::EpiY E{YB, inp(I_B2) + (size_t)l * NEXP * 1024};
                if constexpr (MERGE) { pg8::MoeOrderWait SW{{TM + 1, ntiles, 4, F.G, c2}, (unsigned*)(F.ctl + CW_TILE + l * 512)};
                    pg8::gemm_phase<pg8::EpiY, pg8::MoeOrderWait, true, GEMM_SP2>(F.lds + RING_OFF, g, SW, E, F.tid); }
                else for (int rep = 0; rep < REPS(11); ++rep) pg8::gemm_phase<pg8::EpiY, pg8::MoeOrder, true, GEMM_SP2>(F.lds + RING_OFF, g, S, E, F.tid);
                if (l == 0) { const int nU = ntiles * 4, c = MOE_C((int)blockIdx.x); RETID_(F); cq_run(F, ((nU + F.G - 1) / F.G - (c < nU ? (nU - c + F.G - 1) / F.G : 0)) * CQ_PER_ROUND); }
            }
        }
        SEAM(pb + 9);
        if (EN(12) && IN(pb + 10)) { p_combine(F, l, l + 1 < NL); if (l == 0) { __syncthreads(); RETID_(F); cq_run(F, 1 << 30, CQ_X1 + CQ_W2L0 + TI_DENSE); } } SEAM(pb + 10);
}
__global__ void __launch_bounds__(NWAVES * 64, 2) mk_fwd(Args args) {
    extern __shared__ __attribute__((aligned(16))) unsigned char lds[];
    Frame F;
    F.lds = (LAS unsigned char*)lds;
    F.MISC = (volatile LAS unsigned*)(F.lds + MISC_OFF);
    F.tid = threadIdx.x; F.lane = F.tid & 63; F.wave = __builtin_amdgcn_readfirstlane(F.tid >> 6);
    F.G = gridDim.x; { const int bx = blockIdx.x; F.vcu = XCDMAP_VCU(bx, F.G); }
    F.out = args.out; F.ws = args.ws;
    F.ctl = (gu32*)(args.ws + WS_CTL);
    for (int u = F.tid; u < (LDS_BYTES - LDSCTL_OFF) / 4; u += NWAVES * 64) ((LAS unsigned*)(F.lds + LDSCTL_OFF))[u] = 0u;
    __syncthreads();
    const bool one = (args.ph_hi - args.ph_lo) > 1;
    XcdBarrier bar; bar.bar = (unsigned*)(F.ctl + CW_BAR); bar.x = 0; bar.st = nullptr;
    if (one) bar = xcd_barrier_post((unsigned*)(F.ctl + CW_BAR), F.MISC + 8);
    const int lo = args.ph_lo, hi = args.ph_hi;
    if (EN(0) && IN(0)) { for (int rep = 0; rep < REPS(0); ++rep) { p0_prologue(F); __syncthreads(); } } SEAM(0);
    if (EN(1) && IN(1)) { p_norm_in(F, 0, inp(I_X)); } SEAM(1);
    layer_phases<0>(F, bar, lo, hi, lds);
    layer_phases<1>(F, bar, lo, hi, lds);
#undef IN
#undef SEAM
#undef H
#undef PROJ
#undef BRB
#undef MERGED
#undef XS
#undef ACT
#undef YB
}

extern "C" void kernel_launch(void* const* d_in, const int* in_sizes, int n_in, void* d_out, int out_size, void* d_ws, size_t ws_size, hipStream_t stream) {
    static int grid = 0;
    if (grid == 0) {
        if (n_in != 30 || in_sizes[0] != T * D || out_size != T * D || ws_size < WS_END) { fprintf(stderr, "kernel_launch: unexpected shapes (n_in %d, in0 %d, out %d, ws %zu); nothing launched\n", n_in, n_in > 0 ? in_sizes[0] : -1, out_size, ws_size); grid = -1; return; }
        int dev = 0, cus = 0, per_cu = 0;
        if (hipGetDevice(&dev) != hipSuccess || hipDeviceGetAttribute(&cus, hipDeviceAttributeMultiprocessorCount, dev) != hipSuccess) { grid = -1; return; }
        if (hipFuncSetAttribute((const void*)mk_fwd, hipFuncAttributeMaxDynamicSharedMemorySize, LDS_BYTES) != hipSuccess) { fprintf(stderr, "kernel_launch: hipFuncSetAttribute failed\n"); grid = -1; return; }
        if (hipOccupancyMaxActiveBlocksPerMultiprocessor(&per_cu, (const void*)mk_fwd, NWAVES * 64, LDS_BYTES) != hipSuccess || per_cu < 1) fprintf(stderr, "kernel_launch: occupancy query reports %d blocks per CU\n", per_cu);
        (void)hipGetLastError();
        grid = 256;
        if (cus != 256) fprintf(stderr, "kernel_launch: device has %d CUs; this kernel's static maps assume 256\n", cus);
    }
    if (grid < 0) return;
    if (hipMemsetAsync((char*)d_ws + WS_CTL, 0, CTL_ZERO_BYTES, stream) != hipSuccess) return;
    Args a{};
    for (int i = 0; i < 30; ++i) a.in[i] = (const float*)d_in[i];
    a.out = (float*)d_out; a.ws = (unsigned char*)d_ws;
#if MK_ONE_LAUNCH
    a.ph_lo = 0; a.ph_hi = N_PHASES; a.li = 0;
    hipLaunchKernelGGL(mk_fwd, dim3(grid), dim3(NWAVES * 64), LDS_BYTES, stream, a);
#else
    for (int p = 0; p < N_PHASES; ++p) { a.ph_lo = p; a.ph_hi = p + 1; a.li = p; hipLaunchKernelGGL(mk_fwd, dim3(grid), dim3(NWAVES * 64), LDS_BYTES, stream, a); }
#endif
}
```

```cpp
#include <hip/hip_runtime.h>
#include <hip/hip_bf16.h>
#include <cstdio>
#include <cstdint>
#include <cmath>
namespace pg8 {
#define PG8_LAS __attribute__((address_space(3)))
typedef unsigned short bf16_t;
typedef short bf16x8 __attribute__((ext_vector_type(8)));
typedef float f32x4 __attribute__((ext_vector_type(4)));
typedef unsigned u32x4 __attribute__((ext_vector_type(4)));
constexpr int BM = 256, BK = 64, HALF = 128, HTB = HALF * BK * 2  , STAGE_BYTES = 8 * HTB, NXCD = 8, WGM = 8;

__host__ __device__ __forceinline__ int lds_byte(int r, int c) { const int st = (r >> 4) * 2 + (c >> 5), rr = r & 15, cc = c & 31, ob = rr * 64 + cc * 2; return st * 1024 + (ob ^ (((ob >> 9) & 1) << 5)); }
__host__ __device__ __forceinline__ void stage_rc(int b, int& R, int& C) { const int st = b / 1024, sb = b % 1024, swz = sb ^ (((sb >> 9) & 1) << 5); R = (st >> 1) * 16 + swz / 64; C = (st & 1) * 32 + (swz % 64) / 2; }
__host__ __device__ __forceinline__ int perm32(int rho) { const int n = rho >> 4, i = rho & 15; return 8 * (i >> 2) + 4 * n + (i & 3); }

struct Unit { int pm, pn; };
struct Gemm { const bf16_t* A; const bf16_t* Bt; int M, N, K; };

struct StaticOrder {
    int nM, nN, nwg, G, c;
    __host__ __device__ void init(int M, int N, int G_, int c_) { nM = M / BM; nN = N / BM; nwg = nM * nN; G = G_; c = c_; }
    __host__ __device__ bool next(int i, Unit& u) const {
        const long L = (long)i * G + c; if (L >= nwg) return false;
        int wgid = (int)L; { const int q = nwg / NXCD, r = nwg % NXCD, xcd = wgid % NXCD, off = wgid / NXCD; wgid = (xcd < r ? xcd * (q + 1) : r * (q + 1) + (xcd - r) * q) + off; }
        const int nig = WGM * nN, gid = wgid / nig, fm = gid * WGM, gsz = (nM - fm) < WGM ? (nM - fm) : WGM;
        u.pm = fm + ((wgid % nig) % gsz); u.pn = (wgid % nig) / gsz; return true;
    }
    __device__ __forceinline__ void a_ready(const Unit&) const {}
    __device__ __forceinline__ void done(const Unit&) const {}
};

__device__ __forceinline__ unsigned cvt_pk_bf16(float lo, float hi) { unsigned r; asm volatile("v_cvt_pk_bf16_f32 %0, %1, %2" : "=v"(r) : "v"(lo), "v"(hi)); return r; }
typedef float f32x2 __attribute__((ext_vector_type(2)));
__device__ __forceinline__ f32x2 gelu_pk(f32x2 v) {
    const f32x2 av = __builtin_elementwise_abs(v), d = av * 0.2316418882f + 1.0f;
    f32x2 t; t.x = __builtin_amdgcn_rcpf(d.x); t.y = __builtin_amdgcn_rcpf(d.y);
    f32x2 q = t * 0.5307027145f + (-0.7265760135f); q = q * t + 0.7107068705f; q = q * t + (-0.142248368f); q = q * t + 0.127414796f; q = q * t;
    const f32x2 s = (v * v) * (-0.72134752044f);
    f32x2 e; e.x = __builtin_amdgcn_exp2f(s.x); e.y = __builtin_amdgcn_exp2f(s.y);
    const f32x2 m = v * (q * e), r = v - m;
    f32x2 o; o.x = v.x < 0.f ? m.x : r.x; o.y = v.y < 0.f ? m.y : r.y; return o;
}

template <int ACT  > struct EpiBf16 {
    static constexpr bool PERM = true, AFTER_DRAIN = false; static_assert(ACT == 0 || ACT == 1, "EpiBf16: ACT is 0 (none) or 1 (gelu_pk)");
    bf16_t* O; int ldc; const float* bias; int split_cols; size_t split_stride; float scale0;
    __device__ __forceinline__ void operator()(const f32x4 (&acc)[2][2][4][2], const Unit& u, int wr, int wc, int fr, int fq) const {
        const int row0 = u.pm * BM + wr * 64 + fr; int colt = u.pn * BM; bf16_t* base = O;
        float sc = 1.f; if (split_cols) { const int t = colt / split_cols; base += (size_t)t * split_stride; colt -= t * split_cols; if (t == 0) sc = scale0; }
        const int col0 = colt + wc * 32 + 8 * fq, bcol0 = u.pn * BM + wc * 32 + 8 * fq;
        f32x4 bv[2][2];
#pragma unroll
        for (int bj = 0; bj < 2; ++bj)
#pragma unroll
            for (int n = 0; n < 2; ++n) bv[bj][n] = bias ? *(const f32x4*)(bias + bcol0 + bj * HALF + 4 * n) : (f32x4){0.f, 0.f, 0.f, 0.f};
#pragma unroll
        for (int ai = 0; ai < 2; ++ai)
#pragma unroll
            for (int m = 0; m < 4; ++m) { bf16_t* rowp = base + (size_t)(row0 + ai * HALF + m * 16) * ldc + col0;
#pragma unroll
                for (int bj = 0; bj < 2; ++bj) { f32x4 v0 = acc[ai][bj][m][0] + bv[bj][0], v1 = acc[ai][bj][m][1] + bv[bj][1];
                    if (ACT == 1) { f32x2 a = gelu_pk((f32x2){v0[0], v0[1]}), b = gelu_pk((f32x2){v0[2], v0[3]}), c = gelu_pk((f32x2){v1[0], v1[1]}), d = gelu_pk((f32x2){v1[2], v1[3]});
                        v0 = (f32x4){a.x, a.y, b.x, b.y}; v1 = (f32x4){c.x, c.y, d.x, d.y}; }
                    v0 = v0 * sc; v1 = v1 * sc; u32x4 w; w.x = cvt_pk_bf16(v0[0], v0[1]); w.y = cvt_pk_bf16(v0[2], v0[3]); w.z = cvt_pk_bf16(v1[0], v1[1]); w.w = cvt_pk_bf16(v1[2], v1[3]);
                    *(u32x4*)(rowp + bj * HALF) = w; } }
    }
};

__device__ __forceinline__ float bf_lo(unsigned w) { return __uint_as_float(w << 16); }
__device__ __forceinline__ float bf_hi(unsigned w) { return __uint_as_float(w & 0xffff0000u); }
__device__ __forceinline__ float fast_sigmoid(float v) { return __builtin_amdgcn_rcpf(1.0f + __builtin_amdgcn_exp2f(-1.4426950408889634f * v)); }

struct EpiIn {
    static constexpr bool PERM = true, AFTER_DRAIN = false;
    bf16_t* O; int ldc; int gate_pn0; bf16_t* QKV; const float* gq; const float* gk; const float* gsq; const float* gsk; PG8_LAS float* xq; float qscale, eps;
    struct Pre {}; __device__ __forceinline__ void prefetch(Pre&, const Unit&, int, int, int, int) const {}
    __device__ __forceinline__ void operator()(const f32x4 (&acc)[2][2][4][2], const Unit& u, int wr, int wc, int fr, int fq, const Pre&) const {
        const int pn = u.pn, row0 = u.pm * BM + wr * 64 + fr, col0 = pn * BM + wc * 32 + 8 * fq; const bool gate = pn >= gate_pn0;
        const bool nrm = (pn >= 4 && pn <= 7) || (pn >= 10 && pn <= 12);
        if (!nrm) {
#pragma unroll
            for (int ai = 0; ai < 2; ++ai)
#pragma unroll
                for (int m = 0; m < 4; ++m) { const size_t rr = (size_t)(row0 + ai * HALF + m * 16); bf16_t* rowp = (pn == 8 || pn == 9) ? QKV + (size_t)2 * 16384 * 512 + rr * 512 + (col0 - 2048) : O + rr * ldc + col0;
#pragma unroll
                    for (int bj = 0; bj < 2; ++bj) { f32x4 v0 = acc[ai][bj][m][0], v1 = acc[ai][bj][m][1];
                        if (gate) {
#pragma unroll
                            for (int e = 0; e < 4; ++e) { v0[e] = fast_sigmoid(v0[e]); v1[e] = fast_sigmoid(v1[e]); } }
                        u32x4 w; w.x = cvt_pk_bf16(v0[0], v0[1]); w.y = cvt_pk_bf16(v0[2], v0[3]); w.z = cvt_pk_bf16(v1[0], v1[1]); w.w = cvt_pk_bf16(v1[2], v1[3]);
                        *(u32x4*)(rowp + bj * HALF) = w; } }
            return;
        }
        const int wid = wr * 4 + wc;
#pragma unroll
        for (int ai = 0; ai < 2; ++ai)
#pragma unroll
            for (int m = 0; m < 4; ++m)
#pragma unroll
                for (int bj = 0; bj < 2; ++bj) { const f32x4 v0 = acc[ai][bj][m][0], v1 = acc[ai][bj][m][1];
                    float s = (v0[0] * v0[0] + v0[1] * v0[1]) + (v0[2] * v0[2] + v0[3] * v0[3]) + (v1[0] * v1[0] + v1[1] * v1[1]) + (v1[2] * v1[2] + v1[3] * v1[3]);
                    s += __shfl_xor(s, 16); s += __shfl_xor(s, 32);
                    if (fq == 0) xq[(((wid * 2 + ai) * 4 + m) * 2 + bj) * 16 + fr] = s; }
        asm volatile("s_waitcnt lgkmcnt(0)" ::: "memory"); __builtin_amdgcn_s_barrier(); asm volatile("" ::: "memory");
        const float sc = (pn <= 5 || pn == 10 || pn == 11) ? qscale : 1.0f; const int go = 32 * (wc & 1) + 8 * fq;
        const float* gp;
        { const float* p0 = gq; const float* p1 = gk; const float* p2 = gsq; const float* p3 = gsk;
          asm volatile("" : "+s"(p0)); asm volatile("" : "+s"(p1)); asm volatile("" : "+s"(p2)); asm volatile("" : "+s"(p3));
          gp = pn <= 5 ? p0 : (pn <= 7 ? p1 : (pn <= 11 ? p2 : p3)); }
        const f32x4 g0 = *(const f32x4*)(gp + go), g1 = *(const f32x4*)(gp + go + 4);
#pragma unroll
        for (int ai = 0; ai < 2; ++ai)
#pragma unroll
            for (int m = 0; m < 4; ++m) { const size_t rr = (size_t)(row0 + ai * HALF + m * 16);
                bf16_t* rowp = pn <= 5 ? QKV + rr * 512 + (col0 - 1024) : (pn <= 7 ? QKV + (size_t)16384 * 512 + rr * 512 + (col0 - 1536) : O + rr * ldc + col0);
#pragma unroll
                for (int bj = 0; bj < 2; ++bj) { f32x4 v0 = acc[ai][bj][m][0], v1 = acc[ai][bj][m][1];
                    if (!(pn == 12 && bj == 1)) { const float tot = xq[(((wid * 2 + ai) * 4 + m) * 2 + bj) * 16 + fr] + xq[((((wid ^ 1) * 2 + ai) * 4 + m) * 2 + bj) * 16 + fr];
                        const float r = sc / sqrtf(tot * (1.0f / 64.0f) + eps); v0 = v0 * r * g0; v1 = v1 * r * g1; }
                    u32x4 w; w.x = cvt_pk_bf16(v0[0], v0[1]); w.y = cvt_pk_bf16(v0[2], v0[3]); w.z = cvt_pk_bf16(v1[0], v1[1]); w.w = cvt_pk_bf16(v1[2], v1[3]);
                    *(u32x4*)(rowp + bj * HALF) = w; } }
    }
};
struct EpiBranch {
    static constexpr bool PERM = true, AFTER_DRAIN = false;
    bf16_t* MG; const bf16_t* PROJ; int ldp;
    struct Pre {}; __device__ __forceinline__ void prefetch(Pre&, const Unit&, int, int, int, int) const {}
    __device__ __forceinline__ void operator()(const f32x4 (&acc)[2][2][4][2], const Unit& u, int wr, int wc, int fr, int fq, const Pre&) const {
        const int n = u.pm >> 6, pm = u.pm & 63, pn = u.pn & 3;
        const int row0 = pm * BM + wr * 64 + fr, col0 = pn * BM + wc * 32 + 8 * fq;
#pragma unroll
        for (int ai = 0; ai < 2; ++ai) {
            u32x4 gq[4][2], oq[4][2];
#pragma unroll
            for (int m = 0; m < 4; ++m) { const size_t row = (size_t)(row0 + ai * HALF + m * 16);
#pragma unroll
                for (int bj = 0; bj < 2; ++bj) { gq[m][bj] = *(const u32x4*)(PROJ + row * ldp + 3328 + n * 1024 + col0 + bj * HALF);
                    if (n > 0) oq[m][bj] = *(const u32x4*)(MG + row * 1024 + col0 + bj * HALF); } }
#pragma unroll
            for (int m = 0; m < 4; ++m) { const size_t row = (size_t)(row0 + ai * HALF + m * 16);
#pragma unroll
                for (int bj = 0; bj < 2; ++bj) {
                    const u32x4 g = gq[m][bj];
                    bf16_t* mp = MG + row * 1024 + col0 + bj * HALF;
                    f32x4 v0 = acc[ai][bj][m][0], v1 = acc[ai][bj][m][1];
                    v0[0] *= bf_lo(g.x); v0[1] *= bf_hi(g.x); v0[2] *= bf_lo(g.y); v0[3] *= bf_hi(g.y);
                    v1[0] *= bf_lo(g.z); v1[1] *= bf_hi(g.z); v1[2] *= bf_lo(g.w); v1[3] *= bf_hi(g.w);
                    if (n > 0) { const u32x4 o = oq[m][bj];
                        v0[0] += bf_lo(o.x); v0[1] += bf_hi(o.x); v0[2] += bf_lo(o.y); v0[3] += bf_hi(o.y);
                        v1[0] += bf_lo(o.z); v1[1] += bf_hi(o.z); v1[2] += bf_lo(o.w); v1[3] += bf_hi(o.w); }
                    u32x4 w; w.x = cvt_pk_bf16(v0[0], v0[1]); w.y = cvt_pk_bf16(v0[2], v0[3]); w.z = cvt_pk_bf16(v1[0], v1[1]); w.w = cvt_pk_bf16(v1[2], v1[3]);
                    *(u32x4*)mp = w; } } }
    }
};
template <bool IN_BF16> struct EpiOutT {
    static constexpr bool PERM = true, AFTER_DRAIN = false;
    const void* xin; bf16_t* xout; const float* gm;
    struct Pre { f32x4 gv[2][2]; };
    __device__ __forceinline__ void prefetch(Pre& P, const Unit& u, int wr, int wc, int fr, int fq) const { const int col0 = u.pn * BM + wc * 32 + 8 * fq; const int b = (u.pm * BM) >> 13;
#pragma unroll
        for (int bj = 0; bj < 2; ++bj)
#pragma unroll
            for (int n = 0; n < 2; ++n) P.gv[bj][n] = *(const f32x4*)(gm + (size_t)b * 6144 + col0 + bj * HALF + 4 * n); }
    __device__ __forceinline__ void operator()(const f32x4 (&acc)[2][2][4][2], const Unit& u, int wr, int wc, int fr, int fq, const Pre& P) const {
        const int row0 = u.pm * BM + wr * 64 + fr, col0 = u.pn * BM + wc * 32 + 8 * fq;
        const f32x4 (&gv)[2][2] = P.gv;
#pragma unroll
        for (int ai = 0; ai < 2; ++ai) {
            f32x4 xq[4][2][2]; u32x4 xb[4][2];
#pragma unroll
            for (int m = 0; m < 4; ++m) { const size_t off = (size_t)(row0 + ai * HALF + m * 16) * 1024 + col0;
#pragma unroll
                for (int bj = 0; bj < 2; ++bj) {
                    if constexpr (IN_BF16) xb[m][bj] = *(const u32x4*)((const bf16_t*)xin + off + bj * HALF);
                    else { xq[m][bj][0] = *(const f32x4*)((const float*)xin + off + bj * HALF); xq[m][bj][1] = *(const f32x4*)((const float*)xin + off + bj * HALF + 4); } } }
#pragma unroll
            for (int m = 0; m < 4; ++m) { const size_t off = (size_t)(row0 + ai * HALF + m * 16) * 1024 + col0;
#pragma unroll
                for (int bj = 0; bj < 2; ++bj) { f32x4 x0, x1;
                    if constexpr (IN_BF16) { const u32x4 w = xb[m][bj]; x0 = (f32x4){bf_lo(w.x), bf_hi(w.x), bf_lo(w.y), bf_hi(w.y)}; x1 = (f32x4){bf_lo(w.z), bf_hi(w.z), bf_lo(w.w), bf_hi(w.w)}; }
                    else { x0 = xq[m][bj][0]; x1 = xq[m][bj][1]; }
                    const f32x4 v0 = x0 + gv[bj][0] * acc[ai][bj][m][0], v1 = x1 + gv[bj][1] * acc[ai][bj][m][1];
                    u32x4 w; w.x = cvt_pk_bf16(v0[0], v0[1]); w.y = cvt_pk_bf16(v0[2], v0[3]); w.z = cvt_pk_bf16(v1[0], v1[1]); w.w = cvt_pk_bf16(v1[2], v1[3]);
                    *(u32x4*)(xout + off + bj * HALF) = w; } } }
    }
};
template <bool WT> struct EpiGluT {
    static constexpr bool PERM = true, AFTER_DRAIN = false;
    bf16_t* ACT; const float* b1;
    struct Pre { f32x4 bv[2][2]; };
    __device__ __forceinline__ void prefetch(Pre& P, const Unit& u, int wr, int wc, int fr, int fq) const { const int e = u.pn >> 3, pn = u.pn & 7, hc0 = pn * BM + wc * 32 + 8 * fq;
#pragma unroll
        for (int bj = 0; bj < 2; ++bj)
#pragma unroll
            for (int n = 0; n < 2; ++n) P.bv[bj][n] = *(const f32x4*)(b1 + (size_t)e * 2048 + hc0 + bj * HALF + 4 * n); }
    __device__ __forceinline__ void operator()(const f32x4 (&acc)[2][2][4][2], const Unit& u, int wr, int wc, int fr, int fq, const Pre& P) const {
        const int pn = u.pn & 7;
        const int row0 = u.pm * BM + wr * 64 + fr, ac0 = pn * 128 + wc * 16 + 4 * fq;
        const f32x4 (&bv)[2][2] = P.bv;
#pragma unroll
        for (int ai = 0; ai < 2; ++ai)
#pragma unroll
            for (int m = 0; m < 4; ++m) { bf16_t* rowp = ACT + (size_t)(row0 + ai * HALF + m * 16) * 1024 + ac0;
#pragma unroll
                for (int bj = 0; bj < 2; ++bj) { const f32x4 v0 = acc[ai][bj][m][0] + bv[bj][0], v1 = acc[ai][bj][m][1] + bv[bj][1];
                    float a[4];
#pragma unroll
                    for (int p = 0; p < 4; ++p) { const float gl = p < 2 ? v0[2 * p] : v1[2 * p - 4], ln = p < 2 ? v0[2 * p + 1] : v1[2 * p - 3];
                        const float xg = fminf(gl, 7.0f), xl = fminf(fmaxf(ln, -7.0f), 7.0f);
                        a[p] = xg * __builtin_amdgcn_rcpf(1.0f + __builtin_amdgcn_exp2f(-2.4554669595930157f * xg)) * (xl + 1.0f); }
                    typedef unsigned u32x2 __attribute__((ext_vector_type(2)));
                    u32x2 w; w.x = cvt_pk_bf16(a[0], a[1]); w.y = cvt_pk_bf16(a[2], a[3]);
                    if constexpr (WT) __hip_atomic_store((unsigned long long*)(rowp + bj * 64), (unsigned long long)w.x | ((unsigned long long)w.y << 32), __ATOMIC_RELAXED, __HIP_MEMORY_SCOPE_AGENT);
                    else *(u32x2*)(rowp + bj * 64) = w; } }
    }
};
using EpiGlu = EpiGluT<false>;
struct EpiY {
    static constexpr bool PERM = true, AFTER_DRAIN = false;
    bf16_t* Y; const float* b2;
    struct Pre { f32x4 bv[2][2]; };
    __device__ __forceinline__ void prefetch(Pre& P, const Unit& u, int wr, int wc, int fr, int fq) const { const int e = u.pn >> 2, pn = u.pn & 3, col0 = pn * BM + wc * 32 + 8 * fq;
#pragma unroll
        for (int bj = 0; bj < 2; ++bj)
#pragma unroll
            for (int n = 0; n < 2; ++n) P.bv[bj][n] = *(const f32x4*)(b2 + (size_t)e * 1024 + col0 + bj * HALF + 4 * n); }
    __device__ __forceinline__ void operator()(const f32x4 (&acc)[2][2][4][2], const Unit& u, int wr, int wc, int fr, int fq, const Pre& P) const {
        const int pn = u.pn & 3;
        const int row0 = u.pm * BM + wr * 64 + fr, col0 = pn * BM + wc * 32 + 8 * fq;
        const f32x4 (&bv)[2][2] = P.bv;
#pragma unroll
        for (int ai = 0; ai < 2; ++ai)
#pragma unroll
            for (int m = 0; m < 4; ++m) { bf16_t* rowp = Y + (size_t)(row0 + ai * HALF + m * 16) * 1024 + col0;
#pragma unroll
                for (int bj = 0; bj < 2; ++bj) { const f32x4 v0 = acc[ai][bj][m][0] + bv[bj][0], v1 = acc[ai][bj][m][1] + bv[bj][1];
                    u32x4 w; w.x = cvt_pk_bf16(v0[0], v0[1]); w.y = cvt_pk_bf16(v0[2], v0[3]); w.z = cvt_pk_bf16(v1[0], v1[1]); w.w = cvt_pk_bf16(v1[2], v1[3]);
                    *(u32x4*)(rowp + bj * HALF) = w; } }
    }
};
struct BranchOrder {
    StaticOrder so;
    __device__ void init(int M, int G_, int c_) { so.init(M, 1024, G_, c_); }
    __device__ bool next(int i, Unit& u) const { const int r = i / 3, n = i - 3 * r; Unit t; if (!so.next(r, t)) return false; u.pm = n * 64 + t.pm; u.pn = n * 4 + t.pn; return true; }
    __device__ __forceinline__ void a_ready(const Unit&) const {}
    __device__ __forceinline__ void done(const Unit&) const {}
};
struct MoeOrder {
    const PG8_LAS int* tmap; int ntiles, npn, G, c;
    __device__ bool next(int i, Unit& u) const {
        const int L = i * G + c; if (L >= ntiles * npn) return false;
        const int j = L / npn, pn = L - j * npn; const int e = __builtin_amdgcn_readfirstlane(tmap[j]);
        u.pm = j; u.pn = e * npn + pn; return true; }
    __device__ __forceinline__ void a_ready(const Unit&) const {}
    __device__ __forceinline__ void done(const Unit&) const {}
};
struct MoeOrderSig : MoeOrder { unsigned* cnt;
    __device__ __forceinline__ void done(const Unit& u) const {
        asm volatile("s_waitcnt vmcnt(0)" ::: "memory");
        if (__builtin_amdgcn_mbcnt_hi(~0u, __builtin_amdgcn_mbcnt_lo(~0u, 0u)) == 0u) __hip_atomic_fetch_add(cnt + u.pm, 1u, __ATOMIC_RELAXED, __HIP_MEMORY_SCOPE_AGENT); } };
struct MoeOrderWait : MoeOrder { unsigned* cnt;
    __device__ __forceinline__ void a_ready(const Unit& u) const {
        while (__hip_atomic_load(cnt + u.pm, __ATOMIC_RELAXED, __HIP_MEMORY_SCOPE_AGENT) < 64u) __builtin_amdgcn_s_sleep(8);
        asm volatile("" ::: "memory"); } };
struct MoeOrderX {
    const PG8_LAS int* tm; int npn, xcd, cx;
    __device__ bool next(int i, Unit& u) const {
        int L = i * 32 + cx; const int cnt = __builtin_amdgcn_readfirstlane(tm[448 + xcd]);
        for (int q = 0; q < cnt; ++q) { const int e = __builtin_amdgcn_readfirstlane(tm[384 + xcd * 8 + q]); const int n = __builtin_amdgcn_readfirstlane(tm[352 + e]) * npn;
            if (L < n) { const int jt = L / npn, pn = L - jt * npn; u.pm = __builtin_amdgcn_readfirstlane(tm[320 + e]) + jt; u.pn = e * npn + pn; return true; }
            L -= n; }
        return false; }
    __device__ __forceinline__ void a_ready(const Unit&) const {}
    __device__ __forceinline__ void done(const Unit&) const {}
};

template <class Epi, class Sched, bool ALIGN_EPI = false, bool SP2 = false, bool GATHER = false>
__device__ __forceinline__ void gemm_phase(PG8_LAS unsigned char* lds, const Gemm g, const Sched& S, const Epi& E, const int tid, const PG8_LAS unsigned* rowoff = nullptr) {
    static_assert(!GATHER || SP2, "GATHER is implemented for the SP2 loop");
    const int wid = __builtin_amdgcn_readfirstlane(tid >> 6), lane = tid & 63, wr = wid >> 2, wc = wid & 3, fr = lane & 15, fq = lane >> 4;
    const int K = g.K, nt = K / BK;
    unsigned voffA[2], voffB[2];
#pragma unroll
    for (int i = 0; i < 2; ++i) { int R, C; stage_rc(tid * 16 + i * 8192, R, C); const int Rb = Epi::PERM ? ((R & ~31) + perm32(R & 31)) : R;
        voffA[i] = (unsigned)(R * K + C) * 2u; voffB[i] = (unsigned)(Rb * K + C) * 2u; }
    unsigned vAc[2][2], vAn[2][2]; int gR[2]; unsigned gC[2];
    if constexpr (GATHER) {
#pragma unroll
        for (int i = 0; i < 2; ++i) { int R, C; stage_rc(tid * 16 + i * 8192, R, C); gR[i] = R; gC[i] = (unsigned)C * 2u; }
#pragma unroll
        for (int h = 0; h < 2; ++h)
#pragma unroll
            for (int i = 0; i < 2; ++i) { vAc[h][i] = rowoff[h * HALF + gR[i]] + gC[i]; vAn[h][i] = vAc[h][i]; } }
    const size_t kstep = (size_t)(BK * 2);
    const size_t hstep = (size_t)HALF * K * 2;
    const size_t tstep = 2 * hstep;
    const unsigned ldsw = (unsigned)wid * 1024u;
    const int aoff = lds_byte(wr * 64 + fr, fq * 8), boff = lds_byte(wc * 32 + fr, fq * 8);
#define PG8_SA(b, h) (((b) * 2 + (h)) * HTB)
#define PG8_SB(b, h) ((4 + (b) * 2 + (h)) * HTB)
#define PG8_STAGE(bufoff, gbase, voff) do { _Pragma("unroll") for (int _i = 0; _i < 2; ++_i) \
        __builtin_amdgcn_global_load_lds((const unsigned*)((const char*)(gbase) + (voff)[_i]), (PG8_LAS unsigned*)(lds + (bufoff) + ldsw + _i * 8192), 16, 0, 0); } while (0)
#define PG8_LDA(dst, b, h) do { _Pragma("unroll") for (int m = 0; m < 4; ++m) _Pragma("unroll") for (int k = 0; k < 2; ++k) dst[m][k] = *(const PG8_LAS bf16x8*)(lds + PG8_SA(b, h) + aoff + m * 2048 + k * 1024); } while (0)
#define PG8_LDB(dst, b, h) do { _Pragma("unroll") for (int n = 0; n < 2; ++n) _Pragma("unroll") for (int k = 0; k < 2; ++k) dst[n][k] = *(const PG8_LAS bf16x8*)(lds + PG8_SB(b, h) + boff + n * 2048 + k * 1024); } while (0)
#define PG8_MMA(ai, bj, At, Bt) do { __builtin_amdgcn_s_setprio(1); _Pragma("unroll") for (int m = 0; m < 4; ++m) _Pragma("unroll") for (int n = 0; n < 2; ++n) _Pragma("unroll") for (int k = 0; k < 2; ++k) \
        acc[ai][bj][m][n] = __builtin_amdgcn_mfma_f32_16x16x32_bf16(Bt[n][k], At[m][k], acc[ai][bj][m][n], 0, 0, 0); __builtin_amdgcn_s_setprio(0); } while (0)
#define PG8_WAIT_V(n) asm volatile("s_waitcnt vmcnt(" #n ")" ::: "memory")
#define PG8_WAIT_L(n) asm volatile("s_waitcnt lgkmcnt(" #n ")" ::: "memory")
#define PG8_BAR __builtin_amdgcn_s_barrier()
#define PG8_SCHED __builtin_amdgcn_sched_barrier(0)
    Unit cur, nxt; int ui = 0;
    if (!S.next(0, cur)) return;
    f32x4 acc[2][2][4][2];
#pragma unroll
    for (int a = 0; a < 2; ++a)
#pragma unroll
        for (int b = 0; b < 2; ++b)
#pragma unroll
            for (int m = 0; m < 4; ++m)
#pragma unroll
                for (int n = 0; n < 2; ++n) acc[a][b][m][n] = (f32x4){0.f, 0.f, 0.f, 0.f};
    bf16x8 At[4][2], B0[2][2], B1[2][2];
    const char* cA = (const char*)g.A + (GATHER ? (size_t)0 : (size_t)cur.pm * tstep); const char* cB = (const char*)g.Bt + (size_t)cur.pn * tstep;
    S.a_ready(cur);
    if constexpr (SP2) {
        PG8_STAGE(PG8_SB(0, 0), cB, voffB); PG8_STAGE(PG8_SB(0, 1), cB + hstep, voffB);
        if constexpr (GATHER) { PG8_STAGE(PG8_SA(0, 0), cA, vAc[0]); PG8_STAGE(PG8_SA(0, 1), cA, vAc[1]); } else { PG8_STAGE(PG8_SA(0, 0), cA, voffA); PG8_STAGE(PG8_SA(0, 1), cA + hstep, voffA); }
        if (wr == 1) PG8_BAR;
        PG8_WAIT_V(2); PG8_BAR;
        PG8_STAGE(PG8_SB(1, 0), cB + kstep, voffB); if constexpr (GATHER) { PG8_STAGE(PG8_SA(1, 0), cA + kstep, vAc[0]); } else { PG8_STAGE(PG8_SA(1, 0), cA + kstep, voffA); } PG8_STAGE(PG8_SB(1, 1), cB + hstep + kstep, voffB);
        PG8_WAIT_V(6); PG8_BAR;
    } else {
        PG8_STAGE(PG8_SB(0, 0), cB, voffB); PG8_STAGE(PG8_SA(0, 0), cA, voffA); PG8_STAGE(PG8_SB(0, 1), cB + hstep, voffB); PG8_STAGE(PG8_SA(0, 1), cA + hstep, voffA);
        if (wr == 1) PG8_BAR;
        PG8_WAIT_V(4); PG8_BAR;
        PG8_STAGE(PG8_SB(1, 0), cB + kstep, voffB); PG8_STAGE(PG8_SA(1, 0), cA + kstep, voffA); PG8_STAGE(PG8_SB(1, 1), cB + hstep + kstep, voffB);
        PG8_WAIT_V(6); PG8_BAR;
    }
    for (;;) {
        const bool has_next = S.next(ui + 1, nxt);
        typename Epi::Pre epre; E.prefetch(epre, cur, wr, wc, fr, fq);
        const char* nA = (has_next && !GATHER) ? (const char*)g.A + (size_t)nxt.pm * tstep : cA;
        if constexpr (GATHER) { if (has_next) {
#pragma unroll
            for (int h = 0; h < 2; ++h)
#pragma unroll
                for (int i = 0; i < 2; ++i) vAn[h][i] = rowoff[(ui + 1) * BM + h * HALF + gR[i]] + gC[i]; } } const char* nB = has_next ? (const char*)g.Bt + (size_t)nxt.pn * tstep : cB;
        for (int t = 0; t < nt; t += 2) {
            const bool last = (t == nt - 2);
            const char* a1 = cA + (size_t)(t + 1) * kstep;
            const char* a2 = last ? nA : cA + (size_t)(t + 2) * kstep; const char* b2 = last ? nB : cB + (size_t)(t + 2) * kstep;
            const char* a3 = a2 + kstep; const char* b3 = b2 + kstep;
            if (last && has_next) S.a_ready(nxt);
            if constexpr (SP2) {
            unsigned s0_[2], s1_[2];
            if constexpr (GATHER) { s0_[0] = last ? vAn[0][0] : vAc[0][0]; s0_[1] = last ? vAn[0][1] : vAc[0][1]; s1_[0] = last ? vAn[1][0] : vAc[1][0]; s1_[1] = last ? vAn[1][1] : vAc[1][1]; }
            PG8_LDB(B0, 0, 0); PG8_LDB(B1, 0, 1); PG8_SCHED; PG8_LDA(At, 0, 0); if constexpr (GATHER) { PG8_STAGE(PG8_SA(1, 1), a1, vAc[1]); } else { PG8_STAGE(PG8_SA(1, 1), a1 + hstep, voffA); }
            PG8_WAIT_V(8); PG8_WAIT_L(0); PG8_BAR; PG8_MMA(0, 0, At, B0); PG8_MMA(0, 1, At, B1); PG8_BAR; PG8_SCHED;
            PG8_LDA(At, 0, 1); PG8_STAGE(PG8_SB(0, 0), b2, voffB); PG8_STAGE(PG8_SB(0, 1), b2 + hstep, voffB); if constexpr (GATHER) { PG8_STAGE(PG8_SA(0, 0), a2, s0_); } else { PG8_STAGE(PG8_SA(0, 0), a2, voffA); }
            PG8_WAIT_V(8); PG8_WAIT_L(0); PG8_BAR; PG8_MMA(1, 0, At, B0); PG8_MMA(1, 1, At, B1); PG8_BAR; PG8_SCHED;
            PG8_LDB(B0, 1, 0); PG8_LDB(B1, 1, 1); PG8_SCHED; PG8_LDA(At, 1, 0); if constexpr (GATHER) { PG8_STAGE(PG8_SA(0, 1), a2, s1_); } else { PG8_STAGE(PG8_SA(0, 1), a2 + hstep, voffA); }
            PG8_WAIT_V(8); PG8_WAIT_L(0); PG8_BAR; PG8_MMA(0, 0, At, B0); PG8_MMA(0, 1, At, B1); PG8_BAR; PG8_SCHED;
            PG8_LDA(At, 1, 1); PG8_STAGE(PG8_SB(1, 0), b3, voffB); PG8_STAGE(PG8_SB(1, 1), b3 + hstep, voffB); if constexpr (GATHER) { PG8_STAGE(PG8_SA(1, 0), a3, s0_); } else { PG8_STAGE(PG8_SA(1, 0), a3, voffA); }
            PG8_WAIT_V(8); PG8_WAIT_L(0); PG8_BAR; PG8_MMA(1, 0, At, B0); PG8_MMA(1, 1, At, B1); PG8_BAR; PG8_SCHED;
            } else {
            PG8_LDB(B0, 0, 0); PG8_SCHED; PG8_LDA(At, 0, 0); PG8_STAGE(PG8_SA(1, 1), a1 + hstep, voffA);
            PG8_WAIT_L(8); PG8_BAR; PG8_WAIT_L(0); PG8_MMA(0, 0, At, B0); PG8_BAR; PG8_SCHED;
            PG8_LDB(B1, 0, 1); PG8_STAGE(PG8_SB(0, 0), b2, voffB);
            PG8_BAR; PG8_WAIT_L(0); PG8_MMA(0, 1, At, B1); PG8_BAR;
            PG8_LDA(At, 0, 1); PG8_STAGE(PG8_SA(0, 0), a2, voffA);
            PG8_BAR; PG8_WAIT_L(0); PG8_MMA(1, 0, At, B0); PG8_BAR; PG8_SCHED;
            PG8_STAGE(PG8_SB(0, 1), b2 + hstep, voffB);
            PG8_WAIT_V(6); PG8_BAR; PG8_MMA(1, 1, At, B1); PG8_BAR;
            PG8_LDB(B0, 1, 0); PG8_SCHED; PG8_LDA(At, 1, 0); PG8_STAGE(PG8_SA(0, 1), a2 + hstep, voffA);
            PG8_WAIT_L(8); PG8_BAR; PG8_WAIT_L(0); PG8_MMA(0, 0, At, B0); PG8_BAR; PG8_SCHED;
            PG8_LDB(B1, 1, 1); PG8_STAGE(PG8_SB(1, 0), b3, voffB);
            PG8_BAR; PG8_WAIT_L(0); PG8_MMA(0, 1, At, B1); PG8_BAR;
            PG8_LDA(At, 1, 1); PG8_STAGE(PG8_SA(1, 0), a3, voffA);
            PG8_BAR; PG8_WAIT_L(0); PG8_MMA(1, 0, At, B0); PG8_BAR; PG8_SCHED;
            PG8_STAGE(PG8_SB(1, 1), b3 + hstep, voffB);
            PG8_WAIT_V(6); PG8_BAR; PG8_MMA(1, 1, At, B1); PG8_BAR;
            }
        }
        if constexpr (ALIGN_EPI) { if (wr == 0) PG8_BAR; }
        if constexpr (!Epi::AFTER_DRAIN) { E(acc, cur, wr, wc, fr, fq, epre); S.done(cur); }
        if (!has_next) break;
#pragma unroll
        for (int a = 0; a < 2; ++a)
#pragma unroll
            for (int b = 0; b < 2; ++b)
#pragma unroll
                for (int m = 0; m < 4; ++m)
#pragma unroll
                    for (int n = 0; n < 2; ++n) acc[a][b][m][n] = (f32x4){0.f, 0.f, 0.f, 0.f};
        cur = nxt; cA = nA; cB = nB; ++ui;
        if constexpr (GATHER) {
#pragma unroll
            for (int h = 0; h < 2; ++h)
#pragma unroll
                for (int i = 0; i < 2; ++i) vAc[h][i] = vAn[h][i]; }
        if constexpr (ALIGN_EPI) { if (wr == 1) PG8_BAR; }
    }
    PG8_WAIT_V(0);
    if constexpr (!ALIGN_EPI) { if (wr == 0) PG8_BAR; }
    PG8_BAR;
    if constexpr (Epi::AFTER_DRAIN) { E.fused(acc, cur, wr, wc, fr, fq, lds, wid, lane); S.done(cur); }
#undef PG8_SA
#undef PG8_SB
#undef PG8_STAGE
#undef PG8_LDA
#undef PG8_LDB
#undef PG8_MMA
#undef PG8_WAIT_V
#undef PG8_WAIT_L
#undef PG8_BAR
#undef PG8_SCHED
}
}

#ifndef PG8_SP2
#define PG8_SP2 true
#endif
#ifndef PG8_ALIGN
#define PG8_ALIGN true
#endif
#include <hip/hip_bf16.h>
#include <cmath>
namespace attn2 {
using bf16=__hip_bfloat16;
using bf16x8=__attribute__((ext_vector_type(8)))short;
using s16x4=__attribute__((ext_vector_type(4)))short;
using f32x16=__attribute__((ext_vector_type(16)))float;
using u32x4=__attribute__((ext_vector_type(4)))unsigned;
constexpr int BATCH=2,NHEAD=16,SEQ=8192,D=64,KVP=512,OP=1024;
constexpr int NW=8,QBLK=32,QB=QBLK*NW,KVBLK=64,NQB=SEQ/QB;
constexpr int ATTN_UNIT_ROWS=QB;
__device__ __forceinline__ int crow(int r,int hi){return (r&3)+8*(r>>2)+4*hi;}
#define SBAR() __builtin_amdgcn_sched_barrier(0)
__device__ __forceinline__ void cmask(f32x16&p0,f32x16&p1,int jb,int qrel,int hi,const float*tab){
  const float NEG=-INFINITY; int kb=64*jb+4*hi;
  #pragma unroll
  for(int r=0;r<16;++r){int kv=kb+(r&3)+8*(r>>2); const int d0=qrel-kv,d1=d0-32;
    const float b0=tab[d0<0?0:(d0>127?127:d0)],b1=tab[d1<0?0:(d1>127?127:d1)];
    p0[r]=(d0<0)?NEG:(p0[r]+b0); p1[r]=(d1<0)?NEG:(p1[r]+b1); if((r&1)==1){asm volatile("":"+v"(p0),"+v"(p1)::"memory");}}
}

constexpr int NSLOT=3, SLOTB=8192;
constexpr int LDS_K=0, LDS_V=NSLOT*SLOTB, LDS_WS=3*NSLOT*SLOTB, LDS_OST=LDS_WS+NW*64*4, LDS_BYTES=LDS_OST+NW*4096;
constexpr float C2=0.125f*1.4426950408889634f;
__device__ __forceinline__ void glds16(const void*gsrc,unsigned lds_dst){unsigned keep;
  asm volatile("s_mov_b32 %0, m0\n\ts_mov_b32 m0, %2\n\ts_nop 0\n\tglobal_load_lds_dwordx4 %1, off\n\ts_mov_b32 m0, %0":"=&s"(keep):"v"(gsrc),"s"(lds_dst):"memory");}
__device__ __forceinline__ float max3f(float a,float b,float c){float r;asm("v_max3_f32 %0, %1, %2, %3":"=v"(r):"v"(a),"v"(b),"v"(c));return r;}
__device__ __forceinline__ float max2f(float a,float b){float r;asm("v_max_f32_e32 %0, %1, %2":"=v"(r):"v"(a),"v"(b));return r;}
__device__ __forceinline__ float fadd_s(float a,float b){float r;asm("v_add_f32_e32 %0, %1, %2":"=v"(r):"v"(a),"v"(b));return r;}
__device__ __forceinline__ float fsub_s(float a,float b){float r;asm("v_sub_f32_e32 %0, %1, %2":"=v"(r):"v"(a),"v"(b));return r;}
typedef float f32x2_t __attribute__((ext_vector_type(2))); typedef __bf16 bf16x2_t __attribute__((ext_vector_type(2)));
__device__ __forceinline__ unsigned cvtpk_s(float lo,float hi){f32x2_t v={lo,hi};bf16x2_t b=__builtin_convertvector(v,bf16x2_t);return __builtin_bit_cast(unsigned,b);}
#define WAIT_BAR(N) asm volatile("s_waitcnt vmcnt(" #N ") lgkmcnt(0)\n\ts_barrier":::"memory")

__device__ __forceinline__ void qkt(f32x16&p0,f32x16&p1,const char*Kslot,const bf16x8*qr,int r32,int hi){ const f32x16 negm=f32x16{};
  const char*kb=Kslot+hi*1024+r32*16;
  #pragma unroll
  for(int d0=0;d0<4;++d0){
    const bf16x8 b0=*reinterpret_cast<const bf16x8*>(kb+d0*2048);
    const bf16x8 b1=*reinterpret_cast<const bf16x8*>(kb+d0*2048+512);
    if(d0==0){p0=__builtin_amdgcn_mfma_f32_32x32x16_bf16(b0,qr[0],negm,0,0,0);p1=__builtin_amdgcn_mfma_f32_32x32x16_bf16(b1,qr[0],negm,0,0,0);}
    else{p0=__builtin_amdgcn_mfma_f32_32x32x16_bf16(b0,qr[d0],p0,0,0,0);p1=__builtin_amdgcn_mfma_f32_32x32x16_bf16(b1,qr[d0],p1,0,0,0);}}
}
typedef __attribute__((address_space(3))) const char* lds_cptr;
typedef short v4i16_t __attribute__((ext_vector_type(4)));
__device__ __forceinline__ void kload8(bf16x8*kf,lds_cptr kp){
  kf[0]=*(const __attribute__((address_space(3))) bf16x8*)(kp);      kf[1]=*(const __attribute__((address_space(3))) bf16x8*)(kp+512);
  kf[2]=*(const __attribute__((address_space(3))) bf16x8*)(kp+2048); kf[3]=*(const __attribute__((address_space(3))) bf16x8*)(kp+2560);
  kf[4]=*(const __attribute__((address_space(3))) bf16x8*)(kp+4096); kf[5]=*(const __attribute__((address_space(3))) bf16x8*)(kp+4608);
  kf[6]=*(const __attribute__((address_space(3))) bf16x8*)(kp+6144); kf[7]=*(const __attribute__((address_space(3))) bf16x8*)(kp+6656);
}
__device__ __forceinline__ void kload2(bf16x8*kf,lds_cptr kp,int j){ kf[2*j]=*(const __attribute__((address_space(3))) bf16x8*)(kp+j*2048); kf[2*j+1]=*(const __attribute__((address_space(3))) bf16x8*)(kp+j*2048+512); }
__device__ __forceinline__ s16x4 vtr(lds_cptr p){ return __builtin_bit_cast(s16x4,__builtin_amdgcn_ds_read_tr16_b64_v4i16((__attribute__((address_space(3))) v4i16_t*)p)); }
__device__ __forceinline__ float rowmax(const f32x16&p0,const f32x16&p1){
  float a=max3f(p0[0],p0[1],p1[0]),b=max3f(p0[2],p0[3],p1[1]);a=max3f(a,p1[2],p1[3]);
  #pragma unroll
  for(int r=4;r<16;r+=4){a=max3f(a,p0[r],p0[r+1]);b=max3f(b,p0[r+2],p0[r+3]);a=max3f(a,p1[r],p1[r+1]);b=max3f(b,p1[r+2],p1[r+3]);}
  const float m=max2f(a,b);
  auto rr=__builtin_amdgcn_permlane32_swap(__float_as_uint(m),__float_as_uint(m),false,false);
  return max2f(__uint_as_float(rr[0]),__uint_as_float(rr[1]));
}
__device__ __forceinline__ void pv(f32x16*o,int vb,bf16x8 pa0,bf16x8 pa1,bf16x8 pa2,bf16x8 pa3){
  #pragma unroll
  for(int d0=0;d0<4;++d0){s16x4 lo[4],hi[4];
    #pragma unroll
    for(int ks=0;ks<4;++ks){
      asm volatile("ds_read_b64_tr_b16 %0,%1 offset:%c2":"=&v"(lo[ks]):"v"(vb),"i"(d0*4096+ks*1024):"memory");
      asm volatile("ds_read_b64_tr_b16 %0,%1 offset:%c2":"=&v"(hi[ks]):"v"(vb),"i"(d0*4096+ks*1024+512):"memory");}
    asm volatile("s_waitcnt lgkmcnt(0)":::"memory");SBAR();
    #define PK(k) (bf16x8){lo[k][0],lo[k][1],lo[k][2],lo[k][3],hi[k][0],hi[k][1],hi[k][2],hi[k][3]}
    o[d0]=__builtin_amdgcn_mfma_f32_32x32x16_bf16(pa0,PK(0),o[d0],0,0,0);
    o[d0]=__builtin_amdgcn_mfma_f32_32x32x16_bf16(pa1,PK(1),o[d0],0,0,0);
    o[d0]=__builtin_amdgcn_mfma_f32_32x32x16_bf16(pa2,PK(2),o[d0],0,0,0);
    o[d0]=__builtin_amdgcn_mfma_f32_32x32x16_bf16(pa3,PK(3),o[d0],0,0,0);
    #undef PK
  }
}

#ifndef ATTN_STORE16
#define ATTN_STORE16(p,v) (*(u32x4*)(p)=(v))
#endif
template<int THRL,bool FAST> __device__ __forceinline__ void attn_unit(int b,int hm,int qb,const bf16*PROJ,bf16*O,char*shm,const float*tab,const int tid){
  const int lane=tid&63,r32=lane&31,hi=lane>>5; const int wid=__builtin_amdgcn_readfirstlane(tid>>6);
  const long rowbase=(long)b*SEQ; const int q0=qb*QB;
  const bf16*Qw=PROJ+(rowbase+q0+wid*QBLK)*KVP+hm*64;
  const bf16*Kh=PROJ+(long)16384*512+rowbase*KVP+hm*64,*Vh=PROJ+(long)2*16384*512+rowbase*KVP+(hm>>1)*128;
  const unsigned lds0=(unsigned)(uintptr_t)shm;
  float*wsf=(float*)(shm+LDS_WS)+wid*64;
  const bf16*ksrc=Kh+(long)lane*KVP+wid*8;
  const bf16*vsrc=Vh+(long)(16*(wid&3)+(lane>>2))*KVP+(wid>>2)*32+(lane&3)*8;
  const unsigned kdst=lds0+LDS_K+wid*1024, vdst=lds0+LDS_V+wid*1024;
  #define DMA_K(t,slot) glds16(ksrc+(long)(t)*KVBLK*KVP,(unsigned)__builtin_amdgcn_readfirstlane(kdst+(slot)))
  #define DMA_V(t,slot) do{ glds16(vsrc+(long)(t)*KVBLK*KVP,(unsigned)__builtin_amdgcn_readfirstlane(vdst+2*(slot))); glds16(vsrc+64+(long)(t)*KVBLK*KVP,(unsigned)__builtin_amdgcn_readfirstlane(vdst+8192+2*(slot))); }while(0)
  const int vb0=(int)(lds0+LDS_V)+((lane>>4)&1)*32+(lane&3)*8+(4*hi+((lane&15)>>2))*64;
  const char*Kbase=shm+LDS_K; bf16x8 kf[8];
  const lds_cptr shm3=(lds_cptr)shm; const lds_cptr kp0=shm3+LDS_K+hi*1024+r32*16; const lds_cptr vp0=shm3+LDS_V+((lane>>4)&1)*32+(lane&3)*8+(4*hi+((lane&15)>>2))*64;
  const int NT=(q0+QB)/KVBLK;
  DMA_K(0,0);DMA_V(0,0);DMA_K(1,SLOTB);
  bf16x8 qr[4];
  #pragma unroll
  for(int d0=0;d0<4;++d0)qr[d0]=*reinterpret_cast<const bf16x8*>(&Qw[(long)r32*KVP+d0*16+hi*8]);
  float mhat=0.f,l_reg=0.f;f32x16 o[4];o[0]=f32x16{};o[1]=f32x16{};o[2]=f32x16{};o[3]=f32x16{};
  const int qrel=wid*QBLK+r32;
  #define CMASK(P0,P1,t) do{int jb_=(t)-(NT-4); if(jb_>=-3)cmask(P0,P1,jb_,qrel,hi,tab);}while(0)
  bool resc=false;
  #define START(P0,P1) do{ if constexpr(!FAST){ const float rm=rowmax(P0,P1); resc=false; \
    { const float dl=rm; mhat=fadd_s(mhat,dl); \
      _Pragma("unroll") for(int r=0;r<16;++r){P0[r]=fsub_s(P0[r],dl);P1[r]=fsub_s(P1[r],dl);} } } \
    _Pragma("unroll") for(int r=0;r<16;++r)P0[r]=__builtin_amdgcn_exp2f(P0[r]); }while(0)
  #define RESC() do{ if constexpr(!FAST) if(resc){ asm volatile("s_waitcnt lgkmcnt(0)":::"memory"); \
      _Pragma("unroll") for(int d_=0;d_<4;++d_) _Pragma("unroll") for(int r=0;r<16;++r)o[d_][r]*=wsf[crow(r,hi)]; } }while(0)
  f32x16 pA0,pA1,pB0,pB1;
  int sl_prev=0,sl_cur=0,sl_next=SLOTB;
  #define ROT() do{sl_prev=sl_cur;sl_cur=sl_next;sl_next=(sl_next==(NSLOT-1)*SLOTB)?0:sl_next+SLOTB;}while(0)
  DMA_K(2,2*SLOTB);
  WAIT_BAR(4);
  qkt(pA0,pA1,Kbase,qr,r32,hi);asm volatile("s_nop 15\n\ts_nop 7":"+v"(pA0),"+v"(pA1));CMASK(pA0,pA1,0);
  START(pA0,pA1);
  _Pragma("unroll") for(int r=0;r<16;++r)pA1[r]=__builtin_amdgcn_exp2f(pA1[r]);
  WAIT_BAR(0);
  DMA_K(3,0);DMA_V(1,SLOTB);
  ROT();
  kload8(kf,kp0+sl_cur);
  WAIT_BAR(3);
  s16x4 vlo[4],vhi[4]; u32x4 pw0,pw1,pw2,pw3;
  #define PKW(P,B) cvtpk_s(P[B],P[B+1])
  #define PAF(k) __builtin_bit_cast(bf16x8,pw##k)
  #define VFR(i) (bf16x8){vlo[i][0],vlo[i][1],vlo[i][2],vlo[i][3],vhi[i][0],vhi[i][1],vhi[i][2],vhi[i][3]}
  #define PIN(x) asm volatile("":"+v"(x))
  #define MX3(a,b,c) __builtin_fmaxf(__builtin_fmaxf((a),(b)),(c))
  #define GAPA(MF,A0,A1,A2,A3,W0,W1,PW) do{ MF; sacc+=A0; sacc+=A1; sacc+=A2; sacc+=A3; PIN(sacc); W0; W1; PIN(PW); SBAR(); }while(0)
  #define EX(v) __builtin_amdgcn_exp2f(v)
  #define GAPB(MF,X,B) do{ MF; X[B]=EX(X[B]); X[B+1]=EX(X[B+1]); X[B+2]=EX(X[B+2]); X[B+3]=EX(X[B+3]); PIN(X); SBAR(); }while(0)
  #define GAPB2(MF,X,B) do{ MF; X[B]=EX(X[B]); X[B+1]=EX(X[B+1]); PIN(X); SBAR(); }while(0)
  #define VRDN(k,db) do{ vlo[k]=vtr(vp_+((db)*4096+(k)*1024)); vhi[k]=vtr(vp_+((db)*4096+(k)*1024+512)); }while(0)
  #define VRD(i) do{ vlo[i]=vtr(vp_+(((i)>>2)*4096+((i)&3)*1024)); vhi[i]=vtr(vp_+(((i)>>2)*4096+((i)&3)*1024+512)); }while(0)
  #define KRD(G,j) do{ if(G){ kload2(kf,kp0+sl_next,j); SBAR(); } }while(0)
  #define STEP(C0,C1,P0,P1,t,GK,GV,GL) do{ SBAR(); \
    const lds_cptr vp_=vp0+2*sl_prev; const f32x16 zc_=f32x16{}; \
    VRDN(0,0); SBAR(); float sacc=(P0[0]+P0[1]); \
    GAPA(C0=__builtin_amdgcn_mfma_f32_32x32x16_bf16(kf[0],qr[0],zc_,0,0,0), P0[2],P0[3],P0[4],P0[5],     pw0[0]=PKW(P0,0), pw0[1]=PKW(P0,2), pw0); \
    GAPA(C1=__builtin_amdgcn_mfma_f32_32x32x16_bf16(kf[1],qr[0],zc_,0,0,0), P0[6],P0[7],P0[8],P0[9],     pw0[2]=PKW(P0,4), pw0[3]=PKW(P0,6), pw0); \
    VRDN(1,0); SBAR(); GAPA(C0=__builtin_amdgcn_mfma_f32_32x32x16_bf16(kf[2],qr[1],C0,0,0,0),   P0[10],P0[11],P0[12],P0[13], pw1[0]=PKW(P0,8), pw1[1]=PKW(P0,10), pw1); \
    GAPA(C1=__builtin_amdgcn_mfma_f32_32x32x16_bf16(kf[3],qr[1],C1,0,0,0),   P0[14],P0[15],P1[0],P1[1],   pw1[2]=PKW(P0,12),pw1[3]=PKW(P0,14), pw1); \
    VRDN(2,0); SBAR(); GAPA(C0=__builtin_amdgcn_mfma_f32_32x32x16_bf16(kf[4],qr[2],C0,0,0,0),   P1[2],P1[3],P1[4],P1[5],     pw2[0]=PKW(P1,0), pw2[1]=PKW(P1,2), pw2); \
    GAPA(C1=__builtin_amdgcn_mfma_f32_32x32x16_bf16(kf[5],qr[2],C1,0,0,0),   P1[6],P1[7],P1[8],P1[9],     pw2[2]=PKW(P1,4), pw2[3]=PKW(P1,6), pw2); \
    VRDN(3,0); SBAR(); GAPA(C0=__builtin_amdgcn_mfma_f32_32x32x16_bf16(kf[6],qr[3],C0,0,0,0),   P1[10],P1[11],P1[12],P1[13], pw3[0]=PKW(P1,8), pw3[1]=PKW(P1,10), pw3); \
    GAPA(C1=__builtin_amdgcn_mfma_f32_32x32x16_bf16(kf[7],qr[3],C1,0,0,0),   P1[14],P1[15],0.f,0.f,       pw3[2]=PKW(P1,12),pw3[3]=PKW(P1,14), pw3); \
    l_reg+=sacc; \
    if(GK){DMA_K((t)+3,sl_cur);} if(GV){DMA_V((t)+1,sl_next);} \
    if constexpr(!FAST){ _Pragma("unroll") for(int r=0;r<16;++r){C0[r]-=mhat;C1[r]-=mhat;} } \
    CMASK(C0,C1,t); \
    if constexpr(!FAST){ float a=MX3(C0[0],C0[1],C1[0]),b=MX3(C0[2],C0[3],C1[1]); a=MX3(a,C1[2],C1[3]); \
      _Pragma("unroll") for(int r=4;r<16;r+=4){a=MX3(a,C0[r],C0[r+1]);b=MX3(b,C0[r+2],C0[r+3]);a=MX3(a,C1[r],C1[r+1]);b=MX3(b,C1[r+2],C1[r+3]);} \
      float rm=__builtin_fmaxf(a,b); { auto rr=__builtin_amdgcn_permlane32_swap(__float_as_uint(rm),__float_as_uint(rm),false,false); rm=__builtin_fmaxf(__uint_as_float(rr[0]),__uint_as_float(rr[1])); } \
      resc=false; \
      if(__builtin_expect(__any(rm>(float)THRL),0)){ const float dl=__builtin_fmaxf(rm,0.f); mhat+=dl; \
        _Pragma("unroll") for(int r=0;r<16;++r){C0[r]-=dl;C1[r]-=dl;} \
        const float f=__builtin_amdgcn_exp2f(-dl); l_reg*=f; if(hi==0)wsf[r32]=f; resc=true; } } \
    SBAR(); \
    GAPB2(o[0]=__builtin_amdgcn_mfma_f32_32x32x16_bf16(PAF(0),VFR(0),o[0],0,0,0), C0,0); VRDN(0,1); SBAR(); \
    GAPB2(o[0]=__builtin_amdgcn_mfma_f32_32x32x16_bf16(PAF(1),VFR(1),o[0],0,0,0), C0,2); VRDN(1,1); SBAR(); \
    KRD(GL,0); GAPB2(o[0]=__builtin_amdgcn_mfma_f32_32x32x16_bf16(PAF(2),VFR(2),o[0],0,0,0), C0,4); VRDN(2,1); SBAR(); \
    KRD(GL,1); GAPB2(o[0]=__builtin_amdgcn_mfma_f32_32x32x16_bf16(PAF(3),VFR(3),o[0],0,0,0), C0,6); VRDN(3,1); SBAR(); \
    KRD(GL,2); GAPB2(o[1]=__builtin_amdgcn_mfma_f32_32x32x16_bf16(PAF(0),VFR(0),o[1],0,0,0), C0,8); VRDN(0,2); SBAR(); \
    KRD(GL,3); GAPB2(o[1]=__builtin_amdgcn_mfma_f32_32x32x16_bf16(PAF(1),VFR(1),o[1],0,0,0), C0,10); VRDN(1,2); SBAR(); \
    GAPB2(o[1]=__builtin_amdgcn_mfma_f32_32x32x16_bf16(PAF(2),VFR(2),o[1],0,0,0), C0,12); VRDN(2,2); SBAR(); \
    GAPB2(o[1]=__builtin_amdgcn_mfma_f32_32x32x16_bf16(PAF(3),VFR(3),o[1],0,0,0), C0,14); VRDN(3,2); SBAR(); \
    GAPB2(o[2]=__builtin_amdgcn_mfma_f32_32x32x16_bf16(PAF(0),VFR(0),o[2],0,0,0), C1,0); VRDN(0,3); SBAR(); \
    GAPB2(o[2]=__builtin_amdgcn_mfma_f32_32x32x16_bf16(PAF(1),VFR(1),o[2],0,0,0), C1,2); VRDN(1,3); SBAR(); \
    GAPB2(o[2]=__builtin_amdgcn_mfma_f32_32x32x16_bf16(PAF(2),VFR(2),o[2],0,0,0), C1,4); VRDN(2,3); SBAR(); \
    GAPB2(o[2]=__builtin_amdgcn_mfma_f32_32x32x16_bf16(PAF(3),VFR(3),o[2],0,0,0), C1,6); VRDN(3,3); SBAR(); \
    GAPB2(o[3]=__builtin_amdgcn_mfma_f32_32x32x16_bf16(PAF(0),VFR(0),o[3],0,0,0), C1,8); \
    GAPB2(o[3]=__builtin_amdgcn_mfma_f32_32x32x16_bf16(PAF(1),VFR(1),o[3],0,0,0), C1,10); \
    GAPB2(o[3]=__builtin_amdgcn_mfma_f32_32x32x16_bf16(PAF(2),VFR(2),o[3],0,0,0), C1,12); \
    GAPB2(o[3]=__builtin_amdgcn_mfma_f32_32x32x16_bf16(PAF(3),VFR(3),o[3],0,0,0), C1,14); \
    }while(0)
  int t=1;
  #undef CMASK
  #define CMASK(P0,P1,t) do{}while(0)
  for(;t+7<NT;t+=2){
    STEP(pB0,pB1,pA0,pA1,t,true,true,true);     WAIT_BAR(3); RESC(); ROT();
    STEP(pA0,pA1,pB0,pB1,t+1,true,true,true);   WAIT_BAR(3); RESC(); ROT();
  }
  #undef CMASK
  #define CMASK(P0,P1,t) do{int jb_=(t)-(NT-4); if(jb_>=-3)cmask(P0,P1,jb_,qrel,hi,tab);}while(0)
  #define ENDW(tt) do{ if((tt)+3<NT){WAIT_BAR(3);} else if((tt)+2<NT){WAIT_BAR(2);} else {WAIT_BAR(0);} }while(0)
  for(;t+1<NT;t+=2){
    STEP(pB0,pB1,pA0,pA1,t,(t+3<NT),(t+1<NT),(t+1<NT));       ENDW(t);   RESC(); ROT();
    STEP(pA0,pA1,pB0,pB1,t+1,(t+4<NT),(t+2<NT),(t+2<NT));     ENDW(t+1); RESC(); ROT();
  }
  STEP(pB0,pB1,pA0,pA1,NT-1,false,false,false); RESC();
  { float sacc=pB0[0]+pB0[1]; _Pragma("unroll") for(int r=2;r<16;++r)sacc+=pB0[r]; _Pragma("unroll") for(int r=0;r<16;++r)sacc+=pB1[r]; l_reg+=sacc;
    pw0=(u32x4){PKW(pB0,0),PKW(pB0,2),PKW(pB0,4),PKW(pB0,6)};pw1=(u32x4){PKW(pB0,8),PKW(pB0,10),PKW(pB0,12),PKW(pB0,14)};pw2=(u32x4){PKW(pB1,0),PKW(pB1,2),PKW(pB1,4),PKW(pB1,6)};pw3=(u32x4){PKW(pB1,8),PKW(pB1,10),PKW(pB1,12),PKW(pB1,14)};
    SBAR(); pv(o,vb0+2*sl_cur,PAF(0),PAF(1),PAF(2),PAF(3)); }
  #undef PKW
  #undef PAF
  #undef VFR
  #undef PIN
  #undef MX3
  #undef GAPA
  #undef GAPB
  #undef EX
  #undef VRD
  #undef VRDN
  #undef GAPB2
  #undef KRD
  #undef STEP
  #undef ENDW
  {auto rr=__builtin_amdgcn_permlane32_swap(__float_as_uint(l_reg),__float_as_uint(l_reg),false,false);l_reg=__uint_as_float(rr[0])+__uint_as_float(rr[1]);}
  if(hi==0)wsf[32+r32]=l_reg;asm volatile("s_waitcnt lgkmcnt(0)":::"memory");
  float rli[16];
  #pragma unroll
  for(int r=0;r<16;++r)rli[r]=__builtin_amdgcn_rcpf(wsf[32+crow(r,hi)]);
  bf16*Ow=O+(rowbase+q0+wid*QBLK)*OP+hm*128;
  { bf16*stg=(bf16*)(shm+LDS_OST)+wid*2048;
    #pragma unroll
    for(int pp=0;pp<2;++pp){
      #pragma unroll
      for(int r=0;r<16;++r){const int orow=crow(r,hi);
        #pragma unroll
        for(int d0=0;d0<2;++d0)stg[orow*64+d0*32+r32]=__float2bfloat16(o[2*pp+d0][r]*rli[r]);}
      asm volatile("s_waitcnt lgkmcnt(0)":::"memory");
      #pragma unroll
      for(int i=0;i<4;++i){const int row=i*8+(lane>>3),ch=lane&7; const u32x4 v=*(const u32x4*)(stg+row*64+ch*8); ATTN_STORE16(Ow+(long)row*OP+pp*64+ch*8,v);}
      asm volatile("s_waitcnt lgkmcnt(0)":::"memory"); } }
  asm volatile("s_waitcnt lgkmcnt(0)\n\ts_barrier":::"memory");
  #undef DMA_K
  #undef DMA_V
  #undef CMASK
  #undef START
  #undef RESC
  #undef ROT
}
constexpr int ATTN_LDS_BYTES=LDS_BYTES;
template<int THRL=8> __device__ __forceinline__ void attn_phase(char*lds,const bf16*QKV,bf16*ODT,const float*tab4,int vcu,const int tid,const int fast){
  const int bm=vcu>>4,x=vcu&15; const float*tab=tab4+((bm&7)>>1)*128;
  if(fast){ attn_unit<THRL,true>(bm>>3,bm&7,x,QKV,ODT,lds,tab,tid); attn_unit<THRL,true>(bm>>3,bm&7,31-x,QKV,ODT,lds,tab,tid); }
  else { attn_unit<THRL,false>(bm>>3,bm&7,x,QKV,ODT,lds,tab,tid); attn_unit<THRL,false>(bm>>3,bm&7,31-x,QKV,ODT,lds,tab,tid); }
}
#undef SBAR
#undef WAIT_BAR
}
namespace da {
typedef unsigned short bf16;
typedef short bf16x8 __attribute__((ext_vector_type(8)));
typedef short s16x4 __attribute__((ext_vector_type(4)));
typedef float f32x16 __attribute__((ext_vector_type(16)));
typedef unsigned u32x4 __attribute__((ext_vector_type(4)));
constexpr int NW = 8, QBLK = 32, KVBLK = 64, QB = NW * QBLK, DQ = 64, DV = 128;
constexpr int SHM_V = KVBLK * DV * 2, SHM_K = KVBLK * DQ * 2;
constexpr int LDS_BYTES = 2 * SHM_V + 2 * SHM_K + NW * 64 * 4;
constexpr float SCALE = 0.6931471805599453f;
constexpr float THR = 8.f;
#define DA_KSWZ(row, colB) ((row) * 128 + ((colB) ^ (((row) & 7) << 4)))
#define DA_SBAR() __builtin_amdgcn_sched_barrier(0)
__device__ __forceinline__ int v_st(int k, int c) { const int kk = (k & ~0xC) | ((k & 4) << 1) | ((k & 8) >> 1); return ((kk >> 3) * 4 + (c >> 5)) * 512 + ((kk & 7) * 32 + (c & 31)) * 2; }
__device__ __forceinline__ int v_rd_base(int lane) { return ((lane & 3) << 3) | (((lane >> 2) & 3) << 6) | (((lane >> 4) & 1) << 5) | (((lane >> 5) & 1) << 8); }
constexpr int v_rd_off(int d0, int ks, int half) { return d0 * 512 + ks * 4096 + half * 2048; }
__device__ __forceinline__ int crow(int r, int hi) { return (r & 3) + 8 * (r >> 2) + 4 * hi; }
__device__ __forceinline__ unsigned cvtpk(float lo, float hi) { unsigned r; asm volatile("v_cvt_pk_bf16_f32 %0, %1, %2" : "=v"(r) : "v"(lo), "v"(hi)); return r; }
__device__ __forceinline__ bf16x8 load8(const bf16* p) { return *reinterpret_cast<const bf16x8*>(p); }
__device__ __forceinline__ void mask_bias_tile(f32x16& p0, f32x16& p1, int dq, const float* tab) {
    const float NEG = -__builtin_inff();
#pragma unroll
    for (int r = 0; r < 16; ++r) { const int c = (r & 3) + 8 * (r >> 2); const int d0 = dq - c, d1 = d0 - 32;
        const float b0 = tab[d0 < 0 ? 0 : (d0 > 127 ? 127 : d0)], b1 = tab[d1 < 0 ? 0 : (d1 > 127 ? 127 : d1)];
        p0[r] = d0 < 0 ? NEG : p0[r] + b0; p1[r] = d1 < 0 ? NEG : p1[r] + b1;
        if ((r & 1) == 1) { asm volatile("" : "+v"(p0), "+v"(p1) :: "memory"); } }
}
__device__ __forceinline__ void partialSM(f32x16& p0, f32x16& p1, float& m_reg, float& mn, float& alpha) {
    float pmax = p0[0]; for (int r = 1; r < 16; ++r) pmax = fmaxf(pmax, p0[r]); for (int r = 0; r < 16; ++r) pmax = fmaxf(pmax, p1[r]);
    { auto rr = __builtin_amdgcn_permlane32_swap(__float_as_uint(pmax), __float_as_uint(pmax), false, false);
      pmax = fmaxf(__uint_as_float(rr[0]), __uint_as_float(rr[1])); }
    constexpr float C2 = 1.4426950408889634f * SCALE;
    if (__builtin_expect(__all((pmax - m_reg) * SCALE <= THR), 1)) { mn = m_reg; alpha = 1.f; }
    else { mn = fmaxf(m_reg, pmax); alpha = __builtin_amdgcn_exp2f((m_reg - mn) * C2); m_reg = mn; }
    const float mnL = -mn * C2;
    for (int r = 0; r < 16; ++r) p0[r] = fmaf(p0[r], C2, mnL); for (int r = 0; r < 16; ++r) p1[r] = fmaf(p1[r], C2, mnL);
    for (int r = 0; r < 16; ++r) p0[r] = __builtin_amdgcn_exp2f(p0[r]);
}
__device__ __forceinline__ void finishSM(f32x16& p0, f32x16& p1, float alpha, float& l_reg, bf16x8& pa0, bf16x8& pa1, bf16x8& pa2, bf16x8& pa3) {
    for (int r = 0; r < 16; ++r) p1[r] = __builtin_amdgcn_exp2f(p1[r]);
    float ps = 0; for (int r = 0; r < 16; ++r) ps += p0[r]; for (int r = 0; r < 16; ++r) ps += p1[r];
    { auto rr = __builtin_amdgcn_permlane32_swap(__float_as_uint(ps), __float_as_uint(ps), false, false);
      ps = __uint_as_float(rr[0]) + __uint_as_float(rr[1]); }
    l_reg = l_reg * alpha + ps;
#define DA_PK4(P, B_, OUT) do { unsigned a0 = cvtpk(P[B_+0], P[B_+1]), a1 = cvtpk(P[B_+2], P[B_+3]);                          \
        unsigned b0 = cvtpk(P[B_+4], P[B_+5]), b1 = cvtpk(P[B_+6], P[B_+7]);                                             \
        auto r0 = __builtin_amdgcn_permlane32_swap(a0, b0, false, false); auto r1 = __builtin_amdgcn_permlane32_swap(a1, b1, false, false); \
        u32x4 w = {r0[0], r1[0], r0[1], r1[1]}; OUT = *reinterpret_cast<bf16x8*>(&w); } while (0)
    DA_PK4(p0, 0, pa0); DA_PK4(p0, 8, pa1); DA_PK4(p1, 0, pa2); DA_PK4(p1, 8, pa3);
#undef DA_PK4
}
template <int KB>
__device__ __forceinline__ void qkt(f32x16& p0, f32x16& p1, const char* K_lds, int r32, int hi, const bf16x8* qr) {
    p0 = f32x16{}; p1 = f32x16{};
#pragma unroll
    for (int d0 = 0; d0 < 4; ++d0) { const char* a = K_lds + KB * SHM_K + DA_KSWZ(r32, (d0 * 16 + hi * 8) * 2);
        bf16x8 b0 = *reinterpret_cast<const bf16x8*>(a);
        bf16x8 b1 = *reinterpret_cast<const bf16x8*>(a + 32 * 128);
        p0 = __builtin_amdgcn_mfma_f32_32x32x16_bf16(b0, qr[d0], p0, 0, 0, 0);
        p1 = __builtin_amdgcn_mfma_f32_32x32x16_bf16(b1, qr[d0], p1, 0, 0, 0); }
}
template <int VB>
__device__ __forceinline__ void pv_tile(f32x16* o, int vb0, bf16x8 pa0, bf16x8 pa1, bf16x8 pa2, bf16x8 pa3) {
#define DA_TRRD(dst, off) asm volatile("ds_read_b64_tr_b16 %0, %1 offset:%2" : "=&v"(dst) : "v"(vb0), "i"(off) : "memory")
#define DA_PV_D0(d0) do { s16x4 l0, l1, l2, l3, h0, h1, h2, h3; constexpr int b_ = VB * SHM_V + v_rd_off(d0, 0, 0); \
        DA_TRRD(l0, b_); DA_TRRD(h0, b_ + 2048); DA_TRRD(l1, b_ + 4096); DA_TRRD(h1, b_ + 6144); DA_TRRD(l2, b_ + 8192); DA_TRRD(h2, b_ + 10240); DA_TRRD(l3, b_ + 12288); DA_TRRD(h3, b_ + 14336); \
        asm volatile("s_waitcnt lgkmcnt(0)" ::: "memory"); DA_SBAR();   \
        o[d0] = __builtin_amdgcn_mfma_f32_32x32x16_bf16(pa0, (bf16x8){l0[0], l0[1], l0[2], l0[3], h0[0], h0[1], h0[2], h0[3]}, o[d0], 0, 0, 0);   \
        o[d0] = __builtin_amdgcn_mfma_f32_32x32x16_bf16(pa1, (bf16x8){l1[0], l1[1], l1[2], l1[3], h1[0], h1[1], h1[2], h1[3]}, o[d0], 0, 0, 0);   \
        o[d0] = __builtin_amdgcn_mfma_f32_32x32x16_bf16(pa2, (bf16x8){l2[0], l2[1], l2[2], l2[3], h2[0], h2[1], h2[2], h2[3]}, o[d0], 0, 0, 0);   \
        o[d0] = __builtin_amdgcn_mfma_f32_32x32x16_bf16(pa3, (bf16x8){l3[0], l3[1], l3[2], l3[3], h3[0], h3[1], h3[2], h3[3]}, o[d0], 0, 0, 0); } while (0)
    DA_PV_D0(0); DA_PV_D0(1); DA_PV_D0(2); DA_PV_D0(3);
#undef DA_PV_D0
#undef DA_TRRD
}
constexpr int QP = 512, KP = 512, VP = 512, OP = 1024;
struct BlockRef { const bf16* Q; const bf16* K; const bf16* V; bf16* O; int P0; };
struct Seam { bf16x8 qr[4]; bf16x8 st_v0, st_v1, st_k; };
#define DA_VROW(p, k0, rr) ((p) + (size_t)((k0) + (rr)) * VP + sc)
#define DA_KROW(p, k0) ((p) + (size_t)((k0) + kr) * KP + kc)
#define DA_VMW() asm volatile("s_waitcnt vmcnt(0)" ::: "memory")
#define DA_VMWN(n) asm volatile("s_waitcnt vmcnt(%0)" :: "i"(n) : "memory")
#define DA_SLOAD(Kp, Vp, k0) do { S.st_v0 = load8(DA_VROW(Vp, k0, sr)); S.st_v1 = load8(DA_VROW(Vp, k0, 32 + sr)); S.st_k = load8(DA_KROW(Kp, k0)); } while (0)
#define DA_SWRITE_K(bf) do { *(bf16x8*)(K_lds + (bf) * SHM_K + kws) = S.st_k; } while (0)
#define DA_SWRITE_V(bf) do { *(bf16x8*)(V_lds + (bf) * SHM_V + vst0) = S.st_v0; *(bf16x8*)(V_lds + (bf) * SHM_V + vst1) = S.st_v1; } while (0)
#define DA_SWRITE(bf) do { DA_SWRITE_V(bf); DA_SWRITE_K(bf); } while (0)
__device__ __forceinline__ void prime(const BlockRef& cur, char* lds, Seam& S, const int tid) {
    const int wid = __builtin_amdgcn_readfirstlane(tid >> 6), lane = tid & 63, r32 = lane & 31, hi = lane >> 5;
    const int sr = tid >> 4, sc = (tid & 15) * 8, kr = tid >> 3, kc = (tid & 7) * 8, kws = DA_KSWZ(kr, kc * 2); char* K_lds = lds + 2 * SHM_V;
#pragma unroll
    for (int d0 = 0; d0 < 4; ++d0) S.qr[d0] = load8(cur.Q + (size_t)(wid * QBLK + r32) * QP + d0 * 16 + hi * 8);
    DA_SLOAD(cur.K, cur.V, 0); DA_VMW(); DA_SWRITE_K(0);
    __syncthreads();
}
__device__ __forceinline__ void block(const BlockRef& cur, const BlockRef& nxt, char* lds, Seam& S, const float* tab, const int tid) {
    const int wid = __builtin_amdgcn_readfirstlane(tid >> 6), lane = tid & 63, r32 = lane & 31, hi = lane >> 5;
    const int NT = (cur.P0 + QB - 1) / KVBLK + 1;
    const int qlo = cur.P0 + wid * QBLK, qm = qlo + r32 - 4 * hi;
    char* V_lds = lds; char* K_lds = lds + 2 * SHM_V;
    float* ws = (float*)(lds + 2 * SHM_V + 2 * SHM_K) + wid * 64; float* li_l = ws, * al_l = ws + 32;
    float m_reg = -1e30f, l_reg = 0; f32x16 o[4] = {};
    const int sr = tid >> 4, sc = (tid & 15) * 8, vst0 = v_st(sr, sc), vst1 = v_st(32 + sr, sc), kr = tid >> 3, kc = (tid & 7) * 8, kws = DA_KSWZ(kr, kc * 2);
    const int vb0 = (int)(uintptr_t)V_lds + v_rd_base(lane);
    const bf16* Kh = cur.K; const bf16* Vh = cur.V;
#define DA_RESC(a) do { if (__any((a) < 1.f)) { if (hi == 0) al_l[r32] = (a); asm volatile("s_waitcnt lgkmcnt(0)" ::: "memory");              \
                     for (int d_ = 0; d_ < 4; ++d_) for (int r = 0; r < 16; ++r) o[d_][r] *= al_l[crow(r, hi)]; } } while (0)
#define DA_KBASE(t) ((t) * KVBLK)
#define DA_MASKT(P0_, P1_, t) do { const int kb_ = DA_KBASE(t); if (kb_ + KVBLK - 1 + 113 > qlo) mask_bias_tile(P0_, P1_, qm - kb_, tab); } while (0)
    constexpr int NQL = 4;
#define DA_SEAM_K0() do { DA_VMWN(NQL); DA_SWRITE_K(0); DA_SBAR(); } while (0)
    f32x16 pA0, pA1, pB0, pB1; float mnA, mnB, alA, alB; bf16x8 pa0, pa1, pa2, pa3;
    DA_SWRITE_V(0); DA_SBAR();
    if (NT > 1) { DA_SLOAD(Kh, Vh, DA_KBASE(1)); }
    DA_SBAR(); qkt<0>(pA0, pA1, K_lds, r32, hi, S.qr);
    DA_MASKT(pA0, pA1, 0); partialSM(pA0, pA1, m_reg, mnA, alA);
    if (NT > 1) { DA_VMW(); DA_SWRITE(1); }
    __syncthreads();
#define DA_HALF_STEP(PX0, PX1, mnX, alX, PY0, PY1, alY, t, KB, VB, SB) do {                                                      \
        DA_SBAR(); qkt<KB>(PX0, PX1, K_lds, r32, hi, S.qr);                                             \
        finishSM(PY0, PY1, alY, l_reg, pa0, pa1, pa2, pa3); DA_SBAR();                                                           \
        if ((t) + 1 < NT) { DA_SLOAD(Kh, Vh, DA_KBASE((t) + 1)); DA_SBAR(); }                                               \
        pv_tile<VB>(o, vb0, pa0, pa1, pa2, pa3); DA_MASKT(PX0, PX1, (t)); partialSM(PX0, PX1, m_reg, mnX, alX);                                        \
        __syncthreads();                                                                                                      \
        if ((t) + 1 < NT) { DA_VMW(); DA_SWRITE(SB); }                                                                          \
        DA_RESC(alX); __syncthreads(); } while (0)
    for (int t = 1; t + 1 < NT; t += 2) {
        DA_HALF_STEP(pB0, pB1, mnB, alB, pA0, pA1, alA, t, 1, 0, 0);
        DA_HALF_STEP(pA0, pA1, mnA, alA, pB0, pB1, alB, t + 1, 0, 1, 1);
    }
    const bool even = (NT & 1) == 0;
    if (even) { DA_SBAR(); qkt<1>(pB0, pB1, K_lds, r32, hi, S.qr); DA_SBAR(); }
    DA_SLOAD(nxt.K, nxt.V, 0); DA_SBAR();
#pragma unroll
    for (int d0 = 0; d0 < 4; ++d0) S.qr[d0] = load8(nxt.Q + (size_t)(wid * QBLK + r32) * QP + d0 * 16 + hi * 8);
    DA_SBAR();
    finishSM(pA0, pA1, alA, l_reg, pa0, pa1, pa2, pa3); DA_SBAR();
    pv_tile<0>(o, vb0, pa0, pa1, pa2, pa3);
    if (even) { DA_MASKT(pB0, pB1, NT - 1); partialSM(pB0, pB1, m_reg, mnB, alB); __syncthreads(); DA_RESC(alB);
        finishSM(pB0, pB1, alB, l_reg, pa0, pa1, pa2, pa3); DA_SBAR(); pv_tile<1>(o, vb0, pa0, pa1, pa2, pa3); }
    DA_SBAR(); DA_SEAM_K0();
    if (hi == 0) li_l[r32] = l_reg; asm volatile("s_waitcnt lgkmcnt(0)" ::: "memory");
    float rli[16];
#pragma unroll
    for (int r = 0; r < 16; ++r) rli[r] = __builtin_amdgcn_rcpf(li_l[crow(r, hi)]);
    bf16* Ow = cur.O + (size_t)(wid * QBLK) * OP;
#pragma unroll
    for (int r = 0; r < 16; ++r) { const int orow = crow(r, hi);
#pragma unroll
        for (int d0 = 0; d0 < 4; ++d0) { const float v = o[d0][r] * rli[r];
            const float vn = __shfl_xor(v, 1);
            if ((r32 & 1) == 0) *(unsigned*)(Ow + (size_t)orow * OP + d0 * 32 + r32) = cvtpk(v, vn); } }
    __syncthreads();
#undef DA_RESC
#undef DA_KBASE
#undef DA_MASKT
#undef DA_SEAM_K0
#undef DA_HALF_STEP
}
#undef DA_VROW
#undef DA_KROW
#undef DA_VMW
#undef DA_VMWN
#undef DA_SLOAD
#undef DA_SWRITE_K
#undef DA_SWRITE_V
#undef DA_SWRITE
__device__ __forceinline__ BlockRef ref(const bf16* QKV, bf16* ODT, int bm, int qb) {
    const int b = bm >> 3, hm = bm & 7; BlockRef r; const size_t rowb = (size_t)b * 8192;
    r.Q = QKV + (rowb + (size_t)qb * QB) * QP + hm * 64; r.K = QKV + (size_t)16384 * 512 + rowb * KP + hm * 64; r.V = QKV + (size_t)2 * 16384 * 512 + rowb * VP + (hm >> 1) * 128;
    r.O = ODT + (rowb + (size_t)qb * QB) * OP + hm * 128; r.P0 = qb * QB; return r;
}
__device__ __forceinline__ void phase(char* lds, const bf16* QKV, bf16* ODT, const float* tab4, int vcu, const int tid) {
    const int bm = vcu >> 4, x = vcu & 15; const float* tab = tab4 + ((bm & 7) >> 1) * 128;
    const BlockRef b0 = ref(QKV, ODT, bm, x), b1 = ref(QKV, ODT, bm, 31 - x);
    Seam S;
    prime(b0, lds, S, tid);
    block(b0, b1, lds, S, tab, tid);
    block(b1, b1, lds, S, tab, tid);
}
}
constexpr int NWAVES = 8;
#ifndef MK_ONE_LAUNCH
#define MK_ONE_LAUNCH 1
#endif
constexpr int T = 16384, SEQ = 8192, D = 1024, INW = 6400, NL = 2, NEXP = 32, DFF = 1024;
constexpr int NR_MAX = 73728;
constexpr float NORM_EPS = 1e-6f;
constexpr float LOG2E = 1.4426950408889634f;
constexpr float QSCALE = 0.125f * LOG2E;
constexpr size_t MiB = 1u << 20;
constexpr size_t WS_CTL = 0, CTL_ZERO_BYTES = 65536;
constexpr size_t WS_MOD = 1 * MiB;
constexpr size_t WS_SUMM = 2 * MiB;
constexpr size_t WS_BLKCNT = 3 * MiB;
constexpr size_t WS_TILEMAP = 3 * MiB + 65536;
constexpr size_t WS_TOPW = 4 * MiB;
constexpr size_t WS_ERANK = 4 * MiB + 512 * 1024;
constexpr size_t WS_DEST = 5 * MiB;
constexpr size_t WS_ROWTOK = 5 * MiB + 512 * 1024;
constexpr size_t WS_WIN = 8 * MiB;
constexpr size_t WS_WBR = 34 * MiB;
constexpr size_t WS_WOUT = 40 * MiB;
constexpr size_t WS_W1 = 48 * MiB;
constexpr size_t WS_W2 = 304 * MiB;
constexpr size_t WS_H = 432 * MiB;
constexpr size_t WS_PROJ = 464 * MiB;
constexpr size_t WS_BR = 664 * MiB;
constexpr size_t WS_ODT = 712 * MiB;
constexpr size_t WS_MERGED = 744 * MiB;
constexpr size_t WS_XS = 776 * MiB;
constexpr size_t WS_ACT = 920 * MiB;
constexpr size_t WS_Y = 1064 * MiB;
constexpr size_t WS_END = 1208 * MiB;
constexpr int CW_BAR = 4096;
constexpr int CW_TILE = 8192;
constexpr int RING_OFF = 0, RING_BYTES = 131072;
constexpr int TAB_OFF = 110592;
constexpr int LDSCTL_OFF = RING_BYTES, MISC_OFF = LDSCTL_OFF + 320;
constexpr int TMAP_OFF = LDSCTL_OFF + 1024;
constexpr int LDS_BYTES = 147456;

#define GAS __attribute__((address_space(1)))
#define LAS __attribute__((address_space(3)))
typedef unsigned short bf16;
typedef unsigned v4u __attribute__((ext_vector_type(4)));
typedef unsigned v2u __attribute__((ext_vector_type(2)));
typedef float f32x4 __attribute__((ext_vector_type(4)));
typedef GAS unsigned gu32;
#define RLX_AGENT __ATOMIC_RELAXED, __HIP_MEMORY_SCOPE_AGENT
#define LDS_WAIT() asm volatile("s_waitcnt lgkmcnt(0)" ::: "memory")
#define VM_WAIT() asm volatile("s_waitcnt vmcnt(0)" ::: "memory")
__device__ __forceinline__ unsigned pk2(float lo, float hi) { typedef float f2_t_ __attribute__((ext_vector_type(2))); typedef __bf16 b2_t_ __attribute__((ext_vector_type(2))); f2_t_ v = {lo, hi}; b2_t_ b = __builtin_convertvector(v, b2_t_); return __builtin_bit_cast(unsigned, b); }
__device__ __forceinline__ unsigned f2bf(float f) { return pk2(f, 0.f) & 0xffffu; }
__device__ __forceinline__ float bflo(unsigned w) { return __uint_as_float(w << 16); }
__device__ __forceinline__ float bfhi(unsigned w) { return __uint_as_float(w & 0xffff0000u); }
__device__ __forceinline__ float bf1(bf16 h) { return __uint_as_float((unsigned)h << 16); }
#define XB_TMO      128
#define XB_XCNT(j)  (256  + 64 * (j))
#define XB_XSUB(j)  (1280 + 64 * (j))
#define XB_XGEN(j)  (2304 + 64 * (j))
#define XB_TOP      3328
#define XB_TOPGEN   3392
#define XCD_BAR_WORDS 3456
#define XB_SPIN_CAP (1u << 18)

__device__ __forceinline__ unsigned xb_ld(unsigned* p)              { return __hip_atomic_load(p, __ATOMIC_RELAXED, __HIP_MEMORY_SCOPE_AGENT); }
__device__ __forceinline__ unsigned xb_add(unsigned* p, unsigned v) { return __hip_atomic_fetch_add(p, v, __ATOMIC_RELAXED, __HIP_MEMORY_SCOPE_AGENT); }
__device__ __forceinline__ unsigned xb_xcc_id() { return (unsigned)__builtin_amdgcn_s_getreg((3 << 11) | 20) & 0xFu; }
#define XB_SPIN(cond, bar) do { unsigned _sp = 0; while (cond) { __builtin_amdgcn_s_sleep(1); \
    if ((++_sp & 255u) == 0u) { if (xb_ld(&(bar)[XB_TMO])) break; if (_sp > XB_SPIN_CAP) { atomicAdd(&(bar)[XB_TMO], 1u); break; } } } } while (0)

struct XcdBarrier {
    unsigned* bar; unsigned x;
    volatile LAS unsigned* st;
};

__device__ __forceinline__ XcdBarrier xcd_barrier_post(unsigned* bar, volatile LAS unsigned* st) {
    XcdBarrier b; b.bar = bar; b.x = xb_xcc_id(); b.st = st;
    if (threadIdx.x == 0) (void)xb_add(&bar[XB_XCNT(b.x)], 1u);
    return b;
}
__device__ __forceinline__ void xcd_barrier_complete(unsigned* bar, unsigned x, unsigned& nloc, unsigned& nx) {
    const unsigned G = gridDim.x * gridDim.y * gridDim.z;
    unsigned sum, cnt, mine, sp = 0u;
    for (;;) {
        sum = 0u; cnt = 0u; mine = 0u;
#pragma unroll
        for (unsigned j = 0; j < 16; ++j) { const unsigned c = xb_ld(&bar[XB_XCNT(j)]); sum += c; cnt += (c > 0u) ? 1u : 0u; mine = (j == x) ? c : mine; }
        if (sum == G) break;
        __builtin_amdgcn_s_sleep(1);
        if ((++sp & 255u) == 0u) { if (xb_ld(&bar[XB_TMO])) break; if (sp > XB_SPIN_CAP) { atomicAdd(&bar[XB_TMO], 1u); break; } }
    }
    nloc = mine > 0u ? mine : 1u; nx = cnt > 0u ? cnt : 1u;
}

__device__ __forceinline__ void xcd_barrier(const XcdBarrier& b) {
    asm volatile("s_waitcnt vmcnt(0)" ::: "memory");
    __syncthreads();
    if (threadIdx.x == 0) {
        unsigned* bar = b.bar;
        __builtin_amdgcn_s_waitcnt(0);
        unsigned nloc = b.st[0], nx = b.st[1];
        if (nloc == 0u) { xcd_barrier_complete(bar, b.x, nloc, nx); b.st[0] = nloc; b.st[1] = nx; }
        const unsigned old = xb_add(&bar[XB_XSUB(b.x)], 1u);
        const unsigned gen = old / nloc;
        if (old + 1u == (gen + 1u) * nloc) {
            __builtin_amdgcn_fence(__ATOMIC_RELEASE, "agent");
            asm volatile("s_waitcnt vmcnt(0)" ::: "memory");
            const unsigned og = xb_add(&bar[XB_TOP], 1u);
            const unsigned tg = og / nx;
            if (og + 1u == (tg + 1u) * nx) xb_add(&bar[XB_TOPGEN], 1u);
            else XB_SPIN(xb_ld(&bar[XB_TOPGEN]) == tg, bar);
            __builtin_amdgcn_fence(__ATOMIC_ACQUIRE, "agent");
            xb_add(&bar[XB_XGEN(b.x)], 1u);
            asm volatile("s_waitcnt vmcnt(0)" ::: "memory");
        } else {
            XB_SPIN(xb_ld(&bar[XB_XGEN(b.x)]) == gen, bar);
            __builtin_amdgcn_fence(__ATOMIC_ACQUIRE, "agent");
            asm volatile("s_waitcnt vmcnt(0)" ::: "memory");
        }
    }
    __syncthreads();
}
struct Frame {
    LAS unsigned char* lds;
    volatile LAS unsigned* MISC;
    gu32* ctl;
    int tid, lane, wave, vcu, G;
    float* out; unsigned char* ws;
};
__device__ __forceinline__ const float* inp(int i) { typedef __attribute__((address_space(4))) const unsigned long long* kap_t; kap_t ka = (kap_t)__builtin_amdgcn_kernarg_segment_ptr(); asm volatile("" : "+s"(ka)); return (const float*)(const GAS float*)ka[i]; }
enum { I_X = 0, I_C, I_WADA, I_BADA, I_NMIX, I_NFFN, I_WIN, I_CONVW, I_CONVB, I_LWA, I_LBA, I_LWX, I_LBX, I_LLAM, I_DQN, I_DKN, I_DLAM, I_DSUB, I_SQN, I_SKN, I_SINK, I_RELB, I_WBR, I_WOUT, I_WR, I_BR, I_W1, I_B1, I_W2, I_B2 };

__device__ __forceinline__ float wave_sum(float v) {
#pragma unroll
    for (int o = 1; o < 64; o <<= 1) v += __shfl_xor(v, o);
    return v;
}
struct TrItem { const float* src; bf16* dst; int N, K; };
__device__ __forceinline__ void p0_item_load(const TrItem& t, float (&v)[32], int lane) {
#pragma unroll
    for (int i = 0; i < 32; ++i) v[i] = __builtin_nontemporal_load(t.src + (size_t)(2 * i + (lane >> 5)) * t.N + (lane & 31));
}
__device__ __forceinline__ void p0_item_store(const TrItem& t, const float (&v)[32], LAS float* scr, int lane) {
#pragma unroll
    for (int i = 0; i < 32; ++i) scr[(2 * i + (lane >> 5)) * 33 + (lane & 31)] = v[i];
    LDS_WAIT(); asm volatile("" ::: "memory");
    const int c = lane & 7;
#pragma unroll
    for (int j = 0; j < 4; ++j) { const int n = (lane >> 3) + 8 * j; const LAS float* s = scr + (8 * c) * 33 + n;
        v4u o; o.x = pk2(s[0 * 33], s[1 * 33]); o.y = pk2(s[2 * 33], s[3 * 33]); o.z = pk2(s[4 * 33], s[5 * 33]); o.w = pk2(s[6 * 33], s[7 * 33]);
        __builtin_nontemporal_store(o, (GAS v4u*)(t.dst + (size_t)n * t.K + 8 * c)); }
    LDS_WAIT(); asm volatile("" ::: "memory");
}
constexpr int TI_IN = (1024 / 64) * (INW / 32), TI_BRN = (512 / 64) * (1024 / 32), TI_OUT = (1024 / 64) * (1024 / 32), TI_E1 = (1024 / 64) * (2048 / 32), TI_E2 = (1024 / 64) * (1024 / 32);
constexpr int TI_PER_LAYER = TI_IN + 3 * TI_BRN + TI_OUT + NEXP * TI_E1 + NEXP * TI_E2;
constexpr int TI_DENSE = TI_IN + 3 * TI_BRN + TI_OUT, TI_MOE = NEXP * TI_E1 + NEXP * TI_E2;
#ifndef CQ_X1
#define CQ_X1 32768
#endif
constexpr int CQ_W2L0 = NEXP * TI_E2;
constexpr int CQ_Q0 = TI_DENSE + NEXP * TI_E1 - CQ_X1;
constexpr int CQ_TOTAL = 2 * TI_PER_LAYER - CQ_Q0;
static_assert(CQ_X1 % 16 == 0 && CQ_X1 >= 0 && CQ_X1 <= NEXP * TI_E1, "conversion-queue head");
static_assert(TI_DENSE % 16 == 0 && TI_PER_LAYER % 16 == 0 && CQ_W2L0 % 16 == 0, "conversion-queue batches");
constexpr int CW_CQ = 2048;
__device__ __forceinline__ TrItem p0_item_decode(Frame& F, int it) {
    const int l = it / TI_PER_LAYER; int r = it - l * TI_PER_LAYER; const float* W; bf16* WT; int K, N;
    if (r < TI_IN) { W = inp(I_WIN) + (size_t)l * 1024 * INW; WT = (bf16*)(F.ws + WS_WIN) + (size_t)l * INW * 1024; K = 1024; N = INW; }
    else if ((r -= TI_IN) < 3 * TI_BRN) { const int n = r / TI_BRN; r -= n * TI_BRN; W = inp(I_WBR) + (size_t)(l * 3 + n) * 512 * 1024; WT = (bf16*)(F.ws + WS_WBR) + (size_t)(l * 3 + n) * 1024 * 512; K = 512; N = 1024; }
    else if ((r -= 3 * TI_BRN) < TI_OUT) { W = inp(I_WOUT) + (size_t)l * 1024 * 1024; WT = (bf16*)(F.ws + WS_WOUT) + (size_t)l * 1024 * 1024; K = 1024; N = 1024; }
    else if ((r -= TI_OUT) < NEXP * TI_E1) { const int e = r / TI_E1; r -= e * TI_E1; W = inp(I_W1) + (size_t)(l * NEXP + e) * 1024 * 2048; WT = (bf16*)(F.ws + WS_W1) + (size_t)(l * NEXP + e) * 2048 * 1024; K = 1024; N = 2048; }
    else { r -= NEXP * TI_E1; const int e = r / TI_E2; r -= e * TI_E2; W = inp(I_W2) + (size_t)(l * NEXP + e) * 1024 * 1024; WT = (bf16*)(F.ws + WS_W2) + (size_t)(l * NEXP + e) * 1024 * 1024; K = 1024; N = 1024; }
    const int nblk = N / 32, kb = r / nblk, nb = r - kb * nblk;
    TrItem t; t.src = W + (size_t)(64 * kb) * N + 32 * nb; t.dst = WT + (size_t)(32 * nb) * K + 64 * kb; t.N = N; t.K = K; return t;
}
__device__ __forceinline__ TrItem cq_decode(Frame& F, int q) { return p0_item_decode(F, CQ_Q0 + q); }
__device__ __forceinline__ void cq_run(Frame& F, int max_batches, int until = CQ_TOTAL) {
    LAS float* scr = (LAS float*)(F.lds + RING_OFF + F.wave * 16384);
    volatile LAS int* slot = (volatile LAS int*)(F.lds + LDSCTL_OFF + 64);
    for (int bt = 0; bt < max_batches; ++bt) {
        if (F.tid == 0) { int v = -1;
            if (until >= CQ_TOTAL || __hip_atomic_load((unsigned*)(F.ctl + CW_CQ), __ATOMIC_RELAXED, __HIP_MEMORY_SCOPE_AGENT) < (unsigned)until) v = (int)__hip_atomic_fetch_add((unsigned*)(F.ctl + CW_CQ), 16u, __ATOMIC_RELAXED, __HIP_MEMORY_SCOPE_AGENT);
            *slot = v; }
        __syncthreads();
        const int base = __builtin_amdgcn_readfirstlane(*slot);
        __syncthreads();
        if (base < 0 || base >= CQ_TOTAL) break;
        const int q0 = base + F.wave, q1 = (base + 8 < CQ_TOTAL) ? q0 + 8 : q0;
        const TrItem t0 = cq_decode(F, q0), t1 = cq_decode(F, q1);
        float v0[32], v1[32]; p0_item_load(t0, v0, F.lane); p0_item_load(t1, v1, F.lane);
        p0_item_store(t0, v0, scr, F.lane); p0_item_store(t1, v1, scr, F.lane);
    }
    __syncthreads();
}
__device__ __forceinline__ bool cq_batch8(Frame& F) {
    LAS float* scr = (LAS float*)(F.lds + RING_OFF + F.wave * 16384);
    volatile LAS int* slot = (volatile LAS int*)(F.lds + LDSCTL_OFF + 64);
    if (F.tid == 0) *slot = (int)__hip_atomic_fetch_add((unsigned*)(F.ctl + CW_CQ), 8u, __ATOMIC_RELAXED, __HIP_MEMORY_SCOPE_AGENT);
    __syncthreads();
    const int base = __builtin_amdgcn_readfirstlane(*slot);
    __syncthreads();
    if (base >= CQ_TOTAL) return false;
    const TrItem t0 = cq_decode(F, base + F.wave);
    float v0[32]; p0_item_load(t0, v0, F.lane); p0_item_store(t0, v0, scr, F.lane);
    return true;
}
__device__ __forceinline__ void xcd_barrier_host(Frame& F, const XcdBarrier& b) {
    asm volatile("s_waitcnt vmcnt(0)" ::: "memory");
    __syncthreads();
    volatile LAS unsigned* hw = (volatile LAS unsigned*)(F.lds + LDSCTL_OFF + 68);
    unsigned gen = 0u, tg = 0u; bool leader = false, last = false;
    if (threadIdx.x == 0) {
        unsigned* bar = b.bar;
        __builtin_amdgcn_s_waitcnt(0);
        unsigned nloc = b.st[0], nx = b.st[1];
        if (nloc == 0u) { xcd_barrier_complete(bar, b.x, nloc, nx); b.st[0] = nloc; b.st[1] = nx; }
        const unsigned old = xb_add(&bar[XB_XSUB(b.x)], 1u);
        gen = old / nloc; leader = (old + 1u == (gen + 1u) * nloc);
        if (leader) {
            __builtin_amdgcn_fence(__ATOMIC_RELEASE, "agent");
            asm volatile("s_waitcnt vmcnt(0)" ::: "memory");
            const unsigned og = xb_add(&bar[XB_TOP], 1u);
            tg = og / nx; last = (og + 1u == (tg + 1u) * nx);
            if (last) xb_add(&bar[XB_TOPGEN], 1u);
        }
        hw[0] = leader ? 1u : 0u;
    }
    __syncthreads();
    if (hw[0] == 0u) {
        for (;;) {
            if (hw[1] != 0u) break;
            if (!cq_batch8(F)) { if (threadIdx.x == 0) hw[1] = 1u; break; }
            asm volatile("s_waitcnt vmcnt(0)" ::: "memory");
            if (threadIdx.x == 0) hw[2] = (xb_ld(&b.bar[XB_XGEN(b.x)]) == gen) ? 0u : 1u;
            __syncthreads();
            const unsigned rel = hw[2];
            __syncthreads();
            if (rel != 0u) break;
        }
    }
    if (threadIdx.x == 0) {
        unsigned* bar = b.bar;
        if (leader) {
            if (!last) XB_SPIN(xb_ld(&bar[XB_TOPGEN]) == tg, bar);
            __builtin_amdgcn_fence(__ATOMIC_ACQUIRE, "agent");
            xb_add(&bar[XB_XGEN(b.x)], 1u);
            asm volatile("s_waitcnt vmcnt(0)" ::: "memory");
        } else {
            XB_SPIN(xb_ld(&bar[XB_XGEN(b.x)]) == gen, bar);
            __builtin_amdgcn_fence(__ATOMIC_ACQUIRE, "agent");
            asm volatile("s_waitcnt vmcnt(0)" ::: "memory");
        }
    }
    __syncthreads();
}
__device__ __forceinline__ void p0_prologue(Frame& F) {
    LAS float* scr = (LAS float*)(F.lds + RING_OFF + F.wave * 16384);
    const int gw = F.vcu * NWAVES + F.wave, NGW = F.G * NWAVES;
    {   constexpr int NIT = CQ_Q0;
        float va[32], vb[32]; int it = gw;
        TrItem ta = p0_item_decode(F, it < NIT ? it : NIT - 1), tb = ta;
        p0_item_load(ta, va, F.lane);
        while (it < NIT) {
            const int i1 = it + NGW; tb = p0_item_decode(F, i1 < NIT ? i1 : NIT - 1); p0_item_load(tb, vb, F.lane);
            p0_item_store(ta, va, scr, F.lane);
            if (i1 >= NIT) break;
            const int i2 = i1 + NGW; ta = p0_item_decode(F, i2 < NIT ? i2 : NIT - 1); p0_item_load(ta, va, F.lane);
            p0_item_store(tb, vb, scr, F.lane);
            it = i2;
        }
    }
    __syncthreads();
    LAS float* red = (LAS float*)(F.lds + RING_OFF);
    LAS float* sil = red + 1024;
    for (int i = F.tid; i < 2048; i += NWAVES * 64) { const float c = inp(I_C)[i]; sil[i] = c / (1.0f + __expf(-c)); }
    __syncthreads();
    const int ks = F.tid >> 5, cl = F.tid & 31;
    for (int it = F.vcu; it < NL * 192; it += F.G) {
        const int l = it / 192, cg = it - l * 192; const float* W = inp(I_WADA) + (size_t)l * 1024 * 6144 + cg * 32 + cl + (size_t)(ks * 64) * 6144;
        float wv[64];
#pragma unroll
        for (int k = 0; k < 64; ++k) wv[k] = __builtin_nontemporal_load(W + (size_t)k * 6144);
        float a0 = 0.f, a1 = 0.f;
#pragma unroll
        for (int k = 0; k < 64; k += 4) { const f32x4 s0 = *(const LAS f32x4*)(sil + ks * 64 + k), s1 = *(const LAS f32x4*)(sil + 1024 + ks * 64 + k);
            a0 += s0.x * wv[k] + s0.y * wv[k + 1] + s0.z * wv[k + 2] + s0.w * wv[k + 3]; a1 += s1.x * wv[k] + s1.y * wv[k + 1] + s1.z * wv[k + 2] + s1.w * wv[k + 3]; }
        red[(ks * 2 + 0) * 32 + cl] = a0; red[(ks * 2 + 1) * 32 + cl] = a1;
        __syncthreads();
        if (F.tid < 64) { const int b = F.tid >> 5; float s = inp(I_BADA)[l * 6144 + cg * 32 + cl];
#pragma unroll
            for (int q = 0; q < 16; ++q) s += red[(q * 2 + b) * 32 + cl];
            ((float*)(F.ws + WS_MOD))[(size_t)(l * 2 + b) * 6144 + cg * 32 + cl] = s; }
        __syncthreads();
    }
}
__device__ __forceinline__ const float* modv(Frame& F, int l, int b, int which) { return (const float*)(F.ws + WS_MOD) + (size_t)(l * 2 + b) * 6144 + which * 1024; }

__device__ __forceinline__ void p_norm_in(Frame& F, int l, const float* x) {
    const int gw = F.vcu * NWAVES + F.wave;
    const int r0 = gw * 8, b = r0 >> 13;
    const float* nm = inp(I_NMIX) + l * 1024; const float* sc = modv(F, l, b, 1); const float* sh = modv(F, l, b, 0);
    f32x4 g1[4], g2[4];
#pragma unroll
    for (int j = 0; j < 4; ++j) { const int c = 4 * F.lane + 256 * j; const f32x4 n4 = *(const f32x4*)(nm + c), s4 = *(const f32x4*)(sc + c); g1[j] = n4 * (s4 + 1.0f); g2[j] = *(const f32x4*)(sh + c); }
    for (int rq = r0; rq < r0 + 8; rq += 4) {
        f32x4 v[4][4];
#pragma unroll
        for (int i = 0; i < 4; ++i) { const f32x4* xr = (const f32x4*)(x + (size_t)(rq + i) * D) + F.lane;
#pragma unroll
            for (int j = 0; j < 4; ++j) v[i][j] = __builtin_nontemporal_load(xr + 64 * j); }
#pragma unroll
        for (int i = 0; i < 4; ++i) { float s = 0.f;
#pragma unroll
            for (int j = 0; j < 4; ++j) s += (v[i][j].x * v[i][j].x + v[i][j].y * v[i][j].y) + (v[i][j].z * v[i][j].z + v[i][j].w * v[i][j].w);
            const float rstd = 1.0f / sqrtf(wave_sum(s) * (1.0f / D) + NORM_EPS);
            unsigned long long* o8 = (unsigned long long*)((bf16*)(F.ws + WS_H) + (size_t)(rq + i) * D) + F.lane;
#pragma unroll
            for (int j = 0; j < 4; ++j) { const f32x4 o = v[i][j] * rstd * g1[j] + g2[j]; o8[64 * j] = (unsigned long long)pk2(o.x, o.y) | ((unsigned long long)pk2(o.z, o.w) << 32); } }
    }
}
__device__ __forceinline__ void qknorm_seg(const bf16* p, bf16* dst, const float* gain, float scale, int lane, bool active) {
    v4u w = active ? *(const v4u*)p : (v4u){0u, 0u, 0u, 0u};
    float x[8] = {bflo(w.x), bfhi(w.x), bflo(w.y), bfhi(w.y), bflo(w.z), bfhi(w.z), bflo(w.w), bfhi(w.w)};
    float s = 0.f;
#pragma unroll
    for (int i = 0; i < 8; ++i) s += x[i] * x[i];
    s += __shfl_xor(s, 1); s += __shfl_xor(s, 2); s += __shfl_xor(s, 4);
    const float r = scale / sqrtf(s * (1.0f / 64.0f) + NORM_EPS);
    const int g0 = (lane & 7) * 8;
    const f32x4 ga = *(const f32x4*)(gain + g0), gb = *(const f32x4*)(gain + g0 + 4);
    v4u o; o.x = pk2(x[0] * r * ga.x, x[1] * r * ga.y); o.y = pk2(x[2] * r * ga.z, x[3] * r * ga.w); o.z = pk2(x[4] * r * gb.x, x[5] * r * gb.y); o.w = pk2(x[6] * r * gb.z, x[7] * r * gb.w);
    if (active) *(v4u*)dst = o;
}
__device__ __forceinline__ void p_qknorm(Frame& F, int l) {
    const int gw = F.vcu * NWAVES + F.wave, NGW = F.G * NWAVES;
    bf16* PROJ = (bf16*)(F.ws + WS_PROJ); bf16* QB = (bf16*)(F.ws + WS_XS);
    const float* gq = inp(I_DQN) + l * 64; const float* gk = inp(I_DKN) + l * 64; const float* sq = inp(I_SQN) + l * 64; const float* sk = inp(I_SKN) + l * 64;
    for (int r = gw; r < T; r += NGW) {
        bf16* row = PROJ + (size_t)r * INW + F.lane * 8;
        qknorm_seg(row + 1024, QB + (size_t)r * 512 + F.lane * 8, gq, QSCALE, F.lane, true);
        qknorm_seg(row + 1536, QB + (size_t)T * 512 + (size_t)r * 512 + F.lane * 8, gk, 1.0f, F.lane, true);
        qknorm_seg(row + 2560, row + 2560, sq, QSCALE, F.lane, true);
        qknorm_seg(row + 3072, row + 3072, sk, 1.0f, F.lane, F.lane < 16);
    }
}
constexpr int LRU_LC = 64, LRU_NCH = SEQ / LRU_LC;
struct LruW { float wa[64], wx[64]; float ba, bx, sp8, cw0, cw1, cw2, cw3, cb; };
template <int PASS> __device__ __forceinline__ void lru_unit(Frame& F, const LruW& W, int b, int chunk) {
    const int ch = F.tid; const bf16* PROJ = (const bf16*)(F.ws + WS_PROJ);
    LAS float* xcw = (LAS float*)(F.lds + RING_OFF) + F.wave * 1024;
    float* SA = (float*)(F.ws + WS_SUMM); float* SB = SA + 2 * LRU_NCH * 512;
    const int t0 = chunk * LRU_LC; const size_t rowb = (size_t)b * SEQ;
    float hst = 0.f, aprod = 1.f;
    if (PASS == 2) {
        const float* a = SA + (size_t)(b * LRU_NCH) * 512 + ch; const float* bb = SB + (size_t)(b * LRU_NCH) * 512 + ch;
        for (int c = 0; c < chunk; ++c) hst = a[(size_t)c * 512] * hst + bb[(size_t)c * 512];
    }
    float xm3 = 0.f, xm2 = 0.f, xm1 = 0.f;
    if (t0 > 0) { const bf16* p = PROJ + (rowb + t0 - 3) * INW + ch; xm3 = bf1(p[0]); xm2 = bf1(p[INW]); xm1 = bf1(p[2 * INW]); }
    for (int sub = 0; sub < LRU_LC / 16; ++sub) {
        const int ts = t0 + sub * 16;
        float xr[16], xc[16];
#pragma unroll
        for (int i = 0; i < 16; ++i) xr[i] = bf1(PROJ[(rowb + ts + i) * INW + ch]);
#pragma unroll
        for (int i = 0; i < 16; ++i) { xc[i] = W.cb + W.cw0 * xm3 + W.cw1 * xm2 + W.cw2 * xm1 + W.cw3 * xr[i]; xm3 = xm2; xm2 = xm1; xm1 = xr[i]; xcw[i * 64 + F.lane] = xc[i]; }
        float gr[16];
        if (PASS == 2) {
#pragma unroll
            for (int i = 0; i < 16; ++i) gr[i] = bf1(PROJ[(rowb + ts + i) * INW + 512 + ch]);
        }
        LDS_WAIT(); asm volatile("" ::: "memory");
#pragma unroll
        for (int i = 0; i < 16; ++i) {
            float ga = W.ba, gx = W.bx;
#pragma unroll
            for (int q = 0; q < 16; ++q) { const f32x4 v = *(const LAS f32x4*)(xcw + i * 64 + 4 * q);
                ga += v.x * W.wa[4 * q] + v.y * W.wa[4 * q + 1] + v.z * W.wa[4 * q + 2] + v.w * W.wa[4 * q + 3];
                gx += v.x * W.wx[4 * q] + v.y * W.wx[4 * q + 1] + v.z * W.wx[4 * q + 2] + v.w * W.wx[4 * q + 3]; }
            const float rg = 1.0f / (1.0f + __expf(-ga)), ig = 1.0f / (1.0f + __expf(-gx));
            const float la = -W.sp8 * rg; const float a = __expf(la); const float mult = sqrtf(-expm1f(2.0f * la));
            const float bv = xc[i] * ig * mult;
            hst = a * hst + bv;
            if (PASS == 1) aprod *= a;
            if (PASS == 2) { const float g = gr[i]; const float u = 0.7978845608028654f * (g + 0.044715f * g * g * g); const float th = 1.0f - 2.0f / (1.0f + __expf(2.0f * u));
                ((bf16*)(F.ws + WS_BR))[(rowb + ts + i) * 512 + ch] = (bf16)f2bf(hst * 0.5f * g * (1.0f + th)); }
        }
        LDS_WAIT(); asm volatile("" ::: "memory");
    }
    if (PASS == 1) { SA[(size_t)(b * LRU_NCH + chunk) * 512 + ch] = aprod; SB[(size_t)(b * LRU_NCH + chunk) * 512 + ch] = hst; }
}
__device__ __forceinline__ void lru_load_w(Frame& F, int l, LruW& W) {
    const int ch = F.tid, h = F.wave;
    const float* WA = inp(I_LWA) + (size_t)(l * 8 + h) * 4096 + F.lane; const float* WX = inp(I_LWX) + (size_t)(l * 8 + h) * 4096 + F.lane;
#pragma unroll
    for (int i = 0; i < 64; ++i) { W.wa[i] = WA[i * 64]; W.wx[i] = WX[i * 64]; }
    W.ba = inp(I_LBA)[l * 512 + ch]; W.bx = inp(I_LBX)[l * 512 + ch];
    const float lam = inp(I_LLAM)[l * 512 + ch]; W.sp8 = 8.0f * log1pf(__expf(-lam));
    const float* cw = inp(I_CONVW) + (size_t)l * 4 * 512 + ch; W.cw0 = cw[0]; W.cw1 = cw[512]; W.cw2 = cw[1024]; W.cw3 = cw[1536]; W.cb = inp(I_CONVB)[l * 512 + ch];
}
__device__ __forceinline__ int t5_bucket(int d) {
    if (d < 16) return d;
    const float lr = logf((float)d / 16.0f) / logf(8.0f);
    const int v = 16 + (int)(lr * 16.0f);
    return v < 31 ? v : 31;
}
__device__ __forceinline__ void build_tabs(Frame& F) {
    LAS float* tab = (LAS float*)(F.lds + TAB_OFF);
    const float* rb = inp(I_RELB);
    for (int i = F.tid; i < 12 * 128; i += NWAVES * 64) { const int hd = i >> 7, d = i & 127; const int bk = t5_bucket(d);
        float v = rb[bk * 12 + hd]; if (hd < 4) v -= rb[31 * 12 + hd];
        tab[i] = v * LOG2E;
        if (hd >= 4) tab[12 * 128 + (hd - 4) * 192 + 32 + d] = v * LOG2E; }
    for (int i = F.tid; i < 8 * 64; i += NWAVES * 64) { const int hd = i >> 6, g = i & 63; tab[12 * 128 + hd * 192 + (g < 32 ? g : 128 + g)] = -INFINITY; }
    __syncthreads();
}
constexpr int SWA_ROWB = 144;
__device__ __forceinline__ void swa_unit(Frame& F, int l, int b, int kvh, int qblk) {
    const bf16* PROJ = (const bf16*)(F.ws + WS_PROJ);
    LAS unsigned char* Kl = F.lds + RING_OFF; LAS unsigned char* Vl = Kl + 256 * SWA_ROWB;
    const LAS float* tab = (const LAS float*)(F.lds + TAB_OFF) + 4 * 128;
    const size_t rowb = (size_t)b * SEQ; const int tb = qblk * 128;
    for (int i = F.tid; i < 2 * 256 * 8; i += NWAVES * 64) {
        const int tsr = i >> 11, rem = i & 2047, r = rem >> 3, c = rem & 7; const int tpos = tb - 128 + r;
        v4u v = (v4u){0u, 0u, 0u, 0u};
        if (tpos >= 0) v = *(const v4u*)(PROJ + (rowb + tpos) * INW + (tsr ? 3200 : 3072) + kvh * 64 + c * 8);
        *(LAS v4u*)((tsr ? Vl : Kl) + r * SWA_ROWB + c * 16) = v;
    }
    __syncthreads();
    const int g = F.tid >> 7, r = F.tid & 127; const int head = kvh * 4 + g; const int tq = tb + r;
    float q[64];
    { const bf16* qp = PROJ + (rowb + tq) * INW + 2560 + head * 64;
#pragma unroll
      for (int c = 0; c < 8; ++c) { const v4u w = *(const v4u*)(qp + c * 8); q[8 * c] = bflo(w.x); q[8 * c + 1] = bfhi(w.x); q[8 * c + 2] = bflo(w.y); q[8 * c + 3] = bfhi(w.y); q[8 * c + 4] = bflo(w.z); q[8 * c + 5] = bfhi(w.z); q[8 * c + 6] = bflo(w.w); q[8 * c + 7] = bfhi(w.w); } }
    const float sink2 = inp(I_SINK)[l * 8 + head] * LOG2E;
    float mx = sink2, lsum = 1.0f; float o[64];
#pragma unroll
    for (int d = 0; d < 64; ++d) o[d] = 0.f;
    const LAS float* tb_h = tab + head * 128;
    for (int dist = 127; dist >= 0; --dist) {
        if (tq - dist < 0) continue;
        const int br = 128 + r - dist;
        const LAS unsigned char* kr = Kl + br * SWA_ROWB; float s = 0.f;
#pragma unroll
        for (int c = 0; c < 8; ++c) { const v4u w = *(const LAS v4u*)(kr + c * 16);
            s += q[8 * c] * bflo(w.x) + q[8 * c + 1] * bfhi(w.x) + q[8 * c + 2] * bflo(w.y) + q[8 * c + 3] * bfhi(w.y) + q[8 * c + 4] * bflo(w.z) + q[8 * c + 5] * bfhi(w.z) + q[8 * c + 6] * bflo(w.w) + q[8 * c + 7] * bfhi(w.w); }
        s += tb_h[dist];
        const float mn = fmaxf(mx, s); const float f = __builtin_amdgcn_exp2f(mx - mn), p = __builtin_amdgcn_exp2f(s - mn);
        lsum = lsum * f + p; mx = mn;
        const LAS unsigned char* vr = Vl + br * SWA_ROWB;
#pragma unroll
        for (int c = 0; c < 8; ++c) { const v4u w = *(const LAS v4u*)(vr + c * 16);
            o[8 * c] = o[8 * c] * f + p * bflo(w.x); o[8 * c + 1] = o[8 * c + 1] * f + p * bfhi(w.x); o[8 * c + 2] = o[8 * c + 2] * f + p * bflo(w.y); o[8 * c + 3] = o[8 * c + 3] * f + p * bfhi(w.y);
            o[8 * c + 4] = o[8 * c + 4] * f + p * bflo(w.z); o[8 * c + 5] = o[8 * c + 5] * f + p * bfhi(w.z); o[8 * c + 6] = o[8 * c + 6] * f + p * bflo(w.w); o[8 * c + 7] = o[8 * c + 7] * f + p * bfhi(w.w); }
    }
    const float inv = 1.0f / lsum;
    bf16* op = (bf16*)(F.ws + WS_BR) + (size_t)2 * T * 512 + (rowb + tq) * 512 + head * 64;
#pragma unroll
    for (int c = 0; c < 8; ++c) { v4u w; w.x = pk2(o[8 * c] * inv, o[8 * c + 1] * inv); w.y = pk2(o[8 * c + 2] * inv, o[8 * c + 3] * inv); w.z = pk2(o[8 * c + 4] * inv, o[8 * c + 5] * inv); w.w = pk2(o[8 * c + 6] * inv, o[8 * c + 7] * inv); *(v4u*)(op + c * 8) = w; }
    __syncthreads();
}
__device__ __forceinline__ void p_diffpost(Frame& F, int l) {
    const int gw = F.vcu * NWAVES + F.wave, NGW = F.G * NWAVES;
    const float* lv = inp(I_DLAM) + l * 256;
    const float s1 = wave_sum(lv[F.lane] * lv[64 + F.lane]), s2 = wave_sum(lv[128 + F.lane] * lv[192 + F.lane]);
    const float lam_init = 0.8f - 0.6f * expf(-0.3f * (float)l);
    const float lam = expf(s1) - expf(s2) + lam_init;
    const int h = F.lane >> 4, e0 = (F.lane & 15) * 8;
    const float* sg = inp(I_DSUB) + l * 128 + e0; const f32x4 ga = *(const f32x4*)sg, gb = *(const f32x4*)(sg + 4);
    const float post = 1.0f - lam_init;
    const bf16* ODT = (const bf16*)(F.ws + WS_ODT); bf16* BR1 = (bf16*)(F.ws + WS_BR) + (size_t)T * 512;
    for (int rb = gw; rb < T; rb += 8 * NGW) {
        v4u w0[8], w1[8];
#pragma unroll
        for (int i = 0; i < 8; ++i) { const int r = rb + i * NGW, rc = r < T ? r : rb; w0[i] = __builtin_nontemporal_load((const v4u*)(ODT + (size_t)rc * 1024 + h * 256 + e0)); w1[i] = __builtin_nontemporal_load((const v4u*)(ODT + (size_t)rc * 1024 + h * 256 + 128 + e0)); }
#pragma unroll
        for (int i = 0; i < 8; ++i) { const int r = rb + i * NGW;
            float x[8] = {bflo(w0[i].x) - lam * bflo(w1[i].x), bfhi(w0[i].x) - lam * bfhi(w1[i].x), bflo(w0[i].y) - lam * bflo(w1[i].y), bfhi(w0[i].y) - lam * bfhi(w1[i].y),
                          bflo(w0[i].z) - lam * bflo(w1[i].z), bfhi(w0[i].z) - lam * bfhi(w1[i].z), bflo(w0[i].w) - lam * bflo(w1[i].w), bfhi(w0[i].w) - lam * bfhi(w1[i].w)};
            float s = 0.f;
#pragma unroll
            for (int k = 0; k < 8; ++k) s += x[k] * x[k];
            s += __shfl_xor(s, 1); s += __shfl_xor(s, 2); s += __shfl_xor(s, 4); s += __shfl_xor(s, 8);
            const float rs = post / sqrtf(s * (1.0f / 128.0f) + NORM_EPS);
            v4u o; o.x = pk2(x[0] * rs * ga.x, x[1] * rs * ga.y); o.y = pk2(x[2] * rs * ga.z, x[3] * rs * ga.w); o.z = pk2(x[4] * rs * gb.x, x[5] * rs * gb.y); o.w = pk2(x[6] * rs * gb.z, x[7] * rs * gb.w);
            if (r < T) *(v4u*)(BR1 + (size_t)r * 512 + h * 128 + e0) = o; }
    }
}
typedef short mbf16x8 __attribute__((ext_vector_type(8)));
typedef float mf32x16 __attribute__((ext_vector_type(16)));
__device__ __forceinline__ int crow16(int r, int hi) { return (r & 3) + 8 * (r >> 2) + 4 * hi; }
__device__ __forceinline__ unsigned cvtpk(float lo, float hi) { typedef float f2_t __attribute__((ext_vector_type(2))); typedef __bf16 b2_t __attribute__((ext_vector_type(2))); f2_t v = {lo, hi}; b2_t b = __builtin_convertvector(v, b2_t); return __builtin_bit_cast(unsigned, b); }
#define MFMA32(a, b, c) __builtin_amdgcn_mfma_f32_32x32x16_bf16(a, b, c, 0, 0, 0)
constexpr int SWK_ROWB = 144, SWV_ROWB = 528;
__device__ __forceinline__ void swa_unit_mfma(Frame& F, int l, int b, int kvh, int qblk) {
    const bf16* PROJ = (const bf16*)(F.ws + WS_PROJ);
    LAS unsigned char* Kl = F.lds + RING_OFF; LAS unsigned char* Vt = Kl + 256 * SWK_ROWB;
    const size_t rowb = (size_t)b * SEQ; const int tb = qblk * 128;
    mbf16x8 qall[2][4];
    { const int g_ = F.wave >> 1, qh_ = F.wave & 1, head_ = kvh * 4 + g_, r32_ = F.lane & 31, hi_ = F.lane >> 5;
#pragma unroll
      for (int sb = 0; sb < 2; ++sb) { const bf16* qp = PROJ + (rowb + tb + 64 * qh_ + 32 * sb + r32_) * INW + 2560 + head_ * 64 + 8 * hi_;
#pragma unroll
          for (int ks = 0; ks < 4; ++ks) qall[sb][ks] = *(const mbf16x8*)(qp + 16 * ks); } }
#pragma unroll
    for (int it = 0; it < 4; ++it) { const int i = F.tid + 512 * it, r = i & 255, c = i >> 8; const int tpos = tb - 128 + r;
        v4u kv = (v4u){0u, 0u, 0u, 0u}, vv = kv;
        if (tpos >= 0) { const bf16* p = PROJ + (rowb + tpos) * INW + kvh * 64 + c * 8; kv = *(const v4u*)(p + 3072); vv = *(const v4u*)(p + 3200); }
        *(LAS v4u*)(Kl + r * SWK_ROWB + c * 16) = kv;
        LAS unsigned short* vt = (LAS unsigned short*)(Vt + (8 * c) * SWV_ROWB + 2 * r);
        vt[0 * (SWV_ROWB / 2)] = (unsigned short)(vv.x & 0xffffu); vt[1 * (SWV_ROWB / 2)] = (unsigned short)(vv.x >> 16);
        vt[2 * (SWV_ROWB / 2)] = (unsigned short)(vv.y & 0xffffu); vt[3 * (SWV_ROWB / 2)] = (unsigned short)(vv.y >> 16);
        vt[4 * (SWV_ROWB / 2)] = (unsigned short)(vv.z & 0xffffu); vt[5 * (SWV_ROWB / 2)] = (unsigned short)(vv.z >> 16);
        vt[6 * (SWV_ROWB / 2)] = (unsigned short)(vv.w & 0xffffu); vt[7 * (SWV_ROWB / 2)] = (unsigned short)(vv.w >> 16); }
    __syncthreads();
    const int g = F.wave >> 1, qh = F.wave & 1, head = kvh * 4 + g, r32 = F.lane & 31, hi = F.lane >> 5;
    const LAS float* tabh = (const LAS float*)(F.lds + TAB_OFF) + (4 + head) * 128;
    const float sink2 = inp(I_SINK)[l * 8 + head] * LOG2E;
    bf16* OUT = (bf16*)(F.ws + WS_BR) + (size_t)2 * T * 512;
#pragma unroll 1
    for (int sb = 0; sb < 2; ++sb) {
        const int r0 = 64 * qh + 32 * sb, kb0 = r0 >> 5;
        mbf16x8 qr[4];
#pragma unroll
        for (int ks = 0; ks < 4; ++ks) qr[ks] = sb == 0 ? qall[0][ks] : qall[1][ks];
        mf32x16 p[5];
#pragma unroll
        for (int kk = 0; kk < 5; ++kk) { p[kk] = (mf32x16){};
            const LAS unsigned char* kp = Kl + (32 * (kb0 + kk) + r32) * SWK_ROWB + 16 * hi;
#pragma unroll
            for (int ks = 0; ks < 4; ++ks) { const mbf16x8 kf = *(const LAS mbf16x8*)(kp + 32 * ks); p[kk] = MFMA32(kf, qr[ks], p[kk]); } }
        const int qpos = 128 + r0 + r32; float mx = -INFINITY;
        {
            const LAS float* tl = (const LAS float*)(F.lds + TAB_OFF) + 12 * 128 + head * 192 + (32 + 128 + r32 - 4 * hi - 159);
            const int lim = (qblk > 0 ? 0 : 128) - 32 * kb0 - 4 * hi;
#pragma unroll
            for (int kk = 0; kk < 5; ++kk) {
#pragma unroll
                for (int r = 0; r < 16; ++r) { const int c = 32 * kk + (r & 3) + 8 * (r >> 2); float s = p[kk][r] + tl[159 - c]; s = c < lim ? -INFINITY : s; p[kk][r] = s; mx = fmaxf(mx, s); }
                asm volatile("" ::: "memory"); }
        }
        mx = fmaxf(mx, __shfl_xor(mx, 32)); mx = fmaxf(mx, sink2);
        float lsum = 0.f;
#pragma unroll
        for (int kk = 0; kk < 5; ++kk)
#pragma unroll
            for (int r = 0; r < 16; ++r) { const float e = __builtin_amdgcn_exp2f(p[kk][r] - mx); p[kk][r] = e; lsum += e; }
        lsum += __shfl_xor(lsum, 32); lsum += __builtin_amdgcn_exp2f(sink2 - mx);
        mf32x16 o[2]; o[0] = (mf32x16){}; o[1] = (mf32x16){};
#pragma unroll
        for (int kk = 0; kk < 5; ++kk)
#pragma unroll
            for (int s = 0; s < 2; ++s) {
                v4u pw; pw.x = cvtpk(p[kk][8 * s], p[kk][8 * s + 1]); pw.y = cvtpk(p[kk][8 * s + 2], p[kk][8 * s + 3]); pw.z = cvtpk(p[kk][8 * s + 4], p[kk][8 * s + 5]); pw.w = cvtpk(p[kk][8 * s + 6], p[kk][8 * s + 7]);
                const mbf16x8 pa = __builtin_bit_cast(mbf16x8, pw);
#pragma unroll
                for (int db = 0; db < 2; ++db) { const LAS unsigned char* vp = Vt + (32 * db + r32) * SWV_ROWB + (32 * (kb0 + kk) + 16 * s + 4 * hi) * 2;
                    const v2u lo = *(const LAS v2u*)vp, hi2 = *(const LAS v2u*)(vp + 16);
                    const v4u vw = (v4u){lo.x, lo.y, hi2.x, hi2.y};
                    o[db] = MFMA32(pa, __builtin_bit_cast(mbf16x8, vw), o[db]); } }
        const float linv = 1.0f / lsum;
#pragma unroll
        for (int r = 0; r < 16; ++r) { const int q = crow16(r, hi); const float li = __shfl(linv, q);
            bf16* op = OUT + (rowb + tb + r0 + q) * 512 + head * 64 + r32;
            op[0] = (bf16)f2bf(o[0][r] * li); op[32] = (bf16)f2bf(o[1][r] * li); }
    }
    __syncthreads();
}
constexpr int LRX_ROWB = 144;
struct LruM { mbf16x8 wb[2][2][4]; float ba[2], bx[2], sp8[2]; float cw0, cw1, cw2, cw3, cb; };
__device__ __forceinline__ void lru_load_m(Frame& F, int l, LruM& W) {
    const int h = F.wave, r32 = F.lane & 31, hi = F.lane >> 5;
#pragma unroll
    for (int g = 0; g < 2; ++g) { const float* Wg = inp(g == 0 ? I_LWA : I_LWX) + (size_t)(l * 8 + h) * 4096;
        { float wf[2][4][8];
#pragma unroll
          for (int n = 0; n < 2; ++n)
#pragma unroll
            for (int ks = 0; ks < 4; ++ks) { const float* p = Wg + (size_t)(16 * ks + 8 * hi) * 64 + 32 * n + r32;
#pragma unroll
                for (int i = 0; i < 8; ++i) wf[n][ks][i] = p[64 * i]; }
#pragma unroll
          for (int n = 0; n < 2; ++n)
#pragma unroll
            for (int ks = 0; ks < 4; ++ks) { v4u w; w.x = cvtpk(wf[n][ks][0], wf[n][ks][1]); w.y = cvtpk(wf[n][ks][2], wf[n][ks][3]); w.z = cvtpk(wf[n][ks][4], wf[n][ks][5]); w.w = cvtpk(wf[n][ks][6], wf[n][ks][7]);
                asm volatile("" : "+v"(w));
                W.wb[g][n][ks] = __builtin_bit_cast(mbf16x8, w); }
          asm volatile("" ::: "memory"); } }
#pragma unroll
    for (int n = 0; n < 2; ++n) { const int ch = l * 512 + 64 * h + 32 * n + r32; W.ba[n] = inp(I_LBA)[ch]; W.bx[n] = inp(I_LBX)[ch]; W.sp8[n] = 8.0f * LOG2E * log1pf(__expf(-inp(I_LLAM)[ch])); }
    const int chc = 64 * h + F.lane; const float* cw = inp(I_CONVW) + (size_t)l * 4 * 512 + chc; W.cw0 = cw[0]; W.cw1 = cw[512]; W.cw2 = cw[1024]; W.cw3 = cw[1536]; W.cb = inp(I_CONVB)[l * 512 + chc];
}
template <int PASS> __device__ __forceinline__ void lru_unit_m(Frame& F, LruM& W, const int l, const bool loadw, int b, int chunk) {
    const bf16* PROJ = (const bf16*)(F.ws + WS_PROJ);
    LAS unsigned char* xcb = F.lds + RING_OFF + F.wave * (64 * LRX_ROWB);
    float* SA = (float*)(F.ws + WS_SUMM); float* SB = SA + 2 * LRU_NCH * 512;
    const int h = F.wave, r32 = F.lane & 31, hi = F.lane >> 5;
    const int t0 = chunk * LRU_LC; const size_t rowb = (size_t)b * SEQ;
    unsigned* const LBW = (unsigned*)(F.ws + WS_ACT) + ((size_t)((b * LRU_NCH + chunk) * 8 + h) * 64) * 64 + F.lane;
    const int chv = 64 * h + F.lane; unsigned short xraw[64], xh3 = 0, xh2 = 0, xh1 = 0;
    if (t0 > 0) { const bf16* p = PROJ + (rowb + t0 - 3) * INW + chv; xh3 = p[0]; xh2 = p[INW]; xh1 = p[2 * INW]; }
#pragma unroll
    for (int i = 0; i < 64; ++i) xraw[i] = PROJ[(rowb + t0 + i) * INW + chv];
    asm volatile("" ::: "memory");
    if (loadw) lru_load_m(F, l, W);
    float hc[2] = {0.f, 0.f}, ap[2] = {1.f, 1.f};
    if (PASS == 2 && chunk > 0) {
        const int c1 = chunk >> 1, lo = hi ? c1 : 0, cnt = hi ? chunk - c1 : c1, cmax = chunk - c1;
        const float* a = SA + (size_t)(b * LRU_NCH) * 512 + 64 * h + r32; const float* bb = SB + (size_t)(b * LRU_NCH) * 512 + 64 * h + r32;
        float Ac[2] = {1.f, 1.f}, Bc[2] = {0.f, 0.f};
#pragma unroll 1
        for (int c = 0; c < cmax; c += 16) { float ta[2][16], tb[2][16];
#pragma unroll
            for (int n = 0; n < 2; ++n)
#pragma unroll
                for (int i = 0; i < 16; ++i) { const int ci = c + i; const bool ok = ci < cnt; const int idx = lo + (ok ? ci : 0); const float va = a[(size_t)idx * 512 + 32 * n], vb = bb[(size_t)idx * 512 + 32 * n]; ta[n][i] = ok ? va : 1.f; tb[n][i] = ok ? vb : 0.f; }
#pragma unroll
            for (int n = 0; n < 2; ++n)
#pragma unroll
                for (int i = 0; i < 16; ++i) { Bc[n] = ta[n][i] * Bc[n] + tb[n][i]; Ac[n] *= ta[n][i]; } }
#pragma unroll
        for (int n = 0; n < 2; ++n) { const float Ap = __shfl_xor(Ac[n], 32), Bp = __shfl_xor(Bc[n], 32);
            hc[n] = hi ? (Ac[n] * Bp + Bc[n]) : (Ap * Bc[n] + Bp); }
    }
    { float xm3 = bf1(xh3), xm2 = bf1(xh2), xm1 = bf1(xh1);
#pragma unroll
      for (int i = 0; i < 64; ++i) { const float xv = bf1(xraw[i]); const float xc = W.cb + W.cw0 * xm3 + W.cw1 * xm2 + W.cw2 * xm1 + W.cw3 * xv; xm3 = xm2; xm2 = xm1; xm1 = xv;
          *(LAS unsigned short*)(xcb + i * LRX_ROWB + 2 * F.lane) = (unsigned short)f2bf(xc); } }
    LDS_WAIT(); asm volatile("" ::: "memory");
#pragma unroll 1
    for (int mt = 0; mt < 2; ++mt) {
        mbf16x8 af[4];
#pragma unroll
        for (int ks = 0; ks < 4; ++ks) af[ks] = *(const LAS mbf16x8*)(xcb + (32 * mt + r32) * LRX_ROWB + 32 * ks + 16 * hi);
#pragma unroll
        for (int n = 0; n < 2; ++n) {
            unsigned short gqr[16];
            if (PASS == 2) {
#pragma unroll
                for (int r = 0; r < 16; ++r) gqr[r] = PROJ[(rowb + t0 + 32 * mt + crow16(r, hi)) * INW + 512 + 64 * h + 32 * n + r32];
                asm volatile("" ::: "memory"); }
            mf32x16 ga = (mf32x16){}, gx = (mf32x16){};
#pragma unroll
            for (int ks = 0; ks < 4; ++ks) { ga = MFMA32(af[ks], W.wb[0][n][ks], ga); gx = MFMA32(af[ks], W.wb[1][n][ks], gx); }
            float av[16], bv[16];
#pragma unroll
            for (int r = 0; r < 16; ++r) { const int tok = 32 * mt + crow16(r, hi);
                const float xc = bf1(*(const LAS unsigned short*)(xcb + tok * LRX_ROWB + 2 * (32 * n + r32)));
                const float rg = __builtin_amdgcn_rcpf(1.0f + __builtin_amdgcn_exp2f(-LOG2E * (ga[r] + W.ba[n])));
                const float ui = 1.0f + __builtin_amdgcn_exp2f(-LOG2E * (gx[r] + W.bx[n]));
                const float la = -W.sp8[n] * rg; const float a = __builtin_amdgcn_exp2f(la);
                const float tq = fmaxf(1.0f - a * a, 0.f);
                av[r] = a; bv[r] = xc * tq * __builtin_amdgcn_rsqf(fmaxf(tq, 1e-30f) * ui * ui);
                if (PASS == 1) LBW[(size_t)(((mt * 2 + n) * 16 + r) * 64)] = pk2(la, bv[r]); }
            float hh = hc[n], hs[16];
#pragma unroll
            for (int m = 0; m < 4; ++m) {
                const float t0_ = av[4 * m] * hh + bv[4 * m], t1_ = av[4 * m + 1] * t0_ + bv[4 * m + 1], t2_ = av[4 * m + 2] * t1_ + bv[4 * m + 2], t3_ = av[4 * m + 3] * t2_ + bv[4 * m + 3];
                const float hA = __shfl_xor(t3_, 32);
                const float u0_ = av[4 * m] * hA + bv[4 * m], u1_ = av[4 * m + 1] * u0_ + bv[4 * m + 1], u2_ = av[4 * m + 2] * u1_ + bv[4 * m + 2], u3_ = av[4 * m + 3] * u2_ + bv[4 * m + 3];
                const float hB = __shfl_xor(u3_, 32);
                hs[4 * m] = hi ? u0_ : t0_; hs[4 * m + 1] = hi ? u1_ : t1_; hs[4 * m + 2] = hi ? u2_ : t2_; hs[4 * m + 3] = hi ? u3_ : t3_;
                hh = hi ? u3_ : hB; }
            hc[n] = hh;
            if (PASS == 1) {
#pragma unroll
                for (int r = 0; r < 16; ++r) ap[n] *= av[r]; }
            if (PASS == 2) {
#pragma unroll
                for (int r = 0; r < 16; ++r) { const size_t row = rowb + t0 + 32 * mt + crow16(r, hi); const int ch = 64 * h + 32 * n + r32;
                    const float gq = bf1(gqr[r]); const float u2 = 2.0f * 0.7978845608028654f * (gq + 0.044715f * gq * gq * gq);
                    const float ge = gq * __builtin_amdgcn_rcpf(1.0f + __builtin_amdgcn_exp2f(-LOG2E * u2));
                    ((bf16*)(F.ws + WS_BR))[row * 512 + ch] = (bf16)f2bf(hs[r] * ge);
                    } }
        }
    }
    if (PASS == 1) {
#pragma unroll
        for (int n = 0; n < 2; ++n) { const float at = ap[n] * __shfl_xor(ap[n], 32);
            if (hi == 0) { const size_t o = (size_t)(b * LRU_NCH + chunk) * 512 + 64 * h + 32 * n + r32; SA[o] = at; SB[o] = hc[n]; } }
    }
    LDS_WAIT(); asm volatile("" ::: "memory");
}

__device__ __forceinline__ void lru_p2_block(Frame& F, const int mt, const unsigned (&lb)[2][16], const unsigned short (&gqv)[2][16], float (&hc)[2], const size_t rowb, const int t0, const int h, const int r32, const int hi) {
#pragma unroll
    for (int n = 0; n < 2; ++n) {
        float av[16], bv[16];
#pragma unroll
        for (int r = 0; r < 16; ++r) { av[r] = __builtin_amdgcn_exp2f(bflo(lb[n][r])); bv[r] = bfhi(lb[n][r]); }
        float hh = hc[n], hs[16];
#pragma unroll
        for (int m = 0; m < 4; ++m) {
            const float t0_ = av[4 * m] * hh + bv[4 * m], t1_ = av[4 * m + 1] * t0_ + bv[4 * m + 1], t2_ = av[4 * m + 2] * t1_ + bv[4 * m + 2], t3_ = av[4 * m + 3] * t2_ + bv[4 * m + 3];
            const float hA = __shfl_xor(t3_, 32);
            const float u0_ = av[4 * m] * hA + bv[4 * m], u1_ = av[4 * m + 1] * u0_ + bv[4 * m + 1], u2_ = av[4 * m + 2] * u1_ + bv[4 * m + 2], u3_ = av[4 * m + 3] * u2_ + bv[4 * m + 3];
            const float hB = __shfl_xor(u3_, 32);
            hs[4 * m] = hi ? u0_ : t0_; hs[4 * m + 1] = hi ? u1_ : t1_; hs[4 * m + 2] = hi ? u2_ : t2_; hs[4 * m + 3] = hi ? u3_ : t3_;
            hh = hi ? u3_ : hB; }
        hc[n] = hh;
#pragma unroll
        for (int r = 0; r < 16; ++r) { const size_t row = rowb + t0 + 32 * mt + crow16(r, hi); const int ch = 64 * h + 32 * n + r32;
            const float gq = bf1(gqv[n][r]); const float gq2 = gq * gq;
            const float ge = gq * __builtin_amdgcn_rcpf(1.0f + __builtin_amdgcn_exp2f(gq * (-2.302208198090328f - 0.10294324212736315f * gq2)));
            ((bf16*)(F.ws + WS_BR))[row * 512 + ch] = (bf16)f2bf(hs[r] * ge); }
    }
}
__device__ __forceinline__ void lru_unit_p2(Frame& F, int b, int chunk) {
    const bf16* PROJ = (const bf16*)(F.ws + WS_PROJ);
    float* SA = (float*)(F.ws + WS_SUMM); float* SB = SA + 2 * LRU_NCH * 512;
    const int h = F.wave, r32 = F.lane & 31, hi = F.lane >> 5;
    const int t0 = chunk * LRU_LC; const size_t rowb = (size_t)b * SEQ;
    const unsigned* const LB = (const unsigned*)(F.ws + WS_ACT) + ((size_t)((b * LRU_NCH + chunk) * 8 + h) * 64) * 64 + F.lane;
    unsigned lb0[2][16], lb1[2][16]; unsigned short gq0[2][16], gq1[2][16];
#pragma unroll
    for (int n = 0; n < 2; ++n)
#pragma unroll
        for (int r = 0; r < 16; ++r) { lb0[n][r] = LB[(size_t)((n * 16 + r) * 64)]; gq0[n][r] = PROJ[(rowb + t0 + crow16(r, hi)) * INW + 512 + 64 * h + 32 * n + r32]; }
    asm volatile("" ::: "memory");
    float hc[2] = {0.f, 0.f};
    if (chunk > 0) {
        const int c1 = chunk >> 1, lo = hi ? c1 : 0, cnt = hi ? chunk - c1 : c1, cmax = chunk - c1;
        const float* a = SA + (size_t)(b * LRU_NCH) * 512 + 64 * h + r32; const float* bb = SB + (size_t)(b * LRU_NCH) * 512 + 64 * h + r32;
        float Ac[2] = {1.f, 1.f}, Bc[2] = {0.f, 0.f};
#pragma unroll 1
        for (int c = 0; c < cmax; c += 16) { float ta[2][16], tb[2][16];
#pragma unroll
            for (int n = 0; n < 2; ++n)
#pragma unroll
                for (int i = 0; i < 16; ++i) { const int ci = c + i; const bool ok = ci < cnt; const int idx = lo + (ok ? ci : 0); const float va = a[(size_t)idx * 512 + 32 * n], vb = bb[(size_t)idx * 512 + 32 * n]; ta[n][i] = ok ? va : 1.f; tb[n][i] = ok ? vb : 0.f; }
#pragma unroll
            for (int n = 0; n < 2; ++n)
#pragma unroll
                for (int i = 0; i < 16; ++i) { Bc[n] = ta[n][i] * Bc[n] + tb[n][i]; Ac[n] *= ta[n][i]; } }
#pragma unroll
        for (int n = 0; n < 2; ++n) { const float Ap = __shfl_xor(Ac[n], 32), Bp = __shfl_xor(Bc[n], 32);
            hc[n] = hi ? (Ac[n] * Bp + Bc[n]) : (Ap * Bc[n] + Bp); }
    }
#pragma unroll
    for (int n = 0; n < 2; ++n)
#pragma unroll
        for (int r = 0; r < 16; ++r) { lb1[n][r] = LB[(size_t)(((2 + n) * 16 + r) * 64)]; gq1[n][r] = PROJ[(rowb + t0 + 32 + crow16(r, hi)) * INW + 512 + 64 * h + 32 * n + r32]; }
    asm volatile("" ::: "memory");
    lru_p2_block(F, 0, lb0, gq0, hc, rowb, t0, h, r32, hi);
    lru_p2_block(F, 1, lb1, gq1, hc, rowb, t0, h, r32, hi);
}
__device__ __forceinline__ void p_router(Frame& F, int l) {
    LAS float* PART = (LAS float*)(F.lds + RING_OFF);
    LAS float* RSTD = (LAS float*)(F.lds + RING_OFF + 65536);
    LAS float* CVEC = RSTD + 64;
    LAS int* CNT = (LAS int*)(CVEC + 256);
    const bf16* x = (const bf16*)(F.ws + WS_XS) + (size_t)64 * 1024 * 512;
    const int e = F.lane & 31, half = F.lane >> 5;
    const int rows0 = F.vcu * 64; const int b = rows0 >> 13;
    const float* nf = inp(I_NFFN) + l * 1024; const float* sc = modv(F, l, b, 4); const float* sh = modv(F, l, b, 3);
    if (F.tid < 32) CNT[F.tid] = 0;
    v2u xw[8][4];
#pragma unroll
    for (int q = 0; q < 8; ++q) { const v2u* xr = (const v2u*)(x + (size_t)(rows0 + 8 * F.wave + q) * D) + F.lane;
#pragma unroll
        for (int j = 0; j < 4; ++j) xw[q][j] = xr[64 * j]; }
    asm volatile("" ::: "memory");
    { f32x4 g1[4], g2[4];
#pragma unroll
      for (int j = 0; j < 4; ++j) { const int c = 4 * F.lane + 256 * j; const f32x4 n4 = *(const f32x4*)(nf + c), s4 = *(const f32x4*)(sc + c); g1[j] = n4 * (s4 + 1.0f); g2[j] = *(const f32x4*)(sh + c); }
#pragma unroll
      for (int q = 0; q < 8; ++q) { const int lr = 8 * F.wave + q, r = rows0 + lr; f32x4 v[4]; float s = 0.f;
#pragma unroll
          for (int j = 0; j < 4; ++j) { const v2u w = xw[q][j]; v[j] = (f32x4){bflo(w.x), bfhi(w.x), bflo(w.y), bfhi(w.y)}; s += (v[j].x * v[j].x + v[j].y * v[j].y) + (v[j].z * v[j].z + v[j].w * v[j].w); }
          const float rstd = 1.0f / sqrtf(wave_sum(s) * (1.0f / D) + NORM_EPS);
          if (F.lane == 0) RSTD[lr] = rstd;
          unsigned long long* o8 = (unsigned long long*)((bf16*)(F.ws + WS_H) + (size_t)r * D) + F.lane;
#pragma unroll
          for (int j = 0; j < 4; ++j) { const f32x4 o = v[j] * rstd * g1[j] + g2[j]; o8[64 * j] = (unsigned long long)pk2(o.x, o.y) | ((unsigned long long)pk2(o.z, o.w) << 32); } } }
    asm volatile("" ::: "memory");
    mbf16x8 Bh[8], Bl[8]; float cpart = 0.f;
    { const float* wr = inp(I_WR) + (size_t)l * 1024 * 32 + e; const int k0 = 128 * F.wave + 8 * half;
#pragma unroll
      for (int s = 0; s < 8; ++s) { const int kk = k0 + 16 * s;
          const f32x4 n0 = *(const f32x4*)(nf + kk), n1 = *(const f32x4*)(nf + kk + 4), s0 = *(const f32x4*)(sc + kk), s1 = *(const f32x4*)(sc + kk + 4), h0 = *(const f32x4*)(sh + kk), h1 = *(const f32x4*)(sh + kk + 4);
          const f32x4 ga = n0 * (s0 + 1.0f), gb = n1 * (s1 + 1.0f);
          float wp[8];
#pragma unroll
          for (int i = 0; i < 8; ++i) { const float wv = wr[(size_t)(kk + i) * 32]; wp[i] = wv * (i < 4 ? ga[i & 3] : gb[i & 3]); cpart += wv * (i < 4 ? h0[i & 3] : h1[i & 3]); }
          v4u ph, pl;
#pragma unroll
          for (int i = 0; i < 4; ++i) { const unsigned p = pk2(wp[2 * i], wp[2 * i + 1]); ph[i] = p; pl[i] = pk2(wp[2 * i] - bflo(p), wp[2 * i + 1] - bfhi(p)); }
          Bh[s] = __builtin_bit_cast(mbf16x8, ph); Bl[s] = __builtin_bit_cast(mbf16x8, pl);
          if ((s & 3) == 3) asm volatile("" ::: "memory"); } }
    cpart += __shfl_xor(cpart, 32);
    if (half == 0) CVEC[F.wave * 32 + e] = cpart;
    asm volatile("" ::: "memory");
    { const bf16* xa = x + (size_t)(rows0 + e) * D + 128 * F.wave + 8 * half;
      mbf16x8 A0[8], A1[8];
#pragma unroll
      for (int s = 0; s < 8; ++s) { A0[s] = *(const mbf16x8*)(xa + 16 * s); A1[s] = *(const mbf16x8*)(xa + (size_t)32 * D + 16 * s); }
      mf32x16 acc0 = {}, acc1 = {};
#pragma unroll
      for (int s = 0; s < 8; ++s) {
          acc0 = __builtin_amdgcn_mfma_f32_32x32x16_bf16(A0[s], Bh[s], acc0, 0, 0, 0); acc1 = __builtin_amdgcn_mfma_f32_32x32x16_bf16(A1[s], Bh[s], acc1, 0, 0, 0);
          acc0 = __builtin_amdgcn_mfma_f32_32x32x16_bf16(A0[s], Bl[s], acc0, 0, 0, 0); acc1 = __builtin_amdgcn_mfma_f32_32x32x16_bf16(A1[s], Bl[s], acc1, 0, 0, 0); }
#pragma unroll
      for (int r = 0; r < 16; ++r) { const int row = (r & 3) + 8 * (r >> 2) + 4 * half; PART[(F.wave * 64 + row) * 32 + e] = acc0[r]; PART[(F.wave * 64 + 32 + row) * 32 + e] = acc1[r]; } }
    __syncthreads();
    { float cv = inp(I_BR)[l * 32 + e];
#pragma unroll
      for (int w = 0; w < 8; ++w) cv += CVEC[w * 32 + e];
#pragma unroll
      for (int it = 0; it < 4; ++it) { const int lr = 8 * F.wave + 2 * it + half, r = rows0 + lr; float a = 0.f;
#pragma unroll
          for (int w = 0; w < 8; ++w) a += PART[(w * 64 + lr) * 32 + e];
          const float lg = a * RSTD[lr] + cv;
          int rk = 0;
#pragma unroll
          for (int o = 1; o < 32; ++o) { const float ov = __shfl_xor(lg, o); rk += (ov > lg || (ov == lg && (e ^ o) < e)) ? 1 : 0; }
          float tv[4]; int te[4];
#pragma unroll
          for (int k = 0; k < 4; ++k) { const unsigned long long m = __ballot(rk == k); const unsigned mh = (unsigned)(m >> (32 * half)); const int src = (mh ? __builtin_ctz(mh) : 0) + 32 * half; tv[k] = __shfl(lg, src); te[k] = src & 31; }
          const float p1 = __expf(tv[1] - tv[0]), p2 = __expf(tv[2] - tv[0]), p3 = __expf(tv[3] - tv[0]); const float inv = 1.0f / (1.0f + p1 + p2 + p3);
          if (e < 4) { const float pw = e == 0 ? 1.0f : (e == 1 ? p1 : (e == 2 ? p2 : p3)); const int ee = e == 0 ? te[0] : (e == 1 ? te[1] : (e == 2 ? te[2] : te[3]));
              const int rank = atomicAdd((int*)(CNT + ee), 1);
              ((float*)(F.ws + WS_TOPW))[(size_t)r * 4 + e] = pw * inv;
              ((unsigned*)(F.ws + WS_ERANK))[(size_t)r * 4 + e] = ((unsigned)ee << 20) | (unsigned)rank; } } }
    __syncthreads();
    if (F.tid < 32) ((int*)(F.ws + WS_BLKCNT))[F.vcu * 32 + F.tid] = CNT[F.tid];
}
__device__ __forceinline__ void p_scatter(Frame& F) {
    LAS int* S16 = (LAS int*)(F.lds + RING_OFF);
    LAS int* SLOTB = S16 + 512;
    LAS int* TOT = SLOTB + 32;
    const int* BC = (const int*)(F.ws + WS_BLKCNT);
    const int e = F.tid & 31, part = F.tid >> 5;
    const unsigned er_pre = F.tid < 256 ? ((const unsigned*)(F.ws + WS_ERANK))[(size_t)(F.vcu * 64 + (F.tid >> 2)) * 4 + (F.tid & 3)] : 0u;
    LAS int* PRE = TOT + 32;
    { int s = 0, pre = 0;
#pragma unroll
      for (int q = 0; q < 16; ++q) { const int bb = part * 16 + q; const int v = bb < F.G ? BC[bb * 32 + e] : 0; s += v; if (bb < F.vcu) pre += v; }
      S16[part * 32 + e] = s; if (part == (F.vcu >> 4)) PRE[e] = pre; }
    __syncthreads();
    if (F.tid < 32) { int tot = 0, base = 0; const int mp = F.vcu >> 4;
        for (int q = 0; q < 16; ++q) { tot += S16[q * 32 + e]; if (q < mp) base += S16[q * 32 + e]; }
        TOT[e] = tot; SLOTB[e] = base + PRE[e]; }
    __syncthreads();
    if (F.tid < 64) {
        const int ee = F.tid & 31; const int nt = (TOT[ee] + 255) >> 8; int inc = nt;
#pragma unroll
        for (int o = 1; o < 32; o <<= 1) { const int v = __shfl_up(inc, o, 32); if (ee >= o) inc += v; }
        const int t0 = inc - nt;
        if (F.tid < 32) { SLOTB[ee] += t0 << 8;
            if (F.vcu == 0) { int* tm = (int*)(F.ws + WS_TILEMAP); for (int j = 0; j < nt; ++j) tm[1 + t0 + j] = ee; if (ee == 31) tm[0] = inc; } } }
    __syncthreads();
    const unsigned* ER = (const unsigned*)(F.ws + WS_ERANK); int* DEST = (int*)(F.ws + WS_DEST); int* ROWTOK = (int*)(F.ws + WS_ROWTOK);
    const int rows0 = F.vcu * 64;
    if (F.tid < 256) {
        const int p = F.tid, r = rows0 + (p >> 2), k = p & 3; const unsigned er = er_pre; const int slot = SLOTB[er >> 20] + (int)(er & 0xfffffu);
        DEST[(size_t)r * 4 + k] = slot; ROWTOK[slot] = r; }
}
__device__ __forceinline__ void p_combine(Frame& F, int l, bool next_norm) {
    const int gw = F.vcu * NWAVES + F.wave; const int r0 = gw * 8, b = r0 >> 13;
    const float* gf = modv(F, l, b, 5);
    const int c0 = 8 * F.lane;
    f32x4 gfv[2][2], g1[2][2], g2[2][2];
#pragma unroll
    for (int j = 0; j < 2; ++j)
#pragma unroll
        for (int q = 0; q < 2; ++q) { const int c = c0 + 512 * j + 4 * q; gfv[j][q] = *(const f32x4*)(gf + c);
            if (next_norm) { const f32x4 n4 = *(const f32x4*)(inp(I_NMIX) + (l + 1) * 1024 + c), s4 = *(const f32x4*)(modv(F, l + 1, b, 1) + c); g1[j][q] = n4 * (s4 + 1.0f); g2[j][q] = *(const f32x4*)(modv(F, l + 1, b, 0) + c); }
            else { g1[j][q] = (f32x4){0.f, 0.f, 0.f, 0.f}; g2[j][q] = g1[j][q]; } }
    const float* TW = (const float*)(F.ws + WS_TOPW); const int* DEST = (const int*)(F.ws + WS_DEST); const bf16* Y = (const bf16*)(F.ws + WS_Y);
    const bf16* XR1 = (const bf16*)(F.ws + WS_XS) + (size_t)64 * 1024 * 512; bf16* XR2 = (bf16*)(F.ws + WS_XS) + (size_t)96 * 1024 * 512;
    float tws[8][4]; int dss[8][4];
#pragma unroll
    for (int i = 0; i < 8; ++i) { const f32x4 t4 = *(const f32x4*)(TW + (size_t)(r0 + i) * 4); const v4u d4 = *(const v4u*)(DEST + (size_t)(r0 + i) * 4);
#pragma unroll
        for (int k = 0; k < 4; ++k) { tws[i][k] = __uint_as_float(__builtin_amdgcn_readfirstlane(__float_as_uint(t4[k]))); dss[i][k] = __builtin_amdgcn_readfirstlane((int)d4[k]); } }
#pragma unroll
    for (int i = 0; i < 8; ++i) { const int r = r0 + i;
        const f32x4 tw = (f32x4){tws[i][0], tws[i][1], tws[i][2], tws[i][3]}; const int d0 = dss[i][0], d1 = dss[i][1], d2 = dss[i][2], d3 = dss[i][3];
        f32x4 xo[2][2]; float ss = 0.f;
#pragma unroll
        for (int j = 0; j < 2; ++j) {
            const v4u y0 = __builtin_nontemporal_load((const v4u*)(Y + (size_t)d0 * D + c0 + 512 * j)), y1 = __builtin_nontemporal_load((const v4u*)(Y + (size_t)d1 * D + c0 + 512 * j)), y2 = __builtin_nontemporal_load((const v4u*)(Y + (size_t)d2 * D + c0 + 512 * j)), y3 = __builtin_nontemporal_load((const v4u*)(Y + (size_t)d3 * D + c0 + 512 * j));
            f32x4 m0, m1;
            m0.x = tw.x * bflo(y0.x) + tw.y * bflo(y1.x) + tw.z * bflo(y2.x) + tw.w * bflo(y3.x); m0.y = tw.x * bfhi(y0.x) + tw.y * bfhi(y1.x) + tw.z * bfhi(y2.x) + tw.w * bfhi(y3.x);
            m0.z = tw.x * bflo(y0.y) + tw.y * bflo(y1.y) + tw.z * bflo(y2.y) + tw.w * bflo(y3.y); m0.w = tw.x * bfhi(y0.y) + tw.y * bfhi(y1.y) + tw.z * bfhi(y2.y) + tw.w * bfhi(y3.y);
            m1.x = tw.x * bflo(y0.z) + tw.y * bflo(y1.z) + tw.z * bflo(y2.z) + tw.w * bflo(y3.z); m1.y = tw.x * bfhi(y0.z) + tw.y * bfhi(y1.z) + tw.z * bfhi(y2.z) + tw.w * bfhi(y3.z);
            m1.z = tw.x * bflo(y0.w) + tw.y * bflo(y1.w) + tw.z * bflo(y2.w) + tw.w * bflo(y3.w); m1.w = tw.x * bfhi(y0.w) + tw.y * bfhi(y1.w) + tw.z * bfhi(y2.w) + tw.w * bfhi(y3.w);
            const size_t xo_ = (size_t)r * D + c0 + 512 * j; const v4u xw = __builtin_nontemporal_load((const v4u*)(XR1 + xo_));
            xo[j][0] = (f32x4){bflo(xw.x), bfhi(xw.x), bflo(xw.y), bfhi(xw.y)} + gfv[j][0] * m0; xo[j][1] = (f32x4){bflo(xw.z), bfhi(xw.z), bflo(xw.w), bfhi(xw.w)} + gfv[j][1] * m1;
            if (next_norm) { v4u ow; ow.x = pk2(xo[j][0].x, xo[j][0].y); ow.y = pk2(xo[j][0].z, xo[j][0].w); ow.z = pk2(xo[j][1].x, xo[j][1].y); ow.w = pk2(xo[j][1].z, xo[j][1].w); *(v4u*)(XR2 + xo_) = ow; }
            else { *(f32x4*)(F.out + xo_) = xo[j][0]; *(f32x4*)(F.out + xo_ + 4) = xo[j][1]; }
#pragma unroll
            for (int q = 0; q < 2; ++q) ss += (xo[j][q].x * xo[j][q].x + xo[j][q].y * xo[j][q].y) + (xo[j][q].z * xo[j][q].z + xo[j][q].w * xo[j][q].w);
        }
        if (next_norm) {
            const float rstd = 1.0f / sqrtf(wave_sum(ss) * (1.0f / D) + NORM_EPS);
#pragma unroll
            for (int j = 0; j < 2; ++j) { const f32x4 a = xo[j][0] * rstd * g1[j][0] + g2[j][0], c = xo[j][1] * rstd * g1[j][1] + g2[j][1];
                v4u w; w.x = pk2(a.x, a.y); w.y = pk2(a.z, a.w); w.z = pk2(c.x, c.y); w.w = pk2(c.z, c.w);
                *(v4u*)((bf16*)(F.ws + WS_H) + (size_t)r * D + c0 + 512 * j) = w; }
        }
    }
}
#ifndef CQ_PER_ROUND
#define CQ_PER_ROUND 3
#endif
#ifndef MOE_XCD_ROUNDS
#define MOE_XCD_ROUNDS 1
#endif
#if MOE_XCD_ROUNDS
#define MOE_C(b) ((((b) & 7) << 5) | ((b) >> 3))
#else
#define MOE_C(b) (b)
#endif
#ifndef GEMM_SP2
#define GEMM_SP2 true
#endif
#ifndef ATTN_HAND
#define ATTN_HAND 1
#endif
#if ATTN_HAND
#define ATTN_CALL(l_, q_, o_, t_, v_, i_) attn2::attn_phase<8>(l_, (const attn2::bf16*)(q_), (attn2::bf16*)(o_), t_, v_, i_, attn_fast)
#else
#define ATTN_CALL(l_, q_, o_, t_, v_, i_) (void)attn_fast; da::phase(l_, (const da::bf16*)(q_), (da::bf16*)(o_), t_, v_, i_)
#endif
#ifndef XCD_CHUNKED
#define XCD_CHUNKED 0
#endif
#if XCD_CHUNKED
#define XCDMAP_VCU(bx, G) (bx)
#define XCDMAP_C(b) (((b) % 32) * 8 + (b) / 32)
#else
#define XCDMAP_VCU(bx, G) (((G) % 8 == 0) ? ((bx) % 8) * ((G) / 8) + (bx) / 8 : (bx))
#define XCDMAP_C(b) (b)
#endif
constexpr int N_PHASES = 2 + 11 * NL;
__device__ __forceinline__ void RETID_(Frame& F) { int t_ = threadIdx.x; asm volatile("" : "+v"(t_)); F.tid = t_; F.lane = t_ & 63; F.wave = __builtin_amdgcn_readfirstlane(t_ >> 6); }
struct Args { const float* in[30]; float* out; unsigned char* ws; int ph_lo, ph_hi, li, pad; };
#ifndef PHMASK
#define PHMASK 0x1fff
#endif
#define EN(j) (((PHMASK) >> (j)) & 1)
#ifndef REPMASK
#define REPMASK 0
#endif
#define REPS(j) (1 + (((REPMASK) >> (j)) & 1))
#define RETID() do { int t_ = threadIdx.x; asm volatile("" : "+v"(t_)); F.tid = t_; F.lane = t_ & 63; F.wave = __builtin_amdgcn_readfirstlane(t_ >> 6); } while (0)
#define IN(k) (lo <= (k) && (k) < hi && (RETID_(F), true))
#ifndef MOE_MERGE
#define MOE_MERGE 2
#endif
#ifndef BAR_REPS
#define BAR_REPS 1
#endif
#ifndef BAR_HOST
#define BAR_HOST 1
#endif
#define SEAM(k) do { if (IN(k) && IN((k) + 1)) { if (BAR_HOST) { RETID_(F); xcd_barrier_host(F, bar); } else xcd_barrier(bar); } } while (0)
#define H ((bf16*)(F.ws + WS_H))
#define PROJ ((bf16*)(F.ws + WS_PROJ))
#define BRB ((bf16*)(F.ws + WS_BR))
#define MERGED ((bf16*)(F.ws + WS_MERGED))
#define XS ((bf16*)(F.ws + WS_XS))
#define ACT ((bf16*)(F.ws + WS_ACT))
#define YB ((bf16*)(F.ws + WS_Y))

template <int l> __device__ __forceinline__ void layer_phases(Frame& F, const XcdBarrier& bar, const int lo, const int hi, unsigned char* lds) {
        const int pb = 2 + 11 * l;
        if (lo >= pb + 11 || hi <= pb) return;
        if (EN(2) && IN(pb + 0)) {
            pg8::Gemm g{H, (const bf16*)(F.ws + WS_WIN) + (size_t)l * INW * 1024, T, INW, 1024}; pg8::StaticOrder S; S.init(T, INW, F.G, XCDMAP_C((int)blockIdx.x));
            pg8::EpiIn E{PROJ, INW, 13, (bf16*)(F.ws + WS_XS), inp(I_DQN) + l * 64, inp(I_DKN) + l * 64, inp(I_SQN) + l * 64, inp(I_SKN) + l * 64, (LAS float*)(F.lds + LDSCTL_OFF + 4096), QSCALE, NORM_EPS};
            for (int rep = 0; rep < REPS(2); ++rep) pg8::gemm_phase<pg8::EpiIn, pg8::StaticOrder, true, GEMM_SP2>(F.lds + RING_OFF, g, S, E, F.tid);
            { const int nU = (T / 256) * (INW / 256), c = (int)blockIdx.x; RETID_(F); cq_run(F, ((nU + F.G - 1) / F.G - (c < nU ? (nU - c + F.G - 1) / F.G : 0)) * CQ_PER_ROUND); }
        } SEAM(pb + 0);
        if (EN(4) && IN(pb + 2)) {
#ifndef NO_LRU2
            { LruM W; bool first = true;
              for (int rep = 0; rep < REPS(3); ++rep) for (int u = F.vcu; u < 2 * LRU_NCH; u += F.G) { lru_unit_m<1>(F, W, l, first, u >> 7, u & 127); first = false; } }
#endif
            __syncthreads();
            RETID_(F); build_tabs(F);
            RETID_(F);
#ifndef NO_SWA
            for (int rep = 0; rep < REPS(14); ++rep) for (int u = F.vcu; u < 256; u += F.G) swa_unit_mfma(F, l, u >> 7, (u >> 6) & 1, u & 63);
#endif
            __syncthreads();
#ifndef NO_ATTN
            RETID_(F);
            int attn_fast;
            { const float gqa = fabsf(inp(I_DQN)[l * 64 + F.lane]), gka = fabsf(inp(I_DKN)[l * 64 + F.lane]); float mq = gqa, mk = gka;
              const LAS float* tb = (const LAS float*)(F.lds + TAB_OFF); float mt = 0.f;
#pragma unroll
              for (int i = 0; i < 8; ++i) mt = fmaxf(mt, fabsf(tb[F.lane + 64 * i]));
#pragma unroll
              for (int o = 1; o < 64; o <<= 1) { mq = fmaxf(mq, __shfl_xor(mq, o)); mk = fmaxf(mk, __shfl_xor(mk, o)); mt = fmaxf(mt, __shfl_xor(mt, o)); }
              const float bound = 11.5416f * mq * mk + mt;
              attn_fast = __builtin_amdgcn_readfirstlane((bound <= 100.0f) ? 1 : 0); }
            for (int rep = 0; rep < REPS(4); ++rep) ATTN_CALL((char*)lds + RING_OFF, F.ws + WS_XS, F.ws + WS_ODT, (const float*)(lds + TAB_OFF), F.vcu, F.tid);
#endif
        } SEAM(pb + 2);
        if (EN(5) && IN(pb + 3)) {
            for (int rep = 0; rep < REPS(13); ++rep) for (int u = F.vcu; u < 2 * LRU_NCH; u += F.G) lru_unit_p2(F, u >> 7, u & 127);
            __syncthreads(); RETID_(F);
            for (int rep = 0; rep < REPS(5); ++rep) p_diffpost(F, l);
        } SEAM(pb + 3);
        if (EN(6) && IN(pb + 4)) {
            pg8::Gemm g{BRB, (const bf16*)(F.ws + WS_WBR) + (size_t)l * 3 * 1024 * 512, 3 * T, 1024, 512}; pg8::BranchOrder S; S.init(T, F.G, XCDMAP_C((int)blockIdx.x));
            pg8::EpiBranch E{MERGED, PROJ, INW};
            for (int rep = 0; rep < REPS(6); ++rep) pg8::gemm_phase<pg8::EpiBranch, pg8::BranchOrder, true, GEMM_SP2>(F.lds + RING_OFF, g, S, E, F.tid);
        } SEAM(pb + 4);
        if (EN(7) && IN(pb + 5)) {
            pg8::Gemm g{MERGED, (const bf16*)(F.ws + WS_WOUT) + (size_t)l * 1024 * 1024, T, 1024, 1024}; pg8::StaticOrder S; S.init(T, 1024, F.G, XCDMAP_C((int)blockIdx.x));
            bf16* const XR1 = (bf16*)(F.ws + WS_XS) + (size_t)64 * 1024 * 512; bf16* const XR2 = (bf16*)(F.ws + WS_XS) + (size_t)96 * 1024 * 512;
            if (l == 0) { pg8::EpiOutT<false> E{(const void*)inp(I_X), XR1, modv(F, l, 0, 2)}; pg8::gemm_phase<pg8::EpiOutT<false>, pg8::StaticOrder, true, GEMM_SP2>(F.lds + RING_OFF, g, S, E, F.tid); }
            else { pg8::EpiOutT<true> E{(const void*)XR2, XR1, modv(F, l, 0, 2)}; pg8::gemm_phase<pg8::EpiOutT<true>, pg8::StaticOrder, true, GEMM_SP2>(F.lds + RING_OFF, g, S, E, F.tid); }
        } SEAM(pb + 5);
        if (EN(8) && IN(pb + 6)) { for (int rep = 0; rep < REPS(8); ++rep) { p_router(F, l); __syncthreads(); } } SEAM(pb + 6);
        if (EN(9) && IN(pb + 7)) { for (int rep = 0; rep < REPS(9); ++rep) { p_scatter(F); __syncthreads(); } if (l == 1 || CQ_X1 > 0) { RETID_(F); cq_run(F, 1 << 30, l == 1 ? CQ_TOTAL : CQ_X1); } } SEAM(pb + 7);
        if ((EN(10) || EN(11)) && (IN(pb + 8) || IN(pb + 9))) {
            constexpr bool MERGE = ((MOE_MERGE) >> l) & 1;
            LAS int* TM = (LAS int*)(F.lds + TMAP_OFF); const int* tmg = (const int*)(F.ws + WS_TILEMAP);
            if (F.tid < 512) TM[F.tid] = tmg[F.tid];
            LAS unsigned* RO = (LAS unsigned*)(F.lds + LDSCTL_OFF + 4096);
            if (EN(10) && IN(pb + 8)) { const int* ROWTOK = (const int*)(F.ws + WS_ROWTOK); const int c = MOE_C((int)blockIdx.x);
                for (int i = F.tid; i < 9 * 256; i += NWAVES * 64) { const int u = i >> 8, L = u * F.G + c;
                    const int tok = ROWTOK[(L >> 3) * 256 + (i & 255)]; RO[i] = ((unsigned)tok < (unsigned)T ? (unsigned)tok : 0u) * 2048u; } }
            __syncthreads();
            const int ntiles = __builtin_amdgcn_readfirstlane(TM[0]);
            if (EN(10) && IN(pb + 8)) {
                pg8::Gemm g{H, (const bf16*)(F.ws + WS_W1) + (size_t)l * NEXP * 2048 * 1024, NR_MAX, 2048, 1024}; pg8::MoeOrder S{TM + 1, ntiles, 8, F.G, MOE_C((int)blockIdx.x)};
                pg8::EpiGlu E{ACT, inp(I_B1) + (size_t)l * NEXP * 2048};
                if constexpr (MERGE) { pg8::MoeOrderSig SS{{TM + 1, ntiles, 8, F.G, MOE_C((int)blockIdx.x)}, (unsigned*)(F.ctl + CW_TILE + l * 512)}; pg8::EpiGluT<true> EW{ACT, inp(I_B1) + (size_t)l * NEXP * 2048};
                    pg8::gemm_phase<pg8::EpiGluT<true>, pg8::MoeOrderSig, true, true, true>(F.lds + RING_OFF, g, SS, EW, F.tid, RO); }
                else for (int rep = 0; rep < REPS(10); ++rep) pg8::gemm_phase<pg8::EpiGlu, pg8::MoeOrder, true, true, true>(F.lds + RING_OFF, g, S, E, F.tid, RO);
                if (l == 0) { const int nU = ntiles * 8, c = MOE_C((int)blockIdx.x); RETID_(F); cq_run(F, ((nU + F.G - 1) / F.G - (c < nU ? (nU - c + F.G - 1) / F.G : 0)) * CQ_PER_ROUND); }
                if (l == 0) { RETID_(F); cq_run(F, 1 << 30, CQ_X1 + CQ_W2L0); }
            }
            if constexpr (!MERGE) SEAM(pb + 8);
            if (EN(11) && IN(pb + 9)) {
                pg8::Gemm g{ACT, (const bf16*)(F.ws + WS_W2) + (size_t)l * NEXP * 1024 * 1024, NR_MAX, 1024, 1024}; const int c2 = MERGE ? (MOE_C((int)blockIdx.x) + F.G - (ntiles * 8) % F.G) % F.G : MOE_C((int)blockIdx.x);
                pg8::MoeOrder S{TM + 1, ntiles, 4, F.G, c2};
                pg8::EpiY E{YB, inp(I_B2) + (size_t)l * NEXP * 1024};
                if constexpr (MERGE) { pg8::MoeOrderWait SW{{TM + 1, ntiles, 4, F.G, c2}, (unsigned*)(F.ctl + CW_TILE + l * 512)};
                    pg8::gemm_phase<pg8::EpiY, pg8::MoeOrderWait, true, GEMM_SP2>(F.lds + RING_OFF, g, SW, E, F.tid); }
                else for (int rep = 0; rep < REPS(11); ++rep) pg8::gemm_phase<pg8::EpiY, pg8::MoeOrder, true, GEMM_SP2>(F.lds + RING_OFF, g, S, E, F.tid);
                if (l == 0) { const int nU = ntiles * 4, c = MOE_C((int)blockIdx.x); RETID_(F); cq_run(F, ((nU + F.G - 1) / F.G - (c < nU ? (nU - c + F.G - 1) / F.G : 0)) * CQ_PER_ROUND); }
            }
        }
        SEAM(pb + 9);
        if (EN(12) && IN(pb + 10)) { p_combine(F, l, l + 1 < NL); if (l == 0) { __syncthreads(); RETID_(F); cq_run(F, 1 << 30, CQ_X1 + CQ_W2L0 + TI_DENSE); } } SEAM(pb + 10);
}
__global__ void __launch_bounds__(NWAVES * 64, 2) mk_fwd(Args args) {
    extern __shared__ __attribute__((aligned(16))) unsigned char lds[];
    Frame F;
    F.lds = (LAS unsigned char*)lds;
    F.MISC = (volatile LAS unsigned*)(F.lds + MISC_OFF);
    F.tid = threadIdx.x; F.lane = F.tid & 63; F.wave = __builtin_amdgcn_readfirstlane(F.tid >> 6);
    F.G = gridDim.x; { const int bx = blockIdx.x; F.vcu = XCDMAP_VCU(bx, F.G); }
    F.out = args.out; F.ws = args.ws;
    F.ctl = (gu32*)(args.ws + WS_CTL);
    for (int u = F.tid; u < (LDS_BYTES - LDSCTL_OFF) / 4; u += NWAVES * 64) ((LAS unsigned*)(F.lds + LDSCTL_OFF))[u] = 0u;
    __syncthreads();
    const bool one = (args.ph_hi - args.ph_lo) > 1;
    XcdBarrier bar; bar.bar = (unsigned*)(F.ctl + CW_BAR); bar.x = 0; bar.st = nullptr;
    if (one) bar = xcd_barrier_post((unsigned*)(F.ctl + CW_BAR), F.MISC + 8);
    const int lo = args.ph_lo, hi = args.ph_hi;
    if (EN(0) && IN(0)) { for (int rep = 0; rep < REPS(0); ++rep) { p0_prologue(F); __syncthreads(); } } SEAM(0);
    if (EN(1) && IN(1)) { p_norm_in(F, 0, inp(I_X)); } SEAM(1);
    layer_phases<0>(F, bar, lo, hi, lds);
    layer_phases<1>(F, bar, lo, hi, lds);
#undef IN
#undef SEAM
#undef H
#undef PROJ
#undef BRB
#undef MERGED
#undef XS
#undef ACT
#undef YB
}

extern "C" void kernel_launch(void* const* d_in, const int* in_sizes, int n_in, void* d_out, int out_size, void* d_ws, size_t ws_size, hipStream_t stream) {
    static int grid = 0;
    if (grid == 0) {
        if (n_in != 30 || in_sizes[0] != T * D || out_size != T * D || ws_size < WS_END) { fprintf(stderr, "kernel_launch: unexpected shapes (n_in %d, in0 %d, out %d, ws %zu); nothing launched\n", n_in, n_in > 0 ? in_sizes[0] : -1, out_size, ws_size); grid = -1; return; }
        int dev = 0, cus = 0, per_cu = 0;
        if (hipGetDevice(&dev) != hipSuccess || hipDeviceGetAttribute(&cus, hipDeviceAttributeMultiprocessorCount, dev) != hipSuccess) { grid = -1; return; }
        if (hipFuncSetAttribute((const void*)mk_fwd, hipFuncAttributeMaxDynamicSharedMemorySize, LDS_BYTES) != hipSuccess) { fprintf(stderr, "kernel_launch: hipFuncSetAttribute failed\n"); grid = -1; return; }
        if (hipOccupancyMaxActiveBlocksPerMultiprocessor(&per_cu, (const void*)mk_fwd, NWAVES * 64, LDS_BYTES) != hipSuccess || per_cu < 1) fprintf(stderr, "kernel_launch: occupancy query reports %d blocks per CU\n", per_cu);
        (void)hipGetLastError();
        grid = 256;
        if (cus != 256) fprintf(stderr, "kernel_launch: device has %d CUs; this kernel's static maps assume 256\n", cus);
    }
    if (grid < 0) return;
    if (hipMemsetAsync((char*)d_ws + WS_CTL, 0, CTL_ZERO_BYTES, stream) != hipSuccess) return;
    Args a{};
    for (int i = 0; i < 30; ++i) a.in[i] = (const float*)d_in[i];
    a.out = (float*)d_out; a.ws = (unsigned char*)d_ws;
#if MK_ONE_LAUNCH
    a.ph_lo = 0; a.ph_hi = N_PHASES; a.li = 0;
    hipLaunchKernelGGL(mk_fwd, dim3(grid), dim3(NWAVES * 64), LDS_BYTES, stream, a);
#else
    for (int p = 0; p < N_PHASES; ++p) { a.ph_lo = p; a.ph_hi = p + 1; a.li = p; hipLaunchKernelGGL(mk_fwd, dim3(grid), dim3(NWAVES * 64), LDS_BYTES, stream, a); }
#endif
}
```

```cpp
#include <hip/hip_runtime.h>
#include <hip/hip_bf16.h>
#include <cstdio>
#include <cstdint>
#include <cmath>
namespace pg8 {
#define PG8_LAS __attribute__((address_space(3)))
typedef unsigned short bf16_t;
typedef short bf16x8 __attribute__((ext_vector_type(8)));
typedef float f32x4 __attribute__((ext_vector_type(4)));
typedef unsigned u32x4 __attribute__((ext_vector_type(4)));
constexpr int BM = 256, BK = 64, HALF = 128, HTB = HALF * BK * 2  , STAGE_BYTES = 8 * HTB, NXCD = 8, WGM = 8;

__host__ __device__ __forceinline__ int lds_byte(int r, int c) { const int st = (r >> 4) * 2 + (c >> 5), rr = r & 15, cc = c & 31, ob = rr * 64 + cc * 2; return st * 1024 + (ob ^ (((ob >> 9) & 1) << 5)); }
__host__ __device__ __forceinline__ void stage_rc(int b, int& R, int& C) { const int st = b / 1024, sb = b % 1024, swz = sb ^ (((sb >> 9) & 1) << 5); R = (st >> 1) * 16 + swz / 64; C = (st & 1) * 32 + (swz % 64) / 2; }
__host__ __device__ __forceinline__ int perm32(int rho) { const int n = rho >> 4, i = rho & 15; return 8 * (i >> 2) + 4 * n + (i & 3); }

struct Unit { int pm, pn; };
struct Gemm { const bf16_t* A; const bf16_t* Bt; int M, N, K; };

struct StaticOrder {
    int nM, nN, nwg, G, c;
    __host__ __device__ void init(int M, int N, int G_, int c_) { nM = M / BM; nN = N / BM; nwg = nM * nN; G = G_; c = c_; }
    __host__ __device__ bool next(int i, Unit& u) const {
        const long L = (long)i * G + c; if (L >= nwg) return false;
        int wgid = (int)L; { const int q = nwg / NXCD, r = nwg % NXCD, xcd = wgid % NXCD, off = wgid / NXCD; wgid = (xcd < r ? xcd * (q + 1) : r * (q + 1) + (xcd - r) * q) + off; }
        const int nig = WGM * nN, gid = wgid / nig, fm = gid * WGM, gsz = (nM - fm) < WGM ? (nM - fm) : WGM;
        u.pm = fm + ((wgid % nig) % gsz); u.pn = (wgid % nig) / gsz; return true;
    }
    __device__ __forceinline__ void a_ready(const Unit&) const {}
    __device__ __forceinline__ void done(const Unit&) const {}
};

__device__ __forceinline__ unsigned cvt_pk_bf16(float lo, float hi) { unsigned r; asm volatile("v_cvt_pk_bf16_f32 %0, %1, %2" : "=v"(r) : "v"(lo), "v"(hi)); return r; }
typedef float f32x2 __attribute__((ext_vector_type(2)));
__device__ __forceinline__ f32x2 gelu_pk(f32x2 v) {
    const f32x2 av = __builtin_elementwise_abs(v), d = av * 0.2316418882f + 1.0f;
    f32x2 t; t.x = __builtin_amdgcn_rcpf(d.x); t.y = __builtin_amdgcn_rcpf(d.y);
    f32x2 q = t * 0.5307027145f + (-0.7265760135f); q = q * t + 0.7107068705f; q = q * t + (-0.142248368f); q = q * t + 0.127414796f; q = q * t;
    const f32x2 s = (v * v) * (-0.72134752044f);
    f32x2 e; e.x = __builtin_amdgcn_exp2f(s.x); e.y = __builtin_amdgcn_exp2f(s.y);
    const f32x2 m = v * (q * e), r = v - m;
    f32x2 o; o.x = v.x < 0.f ? m.x : r.x; o.y = v.y < 0.f ? m.y : r.y; return o;
}

template <int ACT  > struct EpiBf16 {
    static constexpr bool PERM = true, AFTER_DRAIN = false; static_assert(ACT == 0 || ACT == 1, "EpiBf16: ACT is 0 (none) or 1 (gelu_pk)");
    bf16_t* O; int ldc; const float* bias; int split_cols; size_t split_stride; float scale0;
    __device__ __forceinline__ void operator()(const f32x4 (&acc)[2][2][4][2], const Unit& u, int wr, int wc, int fr, int fq) const {
        const int row0 = u.pm * BM + wr * 64 + fr; int colt = u.pn * BM; bf16_t* base = O;
        float sc = 1.f; if (split_cols) { const int t = colt / split_cols; base += (size_t)t * split_stride; colt -= t * split_cols; if (t == 0) sc = scale0; }
        const int col0 = colt + wc * 32 + 8 * fq, bcol0 = u.pn * BM + wc * 32 + 8 * fq;
        f32x4 bv[2][2];
#pragma unroll
        for (int bj = 0; bj < 2; ++bj)
#pragma unroll
            for (int n = 0; n < 2; ++n) bv[bj][n] = bias ? *(const f32x4*)(bias + bcol0 + bj * HALF + 4 * n) : (f32x4){0.f, 0.f, 0.f, 0.f};
#pragma unroll
        for (int ai = 0; ai < 2; ++ai)
#pragma unroll
            for (int m = 0; m < 4; ++m) { bf16_t* rowp = base + (size_t)(row0 + ai * HALF + m * 16) * ldc + col0;
#pragma unroll
                for (int bj = 0; bj < 2; ++bj) { f32x4 v0 = acc[ai][bj][m][0] + bv[bj][0], v1 = acc[ai][bj][m][1] + bv[bj][1];
                    if (ACT == 1) { f32x2 a = gelu_pk((f32x2){v0[0], v0[1]}), b = gelu_pk((f32x2){v0[2], v0[3]}), c = gelu_pk((f32x2){v1[0], v1[1]}), d = gelu_pk((f32x2){v1[2], v1[3]});
                        v0 = (f32x4){a.x, a.y, b.x, b.y}; v1 = (f32x4){c.x, c.y, d.x, d.y}; }
                    v0 = v0 * sc; v1 = v1 * sc; u32x4 w; w.x = cvt_pk_bf16(v0[0], v0[1]); w.y = cvt_pk_bf16(v0[2], v0[3]); w.z = cvt_pk_bf16(v1[0], v1[1]); w.w = cvt_pk_bf16(v1[2], v1[3]);
                    *(u32x4*)(rowp + bj * HALF) = w; } }
    }
};

__device__ __forceinline__ float bf_lo(unsigned w) { return __uint_as_float(w << 16); }
__device__ __forceinline__ float bf_hi(unsigned w) { return __uint_as_float(w & 0xffff0000u); }
__device__ __forceinline__ float fast_sigmoid(float v) { return __builtin_amdgcn_rcpf(1.0f + __builtin_amdgcn_exp2f(-1.4426950408889634f * v)); }

struct EpiIn {
    static constexpr bool PERM = true, AFTER_DRAIN = false;
    bf16_t* O; int ldc; int gate_pn0; bf16_t* QKV; const float* gq; const float* gk; const float* gsq; const float* gsk; PG8_LAS float* xq; float qscale, eps;
    struct Pre {}; __device__ __forceinline__ void prefetch(Pre&, const Unit&, int, int, int, int) const {}
    __device__ __forceinline__ void operator()(const f32x4 (&acc)[2][2][4][2], const Unit& u, int wr, int wc, int fr, int fq, const Pre&) const {
        const int pn = u.pn, row0 = u.pm * BM + wr * 64 + fr, col0 = pn * BM + wc * 32 + 8 * fq; const bool gate = pn >= gate_pn0;
        const bool nrm = (pn >= 4 && pn <= 7) || (pn >= 10 && pn <= 12);
        if (!nrm) {
#pragma unroll
            for (int ai = 0; ai < 2; ++ai)
#pragma unroll
                for (int m = 0; m < 4; ++m) { const size_t rr = (size_t)(row0 + ai * HALF + m * 16); bf16_t* rowp = (pn == 8 || pn == 9) ? QKV + (size_t)2 * 16384 * 512 + rr * 512 + (col0 - 2048) : O + rr * ldc + col0;
#pragma unroll
                    for (int bj = 0; bj < 2; ++bj) { f32x4 v0 = acc[ai][bj][m][0], v1 = acc[ai][bj][m][1];
                        if (gate) {
#pragma unroll
                            for (int e = 0; e < 4; ++e) { v0[e] = fast_sigmoid(v0[e]); v1[e] = fast_sigmoid(v1[e]); } }
                        u32x4 w; w.x = cvt_pk_bf16(v0[0], v0[1]); w.y = cvt_pk_bf16(v0[2], v0[3]); w.z = cvt_pk_bf16(v1[0], v1[1]); w.w = cvt_pk_bf16(v1[2], v1[3]);
                        *(u32x4*)(rowp + bj * HALF) = w; } }
            return;
        }
        const int wid = wr * 4 + wc;
#pragma unroll
        for (int ai = 0; ai < 2; ++ai)
#pragma unroll
            for (int m = 0; m < 4; ++m)
#pragma unroll
                for (int bj = 0; bj < 2; ++bj) { const f32x4 v0 = acc[ai][bj][m][0], v1 = acc[ai][bj][m][1];
                    float s = (v0[0] * v0[0] + v0[1] * v0[1]) + (v0[2] * v0[2] + v0[3] * v0[3]) + (v1[0] * v1[0] + v1[1] * v1[1]) + (v1[2] * v1[2] + v1[3] * v1[3]);
                    s += __shfl_xor(s, 16); s += __shfl_xor(s, 32);
                    if (fq == 0) xq[(((wid * 2 + ai) * 4 + m) * 2 + bj) * 16 + fr] = s; }
        asm volatile("s_waitcnt lgkmcnt(0)" ::: "memory"); __builtin_amdgcn_s_barrier(); asm volatile("" ::: "memory");
        const float sc = (pn <= 5 || pn == 10 || pn == 11) ? qscale : 1.0f; const int go = 32 * (wc & 1) + 8 * fq;
        const float* gp;
        { const float* p0 = gq; const float* p1 = gk; const float* p2 = gsq; const float* p3 = gsk;
          asm volatile("" : "+s"(p0)); asm volatile("" : "+s"(p1)); asm volatile("" : "+s"(p2)); asm volatile("" : "+s"(p3));
          gp = pn <= 5 ? p0 : (pn <= 7 ? p1 : (pn <= 11 ? p2 : p3)); }
        const f32x4 g0 = *(const f32x4*)(gp + go), g1 = *(const f32x4*)(gp + go + 4);
#pragma unroll
        for (int ai = 0; ai < 2; ++ai)
#pragma unroll
            for (int m = 0; m < 4; ++m) { const size_t rr = (size_t)(row0 + ai * HALF + m * 16);
                bf16_t* rowp = pn <= 5 ? QKV + rr * 512 + (col0 - 1024) : (pn <= 7 ? QKV + (size_t)16384 * 512 + rr * 512 + (col0 - 1536) : O + rr * ldc + col0);
#pragma unroll
                for (int bj = 0; bj < 2; ++bj) { f32x4 v0 = acc[ai][bj][m][0], v1 = acc[ai][bj][m][1];
                    if (!(pn == 12 && bj == 1)) { const float tot = xq[(((wid * 2 + ai) * 4 + m) * 2 + bj) * 16 + fr] + xq[((((wid ^ 1) * 2 + ai) * 4 + m) * 2 + bj) * 16 + fr];
                        const float r = sc / sqrtf(tot * (1.0f / 64.0f) + eps); v0 = v0 * r * g0; v1 = v1 * r * g1; }
                    u32x4 w; w.x = cvt_pk_bf16(v0[0], v0[1]); w.y = cvt_pk_bf16(v0[2], v0[3]); w.z = cvt_pk_bf16(v1[0], v1[1]); w.w = cvt_pk_bf16(v1[2], v1[3]);
                    *(u32x4*)(rowp + bj * HALF) = w; } }
    }
};
struct EpiBranch {
    static constexpr bool PERM = true, AFTER_DRAIN = false;
    bf16_t* MG; const bf16_t* PROJ; int ldp;
    struct Pre {}; __device__ __forceinline__ void prefetch(Pre&, const Unit&, int, int, int, int) const {}
    __device__ __forceinline__ void operator()(const f32x4 (&acc)[2][2][4][2], const Unit& u, int wr, int wc, int fr, int fq, const Pre&) const {
        const int n = u.pm >> 6, pm = u.pm & 63, pn = u.pn & 3;
        const int row0 = pm * BM + wr * 64 + fr, col0 = pn * BM + wc * 32 + 8 * fq;
#pragma unroll
        for (int ai = 0; ai < 2; ++ai) {
            u32x4 gq[4][2], oq[4][2];
#pragma unroll
            for (int m = 0; m < 4; ++m) { const size_t row = (size_t)(row0 + ai * HALF + m * 16);
#pragma unroll
                for (int bj = 0; bj < 2; ++bj) { gq[m][bj] = *(const u32x4*)(PROJ + row * ldp + 3328 + n * 1024 + col0 + bj * HALF);
                    if (n > 0) oq[m][bj] = *(const u32x4*)(MG + row * 1024 + col0 + bj * HALF); } }
#pragma unroll
            for (int m = 0; m < 4; ++m) { const size_t row = (size_t)(row0 + ai * HALF + m * 16);
#pragma unroll
                for (int bj = 0; bj < 2; ++bj) {
                    const u32x4 g = gq[m][bj];
                    bf16_t* mp = MG + row * 1024 + col0 + bj * HALF;
                    f32x4 v0 = acc[ai][bj][m][0], v1 = acc[ai][bj][m][1];
                    v0[0] *= bf_lo(g.x); v0[1] *= bf_hi(g.x); v0[2] *= bf_lo(g.y); v0[3] *= bf_hi(g.y);
                    v1[0] *= bf_lo(g.z); v1[1] *= bf_hi(g.z); v1[2] *= bf_lo(g.w); v1[3] *= bf_hi(g.w);
                    if (n > 0) { const u32x4 o = oq[m][bj];
                        v0[0] += bf_lo(o.x); v0[1] += bf_hi(o.x); v0[2] += bf_lo(o.y); v0[3] += bf_hi(o.y);
                        v1[0] += bf_lo(o.z); v1[1] += bf_hi(o.z); v1[2] += bf_lo(o.w); v1[3] += bf_hi(o.w); }
                    u32x4 w; w.x = cvt_pk_bf16(v0[0], v0[1]); w.y = cvt_pk_bf16(v0[2], v0[3]); w.z = cvt_pk_bf16(v1[0], v1[1]); w.w = cvt_pk_bf16(v1[2], v1[3]);
                    *(u32x4*)mp = w; } } }
    }
};
template <bool IN_BF16> struct EpiOutT {
    static constexpr bool PERM = true, AFTER_DRAIN = false;
    const void* xin; bf16_t* xout; const float* gm;
    struct Pre { f32x4 gv[2][2]; };
    __device__ __forceinline__ void prefetch(Pre& P, const Unit& u, int wr, int wc, int fr, int fq) const { const int col0 = u.pn * BM + wc * 32 + 8 * fq; const int b = (u.pm * BM) >> 13;
#pragma unroll
        for (int bj = 0; bj < 2; ++bj)
#pragma unroll
            for (int n = 0; n < 2; ++n) P.gv[bj][n] = *(const f32x4*)(gm + (size_t)b * 6144 + col0 + bj * HALF + 4 * n); }
    __device__ __forceinline__ void operator()(const f32x4 (&acc)[2][2][4][2], const Unit& u, int wr, int wc, int fr, int fq, const Pre& P) const {
        const int row0 = u.pm * BM + wr * 64 + fr, col0 = u.pn * BM + wc * 32 + 8 * fq;
        const f32x4 (&gv)[2][2] = P.gv;
#pragma unroll
        for (int ai = 0; ai < 2; ++ai) {
            f32x4 xq[4][2][2]; u32x4 xb[4][2];
#pragma unroll
            for (int m = 0; m < 4; ++m) { const size_t off = (size_t)(row0 + ai * HALF + m * 16) * 1024 + col0;
#pragma unroll
                for (int bj = 0; bj < 2; ++bj) {
                    if constexpr (IN_BF16) xb[m][bj] = *(const u32x4*)((const bf16_t*)xin + off + bj * HALF);
                    else { xq[m][bj][0] = *(const f32x4*)((const float*)xin + off + bj * HALF); xq[m][bj][1] = *(const f32x4*)((const float*)xin + off + bj * HALF + 4); } } }
#pragma unroll
            for (int m = 0; m < 4; ++m) { const size_t off = (size_t)(row0 + ai * HALF + m * 16) * 1024 + col0;
#pragma unroll
                for (int bj = 0; bj < 2; ++bj) { f32x4 x0, x1;
                    if constexpr (IN_BF16) { const u32x4 w = xb[m][bj]; x0 = (f32x4){bf_lo(w.x), bf_hi(w.x), bf_lo(w.y), bf_hi(w.y)}; x1 = (f32x4){bf_lo(w.z), bf_hi(w.z), bf_lo(w.w), bf_hi(w.w)}; }
                    else { x0 = xq[m][bj][0]; x1 = xq[m][bj][1]; }
                    const f32x4 v0 = x0 + gv[bj][0] * acc[ai][bj][m][0], v1 = x1 + gv[bj][1] * acc[ai][bj][m][1];
                    u32x4 w; w.x = cvt_pk_bf16(v0[0], v0[1]); w.y = cvt_pk_bf16(v0[2], v0[3]); w.z = cvt_pk_bf16(v1[0], v1[1]); w.w = cvt_pk_bf16(v1[2], v1[3]);
                    *(u32x4*)(xout + off + bj * HALF) = w; } } }
    }
};
template <bool WT> struct EpiGluT {
    static constexpr bool PERM = true, AFTER_DRAIN = false;
    bf16_t* ACT; const float* b1;
    struct Pre { f32x4 bv[2][2]; };
    __device__ __forceinline__ void prefetch(Pre& P, const Unit& u, int wr, int wc, int fr, int fq) const { const int e = u.pn >> 3, pn = u.pn & 7, hc0 = pn * BM + wc * 32 + 8 * fq;
#pragma unroll
        for (int bj = 0; bj < 2; ++bj)
#pragma unroll
            for (int n = 0; n < 2; ++n) P.bv[bj][n] = *(const f32x4*)(b1 + (size_t)e * 2048 + hc0 + bj * HALF + 4 * n); }
    __device__ __forceinline__ void operator()(const f32x4 (&acc)[2][2][4][2], const Unit& u, int wr, int wc, int fr, int fq, const Pre& P) const {
        const int pn = u.pn & 7;
        const int row0 = u.pm * BM + wr * 64 + fr, ac0 = pn * 128 + wc * 16 + 4 * fq;
        const f32x4 (&bv)[2][2] = P.bv;
#pragma unroll
        for (int ai = 0; ai < 2; ++ai)
#pragma unroll
            for (int m = 0; m < 4; ++m) { bf16_t* rowp = ACT + (size_t)(row0 + ai * HALF + m * 16) * 1024 + ac0;
#pragma unroll
                for (int bj = 0; bj < 2; ++bj) { const f32x4 v0 = acc[ai][bj][m][0] + bv[bj][0], v1 = acc[ai][bj][m][1] + bv[bj][1];
                    float a[4];
#pragma unroll
                    for (int p = 0; p < 4; ++p) { const float gl = p < 2 ? v0[2 * p] : v1[2 * p - 4], ln = p < 2 ? v0[2 * p + 1] : v1[2 * p - 3];
                        const float xg = fminf(gl, 7.0f), xl = fminf(fmaxf(ln, -7.0f), 7.0f);
                        a[p] = xg * fast_sigmoid(1.702f * xg) * (xl + 1.0f); }
                    typedef unsigned u32x2 __attribute__((ext_vector_type(2)));
                    u32x2 w; w.x = cvt_pk_bf16(a[0], a[1]); w.y = cvt_pk_bf16(a[2], a[3]);
                    if constexpr (WT) __hip_atomic_store((unsigned long long*)(rowp + bj * 64), (unsigned long long)w.x | ((unsigned long long)w.y << 32), __ATOMIC_RELAXED, __HIP_MEMORY_SCOPE_AGENT);
                    else *(u32x2*)(rowp + bj * 64) = w; } }
    }
};
using EpiGlu = EpiGluT<false>;
struct EpiY {
    static constexpr bool PERM = true, AFTER_DRAIN = false;
    bf16_t* Y; const float* b2;
    struct Pre { f32x4 bv[2][2]; };
    __device__ __forceinline__ void prefetch(Pre& P, const Unit& u, int wr, int wc, int fr, int fq) const { const int e = u.pn >> 2, pn = u.pn & 3, col0 = pn * BM + wc * 32 + 8 * fq;
#pragma unroll
        for (int bj = 0; bj < 2; ++bj)
#pragma unroll
            for (int n = 0; n < 2; ++n) P.bv[bj][n] = *(const f32x4*)(b2 + (size_t)e * 1024 + col0 + bj * HALF + 4 * n); }
    __device__ __forceinline__ void operator()(const f32x4 (&acc)[2][2][4][2], const Unit& u, int wr, int wc, int fr, int fq, const Pre& P) const {
        const int pn = u.pn & 3;
        const int row0 = u.pm * BM + wr * 64 + fr, col0 = pn * BM + wc * 32 + 8 * fq;
        const f32x4 (&bv)[2][2] = P.bv;
#pragma unroll
        for (int ai = 0; ai < 2; ++ai)
#pragma unroll
            for (int m = 0; m < 4; ++m) { bf16_t* rowp = Y + (size_t)(row0 + ai * HALF + m * 16) * 1024 + col0;
#pragma unroll
                for (int bj = 0; bj < 2; ++bj) { const f32x4 v0 = acc[ai][bj][m][0] + bv[bj][0], v1 = acc[ai][bj][m][1] + bv[bj][1];
                    u32x4 w; w.x = cvt_pk_bf16(v0[0], v0[1]); w.y = cvt_pk_bf16(v0[2], v0[3]); w.z = cvt_pk_bf16(v1[0], v1[1]); w.w = cvt_pk_bf16(v1[2], v1[3]);
                    *(u32x4*)(rowp + bj * HALF) = w; } }
    }
};
struct BranchOrder {
    StaticOrder so;
    __device__ void init(int M, int G_, int c_) { so.init(M, 1024, G_, c_); }
    __device__ bool next(int i, Unit& u) const { const int r = i / 3, n = i - 3 * r; Unit t; if (!so.next(r, t)) return false; u.pm = n * 64 + t.pm; u.pn = n * 4 + t.pn; return true; }
    __device__ __forceinline__ void a_ready(const Unit&) const {}
    __device__ __forceinline__ void done(const Unit&) const {}
};
struct MoeOrder {
    const PG8_LAS int* tmap; int ntiles, npn, G, c;
    __device__ bool next(int i, Unit& u) const {
        const int L = i * G + c; if (L >= ntiles * npn) return false;
        const int j = L / npn, pn = L - j * npn; const int e = __builtin_amdgcn_readfirstlane(tmap[j]);
        u.pm = j; u.pn = e * npn + pn; return true; }
    __device__ __forceinline__ void a_ready(const Unit&) const {}
    __device__ __forceinline__ void done(const Unit&) const {}
};
struct MoeOrderSig : MoeOrder { unsigned* cnt;
    __device__ __forceinline__ void done(const Unit& u) const {
        asm volatile("s_waitcnt vmcnt(0)" ::: "memory");
        if (__builtin_amdgcn_mbcnt_hi(~0u, __builtin_amdgcn_mbcnt_lo(~0u, 0u)) == 0u) __hip_atomic_fetch_add(cnt + u.pm, 1u, __ATOMIC_RELAXED, __HIP_MEMORY_SCOPE_AGENT); } };
struct MoeOrderWait : MoeOrder { unsigned* cnt;
    __device__ __forceinline__ void a_ready(const Unit& u) const {
        while (__hip_atomic_load(cnt + u.pm, __ATOMIC_RELAXED, __HIP_MEMORY_SCOPE_AGENT) < 64u) __builtin_amdgcn_s_sleep(8);
        asm volatile("" ::: "memory"); } };
struct MoeOrderX {
    const PG8_LAS int* tm; int npn, xcd, cx;
    __device__ bool next(int i, Unit& u) const {
        int L = i * 32 + cx; const int cnt = __builtin_amdgcn_readfirstlane(tm[448 + xcd]);
        for (int q = 0; q < cnt; ++q) { const int e = __builtin_amdgcn_readfirstlane(tm[384 + xcd * 8 + q]); const int n = __builtin_amdgcn_readfirstlane(tm[352 + e]) * npn;
            if (L < n) { const int jt = L / npn, pn = L - jt * npn; u.pm = __builtin_amdgcn_readfirstlane(tm[320 + e]) + jt; u.pn = e * npn + pn; return true; }
            L -= n; }
        return false; }
    __device__ __forceinline__ void a_ready(const Unit&) const {}
    __device__ __forceinline__ void done(const Unit&) const {}
};

template <class Epi, class Sched, bool ALIGN_EPI = false, bool SP2 = false, bool GATHER = false>
__device__ __forceinline__ void gemm_phase(PG8_LAS unsigned char* lds, const Gemm g, const Sched& S, const Epi& E, const int tid, const PG8_LAS unsigned* rowoff = nullptr) {
    static_assert(!GATHER || SP2, "GATHER is implemented for the SP2 loop");
    const int wid = __builtin_amdgcn_readfirstlane(tid >> 6), lane = tid & 63, wr = wid >> 2, wc = wid & 3, fr = lane & 15, fq = lane >> 4;
    const int K = g.K, nt = K / BK;
    unsigned voffA[2], voffB[2];
#pragma unroll
    for (int i = 0; i < 2; ++i) { int R, C; stage_rc(tid * 16 + i * 8192, R, C); const int Rb = Epi::PERM ? ((R & ~31) + perm32(R & 31)) : R;
        voffA[i] = (unsigned)(R * K + C) * 2u; voffB[i] = (unsigned)(Rb * K + C) * 2u; }
    unsigned vAc[2][2], vAn[2][2]; int gR[2]; unsigned gC[2];
    if constexpr (GATHER) {
#pragma unroll
        for (int i = 0; i < 2; ++i) { int R, C; stage_rc(tid * 16 + i * 8192, R, C); gR[i] = R; gC[i] = (unsigned)C * 2u; }
#pragma unroll
        for (int h = 0; h < 2; ++h)
#pragma unroll
            for (int i = 0; i < 2; ++i) { vAc[h][i] = rowoff[h * HALF + gR[i]] + gC[i]; vAn[h][i] = vAc[h][i]; } }
    const size_t kstep = (size_t)(BK * 2);
    const size_t hstep = (size_t)HALF * K * 2;
    const size_t tstep = 2 * hstep;
    const unsigned ldsw = (unsigned)wid * 1024u;
    const int aoff = lds_byte(wr * 64 + fr, fq * 8), boff = lds_byte(wc * 32 + fr, fq * 8);
#define PG8_SA(b, h) (((b) * 2 + (h)) * HTB)
#define PG8_SB(b, h) ((4 + (b) * 2 + (h)) * HTB)
#define PG8_STAGE(bufoff, gbase, voff) do { _Pragma("unroll") for (int _i = 0; _i < 2; ++_i) \
        __builtin_amdgcn_global_load_lds((const unsigned*)((const char*)(gbase) + (voff)[_i]), (PG8_LAS unsigned*)(lds + (bufoff) + ldsw + _i * 8192), 16, 0, 0); } while (0)
#define PG8_LDA(dst, b, h) do { _Pragma("unroll") for (int m = 0; m < 4; ++m) _Pragma("unroll") for (int k = 0; k < 2; ++k) dst[m][k] = *(const PG8_LAS bf16x8*)(lds + PG8_SA(b, h) + aoff + m * 2048 + k * 1024); } while (0)
#define PG8_LDB(dst, b, h) do { _Pragma("unroll") for (int n = 0; n < 2; ++n) _Pragma("unroll") for (int k = 0; k < 2; ++k) dst[n][k] = *(const PG8_LAS bf16x8*)(lds + PG8_SB(b, h) + boff + n * 2048 + k * 1024); } while (0)
#define PG8_MMA(ai, bj, At, Bt) do { __builtin_amdgcn_s_setprio(1); _Pragma("unroll") for (int m = 0; m < 4; ++m) _Pragma("unroll") for (int n = 0; n < 2; ++n) _Pragma("unroll") for (int k = 0; k < 2; ++k) \
        acc[ai][bj][m][n] = __builtin_amdgcn_mfma_f32_16x16x32_bf16(Bt[n][k], At[m][k], acc[ai][bj][m][n], 0, 0, 0); __builtin_amdgcn_s_setprio(0); } while (0)
#define PG8_WAIT_V(n) asm volatile("s_waitcnt vmcnt(" #n ")" ::: "memory")
#define PG8_WAIT_L(n) asm volatile("s_waitcnt lgkmcnt(" #n ")" ::: "memory")
#define PG8_BAR __builtin_amdgcn_s_barrier()
#define PG8_SCHED __builtin_amdgcn_sched_barrier(0)
    Unit cur, nxt; int ui = 0;
    if (!S.next(0, cur)) return;
    f32x4 acc[2][2][4][2];
#pragma unroll
    for (int a = 0; a < 2; ++a)
#pragma unroll
        for (int b = 0; b < 2; ++b)
#pragma unroll
            for (int m = 0; m < 4; ++m)
#pragma unroll
                for (int n = 0; n < 2; ++n) acc[a][b][m][n] = (f32x4){0.f, 0.f, 0.f, 0.f};
    bf16x8 At[4][2], B0[2][2], B1[2][2];
    const char* cA = (const char*)g.A + (GATHER ? (size_t)0 : (size_t)cur.pm * tstep); const char* cB = (const char*)g.Bt + (size_t)cur.pn * tstep;
    S.a_ready(cur);
    if constexpr (SP2) {
        PG8_STAGE(PG8_SB(0, 0), cB, voffB); PG8_STAGE(PG8_SB(0, 1), cB + hstep, voffB);
        if constexpr (GATHER) { PG8_STAGE(PG8_SA(0, 0), cA, vAc[0]); PG8_STAGE(PG8_SA(0, 1), cA, vAc[1]); } else { PG8_STAGE(PG8_SA(0, 0), cA, voffA); PG8_STAGE(PG8_SA(0, 1), cA + hstep, voffA); }
        if (wr == 1) PG8_BAR;
        PG8_WAIT_V(2); PG8_BAR;
        PG8_STAGE(PG8_SB(1, 0), cB + kstep, voffB); if constexpr (GATHER) { PG8_STAGE(PG8_SA(1, 0), cA + kstep, vAc[0]); } else { PG8_STAGE(PG8_SA(1, 0), cA + kstep, voffA); } PG8_STAGE(PG8_SB(1, 1), cB + hstep + kstep, voffB);
        PG8_WAIT_V(6); PG8_BAR;
    } else {
        PG8_STAGE(PG8_SB(0, 0), cB, voffB); PG8_STAGE(PG8_SA(0, 0), cA, voffA); PG8_STAGE(PG8_SB(0, 1), cB + hstep, voffB); PG8_STAGE(PG8_SA(0, 1), cA + hstep, voffA);
        if (wr == 1) PG8_BAR;
        PG8_WAIT_V(4); PG8_BAR;
        PG8_STAGE(PG8_SB(1, 0), cB + kstep, voffB); PG8_STAGE(PG8_SA(1, 0), cA + kstep, voffA); PG8_STAGE(PG8_SB(1, 1), cB + hstep + kstep, voffB);
        PG8_WAIT_V(6); PG8_BAR;
    }
    for (;;) {
        const bool has_next = S.next(ui + 1, nxt);
        typename Epi::Pre epre; E.prefetch(epre, cur, wr, wc, fr, fq);
        const char* nA = (has_next && !GATHER) ? (const char*)g.A + (size_t)nxt.pm * tstep : cA;
        if constexpr (GATHER) { if (has_next) {
#pragma unroll
            for (int h = 0; h < 2; ++h)
#pragma unroll
                for (int i = 0; i < 2; ++i) vAn[h][i] = rowoff[(ui + 1) * BM + h * HALF + gR[i]] + gC[i]; } } const char* nB = has_next ? (const char*)g.Bt + (size_t)nxt.pn * tstep : cB;
        for (int t = 0; t < nt; t += 2) {
            const bool last = (t == nt - 2);
            const char* a1 = cA + (size_t)(t + 1) * kstep;
            const char* a2 = last ? nA : cA + (size_t)(t + 2) * kstep; const char* b2 = last ? nB : cB + (size_t)(t + 2) * kstep;
            const char* a3 = a2 + kstep; const char* b3 = b2 + kstep;
            if (last && has_next) S.a_ready(nxt);
            if constexpr (SP2) {
            unsigned s0_[2], s1_[2];
            if constexpr (GATHER) { s0_[0] = last ? vAn[0][0] : vAc[0][0]; s0_[1] = last ? vAn[0][1] : vAc[0][1]; s1_[0] = last ? vAn[1][0] : vAc[1][0]; s1_[1] = last ? vAn[1][1] : vAc[1][1]; }
            PG8_LDB(B0, 0, 0); PG8_LDB(B1, 0, 1); PG8_SCHED; PG8_LDA(At, 0, 0); if constexpr (GATHER) { PG8_STAGE(PG8_SA(1, 1), a1, vAc[1]); } else { PG8_STAGE(PG8_SA(1, 1), a1 + hstep, voffA); }
            PG8_WAIT_V(8); PG8_WAIT_L(0); PG8_BAR; PG8_MMA(0, 0, At, B0); PG8_MMA(0, 1, At, B1); PG8_BAR; PG8_SCHED;
            PG8_LDA(At, 0, 1); PG8_STAGE(PG8_SB(0, 0), b2, voffB); PG8_STAGE(PG8_SB(0, 1), b2 + hstep, voffB); if constexpr (GATHER) { PG8_STAGE(PG8_SA(0, 0), a2, s0_); } else { PG8_STAGE(PG8_SA(0, 0), a2, voffA); }
            PG8_WAIT_V(8); PG8_WAIT_L(0); PG8_BAR; PG8_MMA(1, 0, At, B0); PG8_MMA(1, 1, At, B1); PG8_BAR; PG8_SCHED;
            PG8_LDB(B0, 1, 0); PG8_LDB(B1, 1, 1); PG8_SCHED; PG8_LDA(At, 1, 0); if constexpr (GATHER) { PG8_STAGE(PG8_SA(0, 1), a2, s1_); } else { PG8_STAGE(PG8_SA(0, 1), a2 + hstep, voffA); }
            PG8_WAIT_V(8); PG8_WAIT_L(0); PG8_BAR; PG8_MMA(0, 0, At, B0); PG8_MMA(0, 1, At, B1); PG8_BAR; PG8_SCHED;
            PG8_LDA(At, 1, 1); PG8_STAGE(PG8_SB(1, 0), b3, voffB); PG8_STAGE(PG8_SB(1, 1), b3 + hstep, voffB); if constexpr (GATHER) { PG8_STAGE(PG8_SA(1, 0), a3, s0_); } else { PG8_STAGE(PG8_SA(1, 0), a3, voffA); }
            PG8_WAIT_V(8); PG8_WAIT_L(0); PG8_BAR; PG8_MMA(1, 0, At, B0); PG8_MMA(1, 1, At, B1); PG8_BAR; PG8_SCHED;
            } else {
            PG8_LDB(B0, 0, 0); PG8_SCHED; PG8_LDA(At, 0, 0); PG8_STAGE(PG8_SA(1, 1), a1 + hstep, voffA);
            PG8_WAIT_L(8); PG8_BAR; PG8_WAIT_L(0); PG8_MMA(0, 0, At, B0); PG8_BAR; PG8_SCHED;
            PG8_LDB(B1, 0, 1); PG8_STAGE(PG8_SB(0, 0), b2, voffB);
            PG8_BAR; PG8_WAIT_L(0); PG8_MMA(0, 1, At, B1); PG8_BAR;
            PG8_LDA(At, 0, 1); PG8_STAGE(PG8_SA(0, 0), a2, voffA);
            PG8_BAR; PG8_WAIT_L(0); PG8_MMA(1, 0, At, B0); PG8_BAR; PG8_SCHED;
            PG8_STAGE(PG8_SB(0, 1), b2 + hstep, voffB);
            PG8_WAIT_V(6); PG8_BAR; PG8_MMA(1, 1, At, B1); PG8_BAR;
            PG8_LDB(B0, 1, 0); PG8_SCHED; PG8_LDA(At, 1, 0); PG8_STAGE(PG8_SA(0, 1), a2 + hstep, voffA);
            PG8_WAIT_L(8); PG8_BAR; PG8_WAIT_L(0); PG8_MMA(0, 0, At, B0); PG8_BAR; PG8_SCHED;
            PG8_LDB(B1, 1, 1); PG8_STAGE(PG8_SB(1, 0), b3, voffB);
            PG8_BAR; PG8_WAIT_L(0); PG8_MMA(0, 1, At, B1); PG8_BAR;
            PG8_LDA(At, 1, 1); PG8_STAGE(PG8_SA(1, 0), a3, voffA);
            PG8_BAR; PG8_WAIT_L(0); PG8_MMA(1, 0, At, B0); PG8_BAR; PG8_SCHED;
            PG8_STAGE(PG8_SB(1, 1), b3 + hstep, voffB);
            PG8_WAIT_V(6); PG8_BAR; PG8_MMA(1, 1, At, B1); PG8_BAR;
            }
        }
        if constexpr (ALIGN_EPI) { if (wr == 0) PG8_BAR; }
        if constexpr (!Epi::AFTER_DRAIN) { E(acc, cur, wr, wc, fr, fq, epre); S.done(cur); }
        if (!has_next) break;
#pragma unroll
        for (int a = 0; a < 2; ++a)
#pragma unroll
            for (int b = 0; b < 2; ++b)
#pragma unroll
                for (int m = 0; m < 4; ++m)
#pragma unroll
                    for (int n = 0; n < 2; ++n) acc[a][b][m][n] = (f32x4){0.f, 0.f, 0.f, 0.f};
        cur = nxt; cA = nA; cB = nB; ++ui;
        if constexpr (GATHER) {
#pragma unroll
            for (int h = 0; h < 2; ++h)
#pragma unroll
                for (int i = 0; i < 2; ++i) vAc[h][i] = vAn[h][i]; }
        if constexpr (ALIGN_EPI) { if (wr == 1) PG8_BAR; }
    }
    PG8_WAIT_V(0);
    if constexpr (!ALIGN_EPI) { if (wr == 0) PG8_BAR; }
    PG8_BAR;
    if constexpr (Epi::AFTER_DRAIN) { E.fused(acc, cur, wr, wc, fr, fq, lds, wid, lane); S.done(cur); }
#undef PG8_SA
#undef PG8_SB
#undef PG8_STAGE
#undef PG8_LDA
#undef PG8_LDB
#undef PG8_MMA
#undef PG8_WAIT_V
#undef PG8_WAIT_L
#undef PG8_BAR
#undef PG8_SCHED
}
}

#ifndef PG8_SP2
#define PG8_SP2 true
#endif
#ifndef PG8_ALIGN
#define PG8_ALIGN true
#endif
#include <hip/hip_bf16.h>
#include <cmath>
namespace attn2 {
using bf16=__hip_bfloat16;
using bf16x8=__attribute__((ext_vector_type(8)))short;
using s16x4=__attribute__((ext_vector_type(4)))short;
using f32x16=__attribute__((ext_vector_type(16)))float;
using u32x4=__attribute__((ext_vector_type(4)))unsigned;
constexpr int BATCH=2,NHEAD=16,SEQ=8192,D=64,KVP=512,OP=1024;
constexpr int NW=8,QBLK=32,QB=QBLK*NW,KVBLK=64,NQB=SEQ/QB;
constexpr int ATTN_UNIT_ROWS=QB;
__device__ __forceinline__ int crow(int r,int hi){return (r&3)+8*(r>>2)+4*hi;}
#define SBAR() __builtin_amdgcn_sched_barrier(0)
__device__ __forceinline__ void cmask(f32x16&p0,f32x16&p1,int jb,int qrel,int hi,const float*tab){
  const float NEG=-INFINITY; int kb=64*jb+4*hi;
  #pragma unroll
  for(int r=0;r<16;++r){int kv=kb+(r&3)+8*(r>>2); const int d0=qrel-kv,d1=d0-32;
    const float b0=tab[d0<0?0:(d0>127?127:d0)],b1=tab[d1<0?0:(d1>127?127:d1)];
    p0[r]=(d0<0)?NEG:(p0[r]+b0); p1[r]=(d1<0)?NEG:(p1[r]+b1); if((r&1)==1){asm volatile("":"+v"(p0),"+v"(p1)::"memory");}}
}

constexpr int NSLOT=3, SLOTB=8192;
constexpr int LDS_K=0, LDS_V=NSLOT*SLOTB, LDS_WS=3*NSLOT*SLOTB, LDS_OST=LDS_WS+NW*64*4, LDS_BYTES=LDS_OST+NW*4096;
constexpr float C2=0.125f*1.4426950408889634f;
__device__ __forceinline__ void glds16(const void*gsrc,unsigned lds_dst){unsigned keep;
  asm volatile("s_mov_b32 %0, m0\n\ts_mov_b32 m0, %2\n\ts_nop 0\n\tglobal_load_lds_dwordx4 %1, off\n\ts_mov_b32 m0, %0":"=&s"(keep):"v"(gsrc),"s"(lds_dst):"memory");}
__device__ __forceinline__ float max3f(float a,float b,float c){float r;asm("v_max3_f32 %0, %1, %2, %3":"=v"(r):"v"(a),"v"(b),"v"(c));return r;}
__device__ __forceinline__ float max2f(float a,float b){float r;asm("v_max_f32_e32 %0, %1, %2":"=v"(r):"v"(a),"v"(b));return r;}
__device__ __forceinline__ float fadd_s(float a,float b){float r;asm("v_add_f32_e32 %0, %1, %2":"=v"(r):"v"(a),"v"(b));return r;}
__device__ __forceinline__ float fsub_s(float a,float b){float r;asm("v_sub_f32_e32 %0, %1, %2":"=v"(r):"v"(a),"v"(b));return r;}
typedef float f32x2_t __attribute__((ext_vector_type(2))); typedef __bf16 bf16x2_t __attribute__((ext_vector_type(2)));
__device__ __forceinline__ unsigned cvtpk_s(float lo,float hi){f32x2_t v={lo,hi};bf16x2_t b=__builtin_convertvector(v,bf16x2_t);return __builtin_bit_cast(unsigned,b);}
#define WAIT_BAR(N) asm volatile("s_waitcnt vmcnt(" #N ") lgkmcnt(0)\n\ts_barrier":::"memory")

__device__ __forceinline__ void qkt(f32x16&p0,f32x16&p1,const char*Kslot,const bf16x8*qr,int r32,int hi){ const f32x16 negm=f32x16{};
  const char*kb=Kslot+hi*1024+r32*16;
  #pragma unroll
  for(int d0=0;d0<4;++d0){
    const bf16x8 b0=*reinterpret_cast<const bf16x8*>(kb+d0*2048);
    const bf16x8 b1=*reinterpret_cast<const bf16x8*>(kb+d0*2048+512);
    if(d0==0){p0=__builtin_amdgcn_mfma_f32_32x32x16_bf16(b0,qr[0],negm,0,0,0);p1=__builtin_amdgcn_mfma_f32_32x32x16_bf16(b1,qr[0],negm,0,0,0);}
    else{p0=__builtin_amdgcn_mfma_f32_32x32x16_bf16(b0,qr[d0],p0,0,0,0);p1=__builtin_amdgcn_mfma_f32_32x32x16_bf16(b1,qr[d0],p1,0,0,0);}}
}
typedef __attribute__((address_space(3))) const char* lds_cptr;
typedef short v4i16_t __attribute__((ext_vector_type(4)));
__device__ __forceinline__ void kload8(bf16x8*kf,lds_cptr kp){
  kf[0]=*(const __attribute__((address_space(3))) bf16x8*)(kp);      kf[1]=*(const __attribute__((address_space(3))) bf16x8*)(kp+512);
  kf[2]=*(const __attribute__((address_space(3))) bf16x8*)(kp+2048); kf[3]=*(const __attribute__((address_space(3))) bf16x8*)(kp+2560);
  kf[4]=*(const __attribute__((address_space(3))) bf16x8*)(kp+4096); kf[5]=*(const __attribute__((address_space(3))) bf16x8*)(kp+4608);
  kf[6]=*(const __attribute__((address_space(3))) bf16x8*)(kp+6144); kf[7]=*(const __attribute__((address_space(3))) bf16x8*)(kp+6656);
}
__device__ __forceinline__ void kload2(bf16x8*kf,lds_cptr kp,int j){ kf[2*j]=*(const __attribute__((address_space(3))) bf16x8*)(kp+j*2048); kf[2*j+1]=*(const __attribute__((address_space(3))) bf16x8*)(kp+j*2048+512); }
__device__ __forceinline__ s16x4 vtr(lds_cptr p){ return __builtin_bit_cast(s16x4,__builtin_amdgcn_ds_read_tr16_b64_v4i16((__attribute__((address_space(3))) v4i16_t*)p)); }
__device__ __forceinline__ float rowmax(const f32x16&p0,const f32x16&p1){
  float a=max3f(p0[0],p0[1],p1[0]),b=max3f(p0[2],p0[3],p1[1]);a=max3f(a,p1[2],p1[3]);
  #pragma unroll
  for(int r=4;r<16;r+=4){a=max3f(a,p0[r],p0[r+1]);b=max3f(b,p0[r+2],p0[r+3]);a=max3f(a,p1[r],p1[r+1]);b=max3f(b,p1[r+2],p1[r+3]);}
  const float m=max2f(a,b);
  auto rr=__builtin_amdgcn_permlane32_swap(__float_as_uint(m),__float_as_uint(m),false,false);
  return max2f(__uint_as_float(rr[0]),__uint_as_float(rr[1]));
}
__device__ __forceinline__ void pv(f32x16*o,int vb,bf16x8 pa0,bf16x8 pa1,bf16x8 pa2,bf16x8 pa3){
  #pragma unroll
  for(int d0=0;d0<4;++d0){s16x4 lo[4],hi[4];
    #pragma unroll
    for(int ks=0;ks<4;++ks){
      asm volatile("ds_read_b64_tr_b16 %0,%1 offset:%c2":"=&v"(lo[ks]):"v"(vb),"i"(d0*4096+ks*1024):"memory");
      asm volatile("ds_read_b64_tr_b16 %0,%1 offset:%c2":"=&v"(hi[ks]):"v"(vb),"i"(d0*4096+ks*1024+512):"memory");}
    asm volatile("s_waitcnt lgkmcnt(0)":::"memory");SBAR();
    #define PK(k) (bf16x8){lo[k][0],lo[k][1],lo[k][2],lo[k][3],hi[k][0],hi[k][1],hi[k][2],hi[k][3]}
    o[d0]=__builtin_amdgcn_mfma_f32_32x32x16_bf16(pa0,PK(0),o[d0],0,0,0);
    o[d0]=__builtin_amdgcn_mfma_f32_32x32x16_bf16(pa1,PK(1),o[d0],0,0,0);
    o[d0]=__builtin_amdgcn_mfma_f32_32x32x16_bf16(pa2,PK(2),o[d0],0,0,0);
    o[d0]=__builtin_amdgcn_mfma_f32_32x32x16_bf16(pa3,PK(3),o[d0],0,0,0);
    #undef PK
  }
}

#ifndef ATTN_STORE16
#define ATTN_STORE16(p,v) (*(u32x4*)(p)=(v))
#endif
template<int THRL,bool FAST> __device__ __forceinline__ void attn_unit(int b,int hm,int qb,const bf16*PROJ,bf16*O,char*shm,const float*tab,const int tid){
  const int lane=tid&63,r32=lane&31,hi=lane>>5; const int wid=__builtin_amdgcn_readfirstlane(tid>>6);
  const long rowbase=(long)b*SEQ; const int q0=qb*QB;
  const bf16*Qw=PROJ+(rowbase+q0+wid*QBLK)*KVP+hm*64;
  const bf16*Kh=PROJ+(long)16384*512+rowbase*KVP+hm*64,*Vh=PROJ+(long)2*16384*512+rowbase*KVP+(hm>>1)*128;
  const unsigned lds0=(unsigned)(uintptr_t)shm;
  float*wsf=(float*)(shm+LDS_WS)+wid*64;
  const bf16*ksrc=Kh+(long)lane*KVP+wid*8;
  const bf16*vsrc=Vh+(long)(16*(wid&3)+(lane>>2))*KVP+(wid>>2)*32+(lane&3)*8;
  const unsigned kdst=lds0+LDS_K+wid*1024, vdst=lds0+LDS_V+wid*1024;
  #define DMA_K(t,slot) glds16(ksrc+(long)(t)*KVBLK*KVP,(unsigned)__builtin_amdgcn_readfirstlane(kdst+(slot)))
  #define DMA_V(t,slot) do{ glds16(vsrc+(long)(t)*KVBLK*KVP,(unsigned)__builtin_amdgcn_readfirstlane(vdst+2*(slot))); glds16(vsrc+64+(long)(t)*KVBLK*KVP,(unsigned)__builtin_amdgcn_readfirstlane(vdst+8192+2*(slot))); }while(0)
  const int vb0=(int)(lds0+LDS_V)+((lane>>4)&1)*32+(lane&3)*8+(4*hi+((lane&15)>>2))*64;
  const char*Kbase=shm+LDS_K; bf16x8 kf[8];
  const lds_cptr shm3=(lds_cptr)shm; const lds_cptr kp0=shm3+LDS_K+hi*1024+r32*16; const lds_cptr vp0=shm3+LDS_V+((lane>>4)&1)*32+(lane&3)*8+(4*hi+((lane&15)>>2))*64;
  const int NT=(q0+QB)/KVBLK;
  DMA_K(0,0);DMA_V(0,0);DMA_K(1,SLOTB);
  bf16x8 qr[4];
  #pragma unroll
  for(int d0=0;d0<4;++d0)qr[d0]=*reinterpret_cast<const bf16x8*>(&Qw[(long)r32*KVP+d0*16+hi*8]);
  float mhat=0.f,l_reg=0.f;f32x16 o[4];o[0]=f32x16{};o[1]=f32x16{};o[2]=f32x16{};o[3]=f32x16{};
  const int qrel=wid*QBLK+r32;
  #define CMASK(P0,P1,t) do{int jb_=(t)-(NT-4); if(jb_>=-3)cmask(P0,P1,jb_,qrel,hi,tab);}while(0)
  bool resc=false;
  #define START(P0,P1) do{ if constexpr(!FAST){ const float rm=rowmax(P0,P1); resc=false; \
    { const float dl=rm; mhat=fadd_s(mhat,dl); \
      _Pragma("unroll") for(int r=0;r<16;++r){P0[r]=fsub_s(P0[r],dl);P1[r]=fsub_s(P1[r],dl);} } } \
    _Pragma("unroll") for(int r=0;r<16;++r)P0[r]=__builtin_amdgcn_exp2f(P0[r]); }while(0)
  #define RESC() do{ if constexpr(!FAST) if(resc){ asm volatile("s_waitcnt lgkmcnt(0)":::"memory"); \
      _Pragma("unroll") for(int d_=0;d_<4;++d_) _Pragma("unroll") for(int r=0;r<16;++r)o[d_][r]*=wsf[crow(r,hi)]; } }while(0)
  f32x16 pA0,pA1,pB0,pB1;
  int sl_prev=0,sl_cur=0,sl_next=SLOTB;
  #define ROT() do{sl_prev=sl_cur;sl_cur=sl_next;sl_next=(sl_next==(NSLOT-1)*SLOTB)?0:sl_next+SLOTB;}while(0)
  DMA_K(2,2*SLOTB);
  WAIT_BAR(4);
  qkt(pA0,pA1,Kbase,qr,r32,hi);asm volatile("s_nop 15\n\ts_nop 7":"+v"(pA0),"+v"(pA1));CMASK(pA0,pA1,0);
  START(pA0,pA1);
  _Pragma("unroll") for(int r=0;r<16;++r)pA1[r]=__builtin_amdgcn_exp2f(pA1[r]);
  WAIT_BAR(0);
  DMA_K(3,0);DMA_V(1,SLOTB);
  ROT();
  kload8(kf,kp0+sl_cur);
  WAIT_BAR(3);
  s16x4 vlo[4],vhi[4]; u32x4 pw0,pw1,pw2,pw3;
  #define PKW(P,B) cvtpk_s(P[B],P[B+1])
  #define PAF(k) __builtin_bit_cast(bf16x8,pw##k)
  #define VFR(i) (bf16x8){vlo[i][0],vlo[i][1],vlo[i][2],vlo[i][3],vhi[i][0],vhi[i][1],vhi[i][2],vhi[i][3]}
  #define PIN(x) asm volatile("":"+v"(x))
  #define MX3(a,b,c) __builtin_fmaxf(__builtin_fmaxf((a),(b)),(c))
  #define GAPA(MF,A0,A1,A2,A3,W0,W1,PW) do{ MF; sacc+=A0; sacc+=A1; sacc+=A2; sacc+=A3; PIN(sacc); W0; W1; PIN(PW); SBAR(); }while(0)
  #define EX(v) __builtin_amdgcn_exp2f(v)
  #define GAPB(MF,X,B) do{ MF; X[B]=EX(X[B]); X[B+1]=EX(X[B+1]); X[B+2]=EX(X[B+2]); X[B+3]=EX(X[B+3]); PIN(X); SBAR(); }while(0)
  #define GAPB2(MF,X,B) do{ MF; X[B]=EX(X[B]); X[B+1]=EX(X[B+1]); PIN(X); SBAR(); }while(0)
  #define VRDN(k,db) do{ vlo[k]=vtr(vp_+((db)*4096+(k)*1024)); vhi[k]=vtr(vp_+((db)*4096+(k)*1024+512)); }while(0)
  #define VRD(i) do{ vlo[i]=vtr(vp_+(((i)>>2)*4096+((i)&3)*1024)); vhi[i]=vtr(vp_+(((i)>>2)*4096+((i)&3)*1024+512)); }while(0)
  #define KRD(G,j) do{ if(G){ kload2(kf,kp0+sl_next,j); SBAR(); } }while(0)
  #define STEP(C0,C1,P0,P1,t,GK,GV,GL) do{ SBAR(); \
    const lds_cptr vp_=vp0+2*sl_prev; const f32x16 zc_=f32x16{}; \
    VRDN(0,0); SBAR(); float sacc=(P0[0]+P0[1]); \
    GAPA(C0=__builtin_amdgcn_mfma_f32_32x32x16_bf16(kf[0],qr[0],zc_,0,0,0), P0[2],P0[3],P0[4],P0[5],     pw0[0]=PKW(P0,0), pw0[1]=PKW(P0,2), pw0); \
    GAPA(C1=__builtin_amdgcn_mfma_f32_32x32x16_bf16(kf[1],qr[0],zc_,0,0,0), P0[6],P0[7],P0[8],P0[9],     pw0[2]=PKW(P0,4), pw0[3]=PKW(P0,6), pw0); \
    VRDN(1,0); SBAR(); GAPA(C0=__builtin_amdgcn_mfma_f32_32x32x16_bf16(kf[2],qr[1],C0,0,0,0),   P0[10],P0[11],P0[12],P0[13], pw1[0]=PKW(P0,8), pw1[1]=PKW(P0,10), pw1); \
    GAPA(C1=__builtin_amdgcn_mfma_f32_32x32x16_bf16(kf[3],qr[1],C1,0,0,0),   P0[14],P0[15],P1[0],P1[1],   pw1[2]=PKW(P0,12),pw1[3]=PKW(P0,14), pw1); \
    VRDN(2,0); SBAR(); GAPA(C0=__builtin_amdgcn_mfma_f32_32x32x16_bf16(kf[4],qr[2],C0,0,0,0),   P1[2],P1[3],P1[4],P1[5],     pw2[0]=PKW(P1,0), pw2[1]=PKW(P1,2), pw2); \
    GAPA(C1=__builtin_amdgcn_mfma_f32_32x32x16_bf16(kf[5],qr[2],C1,0,0,0),   P1[6],P1[7],P1[8],P1[9],     pw2[2]=PKW(P1,4), pw2[3]=PKW(P1,6), pw2); \
    VRDN(3,0); SBAR(); GAPA(C0=__builtin_amdgcn_mfma_f32_32x32x16_bf16(kf[6],qr[3],C0,0,0,0),   P1[10],P1[11],P1[12],P1[13], pw3[0]=PKW(P1,8), pw3[1]=PKW(P1,10), pw3); \
    GAPA(C1=__builtin_amdgcn_mfma_f32_32x32x16_bf16(kf[7],qr[3],C1,0,0,0),   P1[14],P1[15],0.f,0.f,       pw3[2]=PKW(P1,12),pw3[3]=PKW(P1,14), pw3); \
    l_reg+=sacc; \
    if(GK){DMA_K((t)+3,sl_cur);} if(GV){DMA_V((t)+1,sl_next);} \
    if constexpr(!FAST){ _Pragma("unroll") for(int r=0;r<16;++r){C0[r]-=mhat;C1[r]-=mhat;} } \
    CMASK(C0,C1,t); \
    if constexpr(!FAST){ float a=MX3(C0[0],C0[1],C1[0]),b=MX3(C0[2],C0[3],C1[1]); a=MX3(a,C1[2],C1[3]); \
      _Pragma("unroll") for(int r=4;r<16;r+=4){a=MX3(a,C0[r],C0[r+1]);b=MX3(b,C0[r+2],C0[r+3]);a=MX3(a,C1[r],C1[r+1]);b=MX3(b,C1[r+2],C1[r+3]);} \
      float rm=__builtin_fmaxf(a,b); { auto rr=__builtin_amdgcn_permlane32_swap(__float_as_uint(rm),__float_as_uint(rm),false,false); rm=__builtin_fmaxf(__uint_as_float(rr[0]),__uint_as_float(rr[1])); } \
      resc=false; \
      if(__builtin_expect(__any(rm>(float)THRL),0)){ const float dl=__builtin_fmaxf(rm,0.f); mhat+=dl; \
        _Pragma("unroll") for(int r=0;r<16;++r){C0[r]-=dl;C1[r]-=dl;} \
        const float f=__builtin_amdgcn_exp2f(-dl); l_reg*=f; if(hi==0)wsf[r32]=f; resc=true; } } \
    SBAR(); \
    GAPB2(o[0]=__builtin_amdgcn_mfma_f32_32x32x16_bf16(PAF(0),VFR(0),o[0],0,0,0), C0,0); VRDN(0,1); SBAR(); \
    GAPB2(o[0]=__builtin_amdgcn_mfma_f32_32x32x16_bf16(PAF(1),VFR(1),o[0],0,0,0), C0,2); VRDN(1,1); SBAR(); \
    KRD(GL,0); GAPB2(o[0]=__builtin_amdgcn_mfma_f32_32x32x16_bf16(PAF(2),VFR(2),o[0],0,0,0), C0,4); VRDN(2,1); SBAR(); \
    KRD(GL,1); GAPB2(o[0]=__builtin_amdgcn_mfma_f32_32x32x16_bf16(PAF(3),VFR(3),o[0],0,0,0), C0,6); VRDN(3,1); SBAR(); \
    KRD(GL,2); GAPB2(o[1]=__builtin_amdgcn_mfma_f32_32x32x16_bf16(PAF(0),VFR(0),o[1],0,0,0), C0,8); VRDN(0,2); SBAR(); \
    KRD(GL,3); GAPB2(o[1]=__builtin_amdgcn_mfma_f32_32x32x16_bf16(PAF(1),VFR(1),o[1],0,0,0), C0,10); VRDN(1,2); SBAR(); \
    GAPB2(o[1]=__builtin_amdgcn_mfma_f32_32x32x16_bf16(PAF(2),VFR(2),o[1],0,0,0), C0,12); VRDN(2,2); SBAR(); \
    GAPB2(o[1]=__builtin_amdgcn_mfma_f32_32x32x16_bf16(PAF(3),VFR(3),o[1],0,0,0), C0,14); VRDN(3,2); SBAR(); \
    GAPB2(o[2]=__builtin_amdgcn_mfma_f32_32x32x16_bf16(PAF(0),VFR(0),o[2],0,0,0), C1,0); VRDN(0,3); SBAR(); \
    GAPB2(o[2]=__builtin_amdgcn_mfma_f32_32x32x16_bf16(PAF(1),VFR(1),o[2],0,0,0), C1,2); VRDN(1,3); SBAR(); \
    GAPB2(o[2]=__builtin_amdgcn_mfma_f32_32x32x16_bf16(PAF(2),VFR(2),o[2],0,0,0), C1,4); VRDN(2,3); SBAR(); \
    GAPB2(o[2]=__builtin_amdgcn_mfma_f32_32x32x16_bf16(PAF(3),VFR(3),o[2],0,0,0), C1,6); VRDN(3,3); SBAR(); \
    GAPB2(o[3]=__builtin_amdgcn_mfma_f32_32x32x16_bf16(PAF(0),VFR(0),o[3],0,0,0), C1,8); \
    GAPB2(o[3]=__builtin_amdgcn_mfma_f32_32x32x16_bf16(PAF(1),VFR(1),o[3],0,0,0), C1,10); \
    GAPB2(o[3]=__builtin_amdgcn_mfma_f32_32x32x16_bf16(PAF(2),VFR(2),o[3],0,0,0), C1,12); \
    GAPB2(o[3]=__builtin_amdgcn_mfma_f32_32x32x16_bf16(PAF(3),VFR(3),o[3],0,0,0), C1,14); \
    }while(0)
  int t=1;
  #undef CMASK
  #define CMASK(P0,P1,t) do{}while(0)
  for(;t+7<NT;t+=2){
    STEP(pB0,pB1,pA0,pA1,t,true,true,true);     WAIT_BAR(3); RESC(); ROT();
    STEP(pA0,pA1,pB0,pB1,t+1,true,true,true);   WAIT_BAR(3); RESC(); ROT();
  }
  #undef CMASK
  #define CMASK(P0,P1,t) do{int jb_=(t)-(NT-4); if(jb_>=-3)cmask(P0,P1,jb_,qrel,hi,tab);}while(0)
  #define ENDW(tt) do{ if((tt)+3<NT){WAIT_BAR(3);} else if((tt)+2<NT){WAIT_BAR(2);} else {WAIT_BAR(0);} }while(0)
  for(;t+1<NT;t+=2){
    STEP(pB0,pB1,pA0,pA1,t,(t+3<NT),(t+1<NT),(t+1<NT));       ENDW(t);   RESC(); ROT();
    STEP(pA0,pA1,pB0,pB1,t+1,(t+4<NT),(t+2<NT),(t+2<NT));     ENDW(t+1); RESC(); ROT();
  }
  STEP(pB0,pB1,pA0,pA1,NT-1,false,false,false); RESC();
  { float sacc=pB0[0]+pB0[1]; _Pragma("unroll") for(int r=2;r<16;++r)sacc+=pB0[r]; _Pragma("unroll") for(int r=0;r<16;++r)sacc+=pB1[r]; l_reg+=sacc;
    pw0=(u32x4){PKW(pB0,0),PKW(pB0,2),PKW(pB0,4),PKW(pB0,6)};pw1=(u32x4){PKW(pB0,8),PKW(pB0,10),PKW(pB0,12),PKW(pB0,14)};pw2=(u32x4){PKW(pB1,0),PKW(pB1,2),PKW(pB1,4),PKW(pB1,6)};pw3=(u32x4){PKW(pB1,8),PKW(pB1,10),PKW(pB1,12),PKW(pB1,14)};
    SBAR(); pv(o,vb0+2*sl_cur,PAF(0),PAF(1),PAF(2),PAF(3)); }
  #undef PKW
  #undef PAF
  #undef VFR
  #undef PIN
  #undef MX3
  #undef GAPA
  #undef GAPB
  #undef EX
  #undef VRD
  #undef VRDN
  #undef GAPB2
  #undef KRD
  #undef STEP
  #undef ENDW
  {auto rr=__builtin_amdgcn_permlane32_swap(__float_as_uint(l_reg),__float_as_uint(l_reg),false,false);l_reg=__uint_as_float(rr[0])+__uint_as_float(rr[1]);}
  if(hi==0)wsf[32+r32]=l_reg;asm volatile("s_waitcnt lgkmcnt(0)":::"memory");
  float rli[16];
  #pragma unroll
  for(int r=0;r<16;++r)rli[r]=__builtin_amdgcn_rcpf(wsf[32+crow(r,hi)]);
  bf16*Ow=O+(rowbase+q0+wid*QBLK)*OP+hm*128;
  { bf16*stg=(bf16*)(shm+LDS_OST)+wid*2048;
    #pragma unroll
    for(int pp=0;pp<2;++pp){
      #pragma unroll
      for(int r=0;r<16;++r){const int orow=crow(r,hi);
        #pragma unroll
        for(int d0=0;d0<2;++d0)stg[orow*64+d0*32+r32]=__float2bfloat16(o[2*pp+d0][r]*rli[r]);}
      asm volatile("s_waitcnt lgkmcnt(0)":::"memory");
      #pragma unroll
      for(int i=0;i<4;++i){const int row=i*8+(lane>>3),ch=lane&7; const u32x4 v=*(const u32x4*)(stg+row*64+ch*8); ATTN_STORE16(Ow+(long)row*OP+pp*64+ch*8,v);}
      asm volatile("s_waitcnt lgkmcnt(0)":::"memory"); } }
  asm volatile("s_waitcnt lgkmcnt(0)\n\ts_barrier":::"memory");
  #undef DMA_K
  #undef DMA_V
  #undef CMASK
  #undef START
  #undef RESC
  #undef ROT
}
constexpr int ATTN_LDS_BYTES=LDS_BYTES;
template<int THRL=8> __device__ __forceinline__ void attn_phase(char*lds,const bf16*QKV,bf16*ODT,const float*tab4,int vcu,const int tid,const int fast){
  const int bm=vcu>>4,x=vcu&15; const float*tab=tab4+((bm&7)>>1)*128;
  if(fast){ attn_unit<THRL,true>(bm>>3,bm&7,x,QKV,ODT,lds,tab,tid); attn_unit<THRL,true>(bm>>3,bm&7,31-x,QKV,ODT,lds,tab,tid); }
  else { attn_unit<THRL,false>(bm>>3,bm&7,x,QKV,ODT,lds,tab,tid); attn_unit<THRL,false>(bm>>3,bm&7,31-x,QKV,ODT,lds,tab,tid); }
}
#undef SBAR
#undef WAIT_BAR
}
namespace da {
typedef unsigned short bf16;
typedef short bf16x8 __attribute__((ext_vector_type(8)));
typedef short s16x4 __attribute__((ext_vector_type(4)));
typedef float f32x16 __attribute__((ext_vector_type(16)));
typedef unsigned u32x4 __attribute__((ext_vector_type(4)));
constexpr int NW = 8, QBLK = 32, KVBLK = 64, QB = NW * QBLK, DQ = 64, DV = 128;
constexpr int SHM_V = KVBLK * DV * 2, SHM_K = KVBLK * DQ * 2;
constexpr int LDS_BYTES = 2 * SHM_V + 2 * SHM_K + NW * 64 * 4;
constexpr float SCALE = 0.6931471805599453f;
constexpr float THR = 8.f;
#define DA_KSWZ(row, colB) ((row) * 128 + ((colB) ^ (((row) & 7) << 4)))
#define DA_SBAR() __builtin_amdgcn_sched_barrier(0)
__device__ __forceinline__ int v_st(int k, int c) { const int kk = (k & ~0xC) | ((k & 4) << 1) | ((k & 8) >> 1); return ((kk >> 3) * 4 + (c >> 5)) * 512 + ((kk & 7) * 32 + (c & 31)) * 2; }
__device__ __forceinline__ int v_rd_base(int lane) { return ((lane & 3) << 3) | (((lane >> 2) & 3) << 6) | (((lane >> 4) & 1) << 5) | (((lane >> 5) & 1) << 8); }
constexpr int v_rd_off(int d0, int ks, int half) { return d0 * 512 + ks * 4096 + half * 2048; }
__device__ __forceinline__ int crow(int r, int hi) { return (r & 3) + 8 * (r >> 2) + 4 * hi; }
__device__ __forceinline__ unsigned cvtpk(float lo, float hi) { unsigned r; asm volatile("v_cvt_pk_bf16_f32 %0, %1, %2" : "=v"(r) : "v"(lo), "v"(hi)); return r; }
__device__ __forceinline__ bf16x8 load8(const bf16* p) { return *reinterpret_cast<const bf16x8*>(p); }
__device__ __forceinline__ void mask_bias_tile(f32x16& p0, f32x16& p1, int dq, const float* tab) {
    const float NEG = -__builtin_inff();
#pragma unroll
    for (int r = 0; r < 16; ++r) { const int c = (r & 3) + 8 * (r >> 2); const int d0 = dq - c, d1 = d0 - 32;
        const float b0 = tab[d0 < 0 ? 0 : (d0 > 127 ? 127 : d0)], b1 = tab[d1 < 0 ? 0 : (d1 > 127 ? 127 : d1)];
        p0[r] = d0 < 0 ? NEG : p0[r] + b0; p1[r] = d1 < 0 ? NEG : p1[r] + b1;
        if ((r & 1) == 1) { asm volatile("" : "+v"(p0), "+v"(p1) :: "memory"); } }
}
__device__ __forceinline__ void partialSM(f32x16& p0, f32x16& p1, float& m_reg, float& mn, float& alpha) {
    float pmax = p0[0]; for (int r = 1; r < 16; ++r) pmax = fmaxf(pmax, p0[r]); for (int r = 0; r < 16; ++r) pmax = fmaxf(pmax, p1[r]);
    { auto rr = __builtin_amdgcn_permlane32_swap(__float_as_uint(pmax), __float_as_uint(pmax), false, false);
      pmax = fmaxf(__uint_as_float(rr[0]), __uint_as_float(rr[1])); }
    constexpr float C2 = 1.4426950408889634f * SCALE;
    if (__builtin_expect(__all((pmax - m_reg) * SCALE <= THR), 1)) { mn = m_reg; alpha = 1.f; }
    else { mn = fmaxf(m_reg, pmax); alpha = __builtin_amdgcn_exp2f((m_reg - mn) * C2); m_reg = mn; }
    const float mnL = -mn * C2;
    for (int r = 0; r < 16; ++r) p0[r] = fmaf(p0[r], C2, mnL); for (int r = 0; r < 16; ++r) p1[r] = fmaf(p1[r], C2, mnL);
    for (int r = 0; r < 16; ++r) p0[r] = __builtin_amdgcn_exp2f(p0[r]);
}
__device__ __forceinline__ void finishSM(f32x16& p0, f32x16& p1, float alpha, float& l_reg, bf16x8& pa0, bf16x8& pa1, bf16x8& pa2, bf16x8& pa3) {
    for (int r = 0; r < 16; ++r) p1[r] = __builtin_amdgcn_exp2f(p1[r]);
    float ps = 0; for (int r = 0; r < 16; ++r) ps += p0[r]; for (int r = 0; r < 16; ++r) ps += p1[r];
    { auto rr = __builtin_amdgcn_permlane32_swap(__float_as_uint(ps), __float_as_uint(ps), false, false);
      ps = __uint_as_float(rr[0]) + __uint_as_float(rr[1]); }
    l_reg = l_reg * alpha + ps;
#define DA_PK4(P, B_, OUT) do { unsigned a0 = cvtpk(P[B_+0], P[B_+1]), a1 = cvtpk(P[B_+2], P[B_+3]);                          \
        unsigned b0 = cvtpk(P[B_+4], P[B_+5]), b1 = cvtpk(P[B_+6], P[B_+7]);                                             \
        auto r0 = __builtin_amdgcn_permlane32_swap(a0, b0, false, false); auto r1 = __builtin_amdgcn_permlane32_swap(a1, b1, false, false); \
        u32x4 w = {r0[0], r1[0], r0[1], r1[1]}; OUT = *reinterpret_cast<bf16x8*>(&w); } while (0)
    DA_PK4(p0, 0, pa0); DA_PK4(p0, 8, pa1); DA_PK4(p1, 0, pa2); DA_PK4(p1, 8, pa3);
#undef DA_PK4
}
template <int KB>
__device__ __forceinline__ void qkt(f32x16& p0, f32x16& p1, const char* K_lds, int r32, int hi, const bf16x8* qr) {
    p0 = f32x16{}; p1 = f32x16{};
#pragma unroll
    for (int d0 = 0; d0 < 4; ++d0) { const char* a = K_lds + KB * SHM_K + DA_KSWZ(r32, (d0 * 16 + hi * 8) * 2);
        bf16x8 b0 = *reinterpret_cast<const bf16x8*>(a);
        bf16x8 b1 = *reinterpret_cast<const bf16x8*>(a + 32 * 128);
        p0 = __builtin_amdgcn_mfma_f32_32x32x16_bf16(b0, qr[d0], p0, 0, 0, 0);
        p1 = __builtin_amdgcn_mfma_f32_32x32x16_bf16(b1, qr[d0], p1, 0, 0, 0); }
}
template <int VB>
__device__ __forceinline__ void pv_tile(f32x16* o, int vb0, bf16x8 pa0, bf16x8 pa1, bf16x8 pa2, bf16x8 pa3) {
#define DA_TRRD(dst, off) asm volatile("ds_read_b64_tr_b16 %0, %1 offset:%2" : "=&v"(dst) : "v"(vb0), "i"(off) : "memory")
#define DA_PV_D0(d0) do { s16x4 l0, l1, l2, l3, h0, h1, h2, h3; constexpr int b_ = VB * SHM_V + v_rd_off(d0, 0, 0); \
        DA_TRRD(l0, b_); DA_TRRD(h0, b_ + 2048); DA_TRRD(l1, b_ + 4096); DA_TRRD(h1, b_ + 6144); DA_TRRD(l2, b_ + 8192); DA_TRRD(h2, b_ + 10240); DA_TRRD(l3, b_ + 12288); DA_TRRD(h3, b_ + 14336); \
        asm volatile("s_waitcnt lgkmcnt(0)" ::: "memory"); DA_SBAR();   \
        o[d0] = __builtin_amdgcn_mfma_f32_32x32x16_bf16(pa0, (bf16x8){l0[0], l0[1], l0[2], l0[3], h0[0], h0[1], h0[2], h0[3]}, o[d0], 0, 0, 0);   \
        o[d0] = __builtin_amdgcn_mfma_f32_32x32x16_bf16(pa1, (bf16x8){l1[0], l1[1], l1[2], l1[3], h1[0], h1[1], h1[2], h1[3]}, o[d0], 0, 0, 0);   \
        o[d0] = __builtin_amdgcn_mfma_f32_32x32x16_bf16(pa2, (bf16x8){l2[0], l2[1], l2[2], l2[3], h2[0], h2[1], h2[2], h2[3]}, o[d0], 0, 0, 0);   \
        o[d0] = __builtin_amdgcn_mfma_f32_32x32x16_bf16(pa3, (bf16x8){l3[0], l3[1], l3[2], l3[3], h3[0], h3[1], h3[2], h3[3]}, o[d0], 0, 0, 0); } while (0)
    DA_PV_D0(0); DA_PV_D0(1); DA_PV_D0(2); DA_PV_D0(3);
#undef DA_PV_D0
#undef DA_TRRD
}
constexpr int QP = 512, KP = 512, VP = 512, OP = 1024;
struct BlockRef { const bf16* Q; const bf16* K; const bf16* V; bf16* O; int P0; };
struct Seam { bf16x8 qr[4]; bf16x8 st_v0, st_v1, st_k; };
#define DA_VROW(p, k0, rr) ((p) + (size_t)((k0) + (rr)) * VP + sc)
#define DA_KROW(p, k0) ((p) + (size_t)((k0) + kr) * KP + kc)
#define DA_VMW() asm volatile("s_waitcnt vmcnt(0)" ::: "memory")
#define DA_VMWN(n) asm volatile("s_waitcnt vmcnt(%0)" :: "i"(n) : "memory")
#define DA_SLOAD(Kp, Vp, k0) do { S.st_v0 = load8(DA_VROW(Vp, k0, sr)); S.st_v1 = load8(DA_VROW(Vp, k0, 32 + sr)); S.st_k = load8(DA_KROW(Kp, k0)); } while (0)
#define DA_SWRITE_K(bf) do { *(bf16x8*)(K_lds + (bf) * SHM_K + kws) = S.st_k; } while (0)
#define DA_SWRITE_V(bf) do { *(bf16x8*)(V_lds + (bf) * SHM_V + vst0) = S.st_v0; *(bf16x8*)(V_lds + (bf) * SHM_V + vst1) = S.st_v1; } while (0)
#define DA_SWRITE(bf) do { DA_SWRITE_V(bf); DA_SWRITE_K(bf); } while (0)
__device__ __forceinline__ void prime(const BlockRef& cur, char* lds, Seam& S, const int tid) {
    const int wid = __builtin_amdgcn_readfirstlane(tid >> 6), lane = tid & 63, r32 = lane & 31, hi = lane >> 5;
    const int sr = tid >> 4, sc = (tid & 15) * 8, kr = tid >> 3, kc = (tid & 7) * 8, kws = DA_KSWZ(kr, kc * 2); char* K_lds = lds + 2 * SHM_V;
#pragma unroll
    for (int d0 = 0; d0 < 4; ++d0) S.qr[d0] = load8(cur.Q + (size_t)(wid * QBLK + r32) * QP + d0 * 16 + hi * 8);
    DA_SLOAD(cur.K, cur.V, 0); DA_VMW(); DA_SWRITE_K(0);
    __syncthreads();
}
__device__ __forceinline__ void block(const BlockRef& cur, const BlockRef& nxt, char* lds, Seam& S, const float* tab, const int tid) {
    const int wid = __builtin_amdgcn_readfirstlane(tid >> 6), lane = tid & 63, r32 = lane & 31, hi = lane >> 5;
    const int NT = (cur.P0 + QB - 1) / KVBLK + 1;
    const int qlo = cur.P0 + wid * QBLK, qm = qlo + r32 - 4 * hi;
    char* V_lds = lds; char* K_lds = lds + 2 * SHM_V;
    float* ws = (float*)(lds + 2 * SHM_V + 2 * SHM_K) + wid * 64; float* li_l = ws, * al_l = ws + 32;
    float m_reg = -1e30f, l_reg = 0; f32x16 o[4] = {};
    const int sr = tid >> 4, sc = (tid & 15) * 8, vst0 = v_st(sr, sc), vst1 = v_st(32 + sr, sc), kr = tid >> 3, kc = (tid & 7) * 8, kws = DA_KSWZ(kr, kc * 2);
    const int vb0 = (int)(uintptr_t)V_lds + v_rd_base(lane);
    const bf16* Kh = cur.K; const bf16* Vh = cur.V;
#define DA_RESC(a) do { if (__any((a) < 1.f)) { if (hi == 0) al_l[r32] = (a); asm volatile("s_waitcnt lgkmcnt(0)" ::: "memory");              \
                     for (int d_ = 0; d_ < 4; ++d_) for (int r = 0; r < 16; ++r) o[d_][r] *= al_l[crow(r, hi)]; } } while (0)
#define DA_KBASE(t) ((t) * KVBLK)
#define DA_MASKT(P0_, P1_, t) do { const int kb_ = DA_KBASE(t); if (kb_ + KVBLK - 1 + 113 > qlo) mask_bias_tile(P0_, P1_, qm - kb_, tab); } while (0)
    constexpr int NQL = 4;
#define DA_SEAM_K0() do { DA_VMWN(NQL); DA_SWRITE_K(0); DA_SBAR(); } while (0)
    f32x16 pA0, pA1, pB0, pB1; float mnA, mnB, alA, alB; bf16x8 pa0, pa1, pa2, pa3;
    DA_SWRITE_V(0); DA_SBAR();
    if (NT > 1) { DA_SLOAD(Kh, Vh, DA_KBASE(1)); }
    DA_SBAR(); qkt<0>(pA0, pA1, K_lds, r32, hi, S.qr);
    DA_MASKT(pA0, pA1, 0); partialSM(pA0, pA1, m_reg, mnA, alA);
    if (NT > 1) { DA_VMW(); DA_SWRITE(1); }
    __syncthreads();
#define DA_HALF_STEP(PX0, PX1, mnX, alX, PY0, PY1, alY, t, KB, VB, SB) do {                                                      \
        DA_SBAR(); qkt<KB>(PX0, PX1, K_lds, r32, hi, S.qr);                                             \
        finishSM(PY0, PY1, alY, l_reg, pa0, pa1, pa2, pa3); DA_SBAR();                                                           \
        if ((t) + 1 < NT) { DA_SLOAD(Kh, Vh, DA_KBASE((t) + 1)); DA_SBAR(); }                                               \
        pv_tile<VB>(o, vb0, pa0, pa1, pa2, pa3); DA_MASKT(PX0, PX1, (t)); partialSM(PX0, PX1, m_reg, mnX, alX);                                        \
        __syncthreads();                                                                                                      \
        if ((t) + 1 < NT) { DA_VMW(); DA_SWRITE(SB); }                                                                          \
        DA_RESC(alX); __syncthreads(); } while (0)
    for (int t = 1; t + 1 < NT; t += 2) {
        DA_HALF_STEP(pB0, pB1, mnB, alB, pA0, pA1, alA, t, 1, 0, 0);
        DA_HALF_STEP(pA0, pA1, mnA, alA, pB0, pB1, alB, t + 1, 0, 1, 1);
    }
    const bool even = (NT & 1) == 0;
    if (even) { DA_SBAR(); qkt<1>(pB0, pB1, K_lds, r32, hi, S.qr); DA_SBAR(); }
    DA_SLOAD(nxt.K, nxt.V, 0); DA_SBAR();
#pragma unroll
    for (int d0 = 0; d0 < 4; ++d0) S.qr[d0] = load8(nxt.Q + (size_t)(wid * QBLK + r32) * QP + d0 * 16 + hi * 8);
    DA_SBAR();
    finishSM(pA0, pA1, alA, l_reg, pa0, pa1, pa2, pa3); DA_SBAR();
    pv_tile<0>(o, vb0, pa0, pa1, pa2, pa3);
    if (even) { DA_MASKT(pB0, pB1, NT - 1); partialSM(pB0, pB1, m_reg, mnB, alB); __syncthreads(); DA_RESC(alB);
        finishSM(pB0, pB1, alB, l_reg, pa0, pa1, pa2, pa3); DA_SBAR(); pv_tile<1>(o, vb0, pa0, pa1, pa2, pa3); }
    DA_SBAR(); DA_SEAM_K0();
    if (hi == 0) li_l[r32] = l_reg; asm volatile("s_waitcnt lgkmcnt(0)" ::: "memory");
    float rli[16];
#pragma unroll
    for (int r = 0; r < 16; ++r) rli[r] = __builtin_amdgcn_rcpf(li_l[crow(r, hi)]);
    bf16* Ow = cur.O + (size_t)(wid * QBLK) * OP;
#pragma unroll
    for (int r = 0; r < 16; ++r) { const int orow = crow(r, hi);
#pragma unroll
        for (int d0 = 0; d0 < 4; ++d0) { const float v = o[d0][r] * rli[r];
            const float vn = __shfl_xor(v, 1);
            if ((r32 & 1) == 0) *(unsigned*)(Ow + (size_t)orow * OP + d0 * 32 + r32) = cvtpk(v, vn); } }
    __syncthreads();
#undef DA_RESC
#undef DA_KBASE
#undef DA_MASKT
#undef DA_SEAM_K0
#undef DA_HALF_STEP
}
#undef DA_VROW
#undef DA_KROW
#undef DA_VMW
#undef DA_VMWN
#undef DA_SLOAD
#undef DA_SWRITE_K
#undef DA_SWRITE_V
#undef DA_SWRITE
__device__ __forceinline__ BlockRef ref(const bf16* QKV, bf16* ODT, int bm, int qb) {
    const int b = bm >> 3, hm = bm & 7; BlockRef r; const size_t rowb = (size_t)b * 8192;
    r.Q = QKV + (rowb + (size_t)qb * QB) * QP + hm * 64; r.K = QKV + (size_t)16384 * 512 + rowb * KP + hm * 64; r.V = QKV + (size_t)2 * 16384 * 512 + rowb * VP + (hm >> 1) * 128;
    r.O = ODT + (rowb + (size_t)qb * QB) * OP + hm * 128; r.P0 = qb * QB; return r;
}
__device__ __forceinline__ void phase(char* lds, const bf16* QKV, bf16* ODT, const float* tab4, int vcu, const int tid) {
    const int bm = vcu >> 4, x = vcu & 15; const float* tab = tab4 + ((bm & 7) >> 1) * 128;
    const BlockRef b0 = ref(QKV, ODT, bm, x), b1 = ref(QKV, ODT, bm, 31 - x);
    Seam S;
    prime(b0, lds, S, tid);
    block(b0, b1, lds, S, tab, tid);
    block(b1, b1, lds, S, tab, tid);
}
}
constexpr int NWAVES = 8;
#ifndef MK_ONE_LAUNCH
#define MK_ONE_LAUNCH 1
#endif
constexpr int T = 16384, SEQ = 8192, D = 1024, INW = 6400, NL = 2, NEXP = 32, DFF = 1024;
constexpr int NR_MAX = 73728;
constexpr float NORM_EPS = 1e-6f;
constexpr float LOG2E = 1.4426950408889634f;
constexpr float QSCALE = 0.125f * LOG2E;
constexpr size_t MiB = 1u << 20;
constexpr size_t WS_CTL = 0, CTL_ZERO_BYTES = 65536;
constexpr size_t WS_MOD = 1 * MiB;
constexpr size_t WS_SUMM = 2 * MiB;
constexpr size_t WS_BLKCNT = 3 * MiB;
constexpr size_t WS_TILEMAP = 3 * MiB + 65536;
constexpr size_t WS_TOPW = 4 * MiB;
constexpr size_t WS_ERANK = 4 * MiB + 512 * 1024;
constexpr size_t WS_DEST = 5 * MiB;
constexpr size_t WS_ROWTOK = 5 * MiB + 512 * 1024;
constexpr size_t WS_WIN = 8 * MiB;
constexpr size_t WS_WBR = 34 * MiB;
constexpr size_t WS_WOUT = 40 * MiB;
constexpr size_t WS_W1 = 48 * MiB;
constexpr size_t WS_W2 = 304 * MiB;
constexpr size_t WS_H = 432 * MiB;
constexpr size_t WS_PROJ = 464 * MiB;
constexpr size_t WS_BR = 664 * MiB;
constexpr size_t WS_ODT = 712 * MiB;
constexpr size_t WS_MERGED = 744 * MiB;
constexpr size_t WS_XS = 776 * MiB;
constexpr size_t WS_ACT = 920 * MiB;
constexpr size_t WS_Y = 1064 * MiB;
constexpr size_t WS_END = 1208 * MiB;
constexpr int CW_BAR = 4096;
constexpr int CW_TILE = 8192;
constexpr int RING_OFF = 0, RING_BYTES = 131072;
constexpr int TAB_OFF = 110592;
constexpr int LDSCTL_OFF = RING_BYTES, MISC_OFF = LDSCTL_OFF + 320;
constexpr int TMAP_OFF = LDSCTL_OFF + 1024;
constexpr int LDS_BYTES = 147456;

#define GAS __attribute__((address_space(1)))
#define LAS __attribute__((address_space(3)))
typedef unsigned short bf16;
typedef unsigned v4u __attribute__((ext_vector_type(4)));
typedef unsigned v2u __attribute__((ext_vector_type(2)));
typedef float f32x4 __attribute__((ext_vector_type(4)));
typedef GAS unsigned gu32;
#define RLX_AGENT __ATOMIC_RELAXED, __HIP_MEMORY_SCOPE_AGENT
#define LDS_WAIT() asm volatile("s_waitcnt lgkmcnt(0)" ::: "memory")
#define VM_WAIT() asm volatile("s_waitcnt vmcnt(0)" ::: "memory")
__device__ __forceinline__ unsigned pk2(float lo, float hi) { typedef float f2_t_ __attribute__((ext_vector_type(2))); typedef __bf16 b2_t_ __attribute__((ext_vector_type(2))); f2_t_ v = {lo, hi}; b2_t_ b = __builtin_convertvector(v, b2_t_); return __builtin_bit_cast(unsigned, b); }
__device__ __forceinline__ unsigned f2bf(float f) { return pk2(f, 0.f) & 0xffffu; }
__device__ __forceinline__ float bflo(unsigned w) { return __uint_as_float(w << 16); }
__device__ __forceinline__ float bfhi(unsigned w) { return __uint_as_float(w & 0xffff0000u); }
__device__ __forceinline__ float bf1(bf16 h) { return __uint_as_float((unsigned)h << 16); }
#define XB_TMO      128
#define XB_XCNT(j)  (256  + 64 * (j))
#define XB_XSUB(j)  (1280 + 64 * (j))
#define XB_XGEN(j)  (2304 + 64 * (j))
#define XB_TOP      3328
#define XB_TOPGEN   3392
#define XCD_BAR_WORDS 3456
#define XB_SPIN_CAP (1u << 18)

__device__ __forceinline__ unsigned xb_ld(unsigned* p)              { return __hip_atomic_load(p, __ATOMIC_RELAXED, __HIP_MEMORY_SCOPE_AGENT); }
__device__ __forceinline__ unsigned xb_add(unsigned* p, unsigned v) { return __hip_atomic_fetch_add(p, v, __ATOMIC_RELAXED, __HIP_MEMORY_SCOPE_AGENT); }
__device__ __forceinline__ unsigned xb_xcc_id() { return (unsigned)__builtin_amdgcn_s_getreg((3 << 11) | 20) & 0xFu; }
#define XB_SPIN(cond, bar) do { unsigned _sp = 0; while (cond) { __builtin_amdgcn_s_sleep(1); \
    if ((++_sp & 255u) == 0u) { if (xb_ld(&(bar)[XB_TMO])) break; if (_sp > XB_SPIN_CAP) { atomicAdd(&(bar)[XB_TMO], 1u); break; } } } } while (0)

struct XcdBarrier {
    unsigned* bar; unsigned x;
    volatile LAS unsigned* st;
};

__device__ __forceinline__ XcdBarrier xcd_barrier_post(unsigned* bar, volatile LAS unsigned* st) {
    XcdBarrier b; b.bar = bar; b.x = xb_xcc_id(); b.st = st;
    if (threadIdx.x == 0) (void)xb_add(&bar[XB_XCNT(b.x)], 1u);
    return b;
}
__device__ __forceinline__ void xcd_barrier_complete(unsigned* bar, unsigned x, unsigned& nloc, unsigned& nx) {
    const unsigned G = gridDim.x * gridDim.y * gridDim.z;
    unsigned sum, cnt, mine, sp = 0u;
    for (;;) {
        sum = 0u; cnt = 0u; mine = 0u;
#pragma unroll
        for (unsigned j = 0; j < 16; ++j) { const unsigned c = xb_ld(&bar[XB_XCNT(j)]); sum += c; cnt += (c > 0u) ? 1u : 0u; mine = (j == x) ? c : mine; }
        if (sum == G) break;
        __builtin_amdgcn_s_sleep(1);
        if ((++sp & 255u) == 0u) { if (xb_ld(&bar[XB_TMO])) break; if (sp > XB_SPIN_CAP) { atomicAdd(&bar[XB_TMO], 1u); break; } }
    }
    nloc = mine > 0u ? mine : 1u; nx = cnt > 0u ? cnt : 1u;
}

__device__ __forceinline__ void xcd_barrier(const XcdBarrier& b) {
    asm volatile("s_waitcnt vmcnt(0)" ::: "memory");
    __syncthreads();
    if (threadIdx.x == 0) {
        unsigned* bar = b.bar;
        __builtin_amdgcn_s_waitcnt(0);
        unsigned nloc = b.st[0], nx = b.st[1];
        if (nloc == 0u) { xcd_barrier_complete(bar, b.x, nloc, nx); b.st[0] = nloc; b.st[1] = nx; }
        const unsigned old = xb_add(&bar[XB_XSUB(b.x)], 1u);
        const unsigned gen = old / nloc;
        if (old + 1u == (gen + 1u) * nloc) {
            __builtin_amdgcn_fence(__ATOMIC_RELEASE, "agent");
            asm volatile("s_waitcnt vmcnt(0)" ::: "memory");
            const unsigned og = xb_add(&bar[XB_TOP], 1u);
            const unsigned tg = og / nx;
            if (og + 1u == (tg + 1u) * nx) xb_add(&bar[XB_TOPGEN], 1u);
            else XB_SPIN(xb_ld(&bar[XB_TOPGEN]) == tg, bar);
            __builtin_amdgcn_fence(__ATOMIC_ACQUIRE, "agent");
            xb_add(&bar[XB_XGEN(b.x)], 1u);
            asm volatile("s_waitcnt vmcnt(0)" ::: "memory");
        } else {
            XB_SPIN(xb_ld(&bar[XB_XGEN(b.x)]) == gen, bar);
            __builtin_amdgcn_fence(__ATOMIC_ACQUIRE, "agent");
            asm volatile("s_waitcnt vmcnt(0)" ::: "memory");
        }
    }
    __syncthreads();
}
struct Frame {
    LAS unsigned char* lds;
    volatile LAS unsigned* MISC;
    gu32* ctl;
    int tid, lane, wave, vcu, G;
    float* out; unsigned char* ws;
};
__device__ __forceinline__ const float* inp(int i) { typedef __attribute__((address_space(4))) const unsigned long long* kap_t; kap_t ka = (kap_t)__builtin_amdgcn_kernarg_segment_ptr(); asm volatile("" : "+s"(ka)); return (const float*)(const GAS float*)ka[i]; }
enum { I_X = 0, I_C, I_WADA, I_BADA, I_NMIX, I_NFFN, I_WIN, I_CONVW, I_CONVB, I_LWA, I_LBA, I_LWX, I_LBX, I_LLAM, I_DQN, I_DKN, I_DLAM, I_DSUB, I_SQN, I_SKN, I_SINK, I_RELB, I_WBR, I_WOUT, I_WR, I_BR, I_W1, I_B1, I_W2, I_B2 };

__device__ __forceinline__ float wave_sum(float v) {
#pragma unroll
    for (int o = 1; o < 64; o <<= 1) v += __shfl_xor(v, o);
    return v;
}
struct TrItem { const float* src; bf16* dst; int N, K; };
__device__ __forceinline__ void p0_item_load(const TrItem& t, float (&v)[32], int lane) {
#pragma unroll
    for (int i = 0; i < 32; ++i) v[i] = __builtin_nontemporal_load(t.src + (size_t)(2 * i + (lane >> 5)) * t.N + (lane & 31));
}
__device__ __forceinline__ void p0_item_store(const TrItem& t, const float (&v)[32], LAS float* scr, int lane) {
#pragma unroll
    for (int i = 0; i < 32; ++i) scr[(2 * i + (lane >> 5)) * 33 + (lane & 31)] = v[i];
    LDS_WAIT(); asm volatile("" ::: "memory");
    const int c = lane & 7;
#pragma unroll
    for (int j = 0; j < 4; ++j) { const int n = (lane >> 3) + 8 * j; const LAS float* s = scr + (8 * c) * 33 + n;
        v4u o; o.x = pk2(s[0 * 33], s[1 * 33]); o.y = pk2(s[2 * 33], s[3 * 33]); o.z = pk2(s[4 * 33], s[5 * 33]); o.w = pk2(s[6 * 33], s[7 * 33]);
        __builtin_nontemporal_store(o, (GAS v4u*)(t.dst + (size_t)n * t.K + 8 * c)); }
    LDS_WAIT(); asm volatile("" ::: "memory");
}
constexpr int TI_IN = (1024 / 64) * (INW / 32), TI_BRN = (512 / 64) * (1024 / 32), TI_OUT = (1024 / 64) * (1024 / 32), TI_E1 = (1024 / 64) * (2048 / 32), TI_E2 = (1024 / 64) * (1024 / 32);
constexpr int TI_PER_LAYER = TI_IN + 3 * TI_BRN + TI_OUT + NEXP * TI_E1 + NEXP * TI_E2;
constexpr int TI_DENSE = TI_IN + 3 * TI_BRN + TI_OUT, TI_MOE = NEXP * TI_E1 + NEXP * TI_E2;
#ifndef CQ_X1
#define CQ_X1 32768
#endif
constexpr int CQ_W2L0 = NEXP * TI_E2;
constexpr int CQ_Q0 = TI_DENSE + NEXP * TI_E1 - CQ_X1;
constexpr int CQ_TOTAL = 2 * TI_PER_LAYER - CQ_Q0;
static_assert(CQ_X1 % 16 == 0 && CQ_X1 >= 0 && CQ_X1 <= NEXP * TI_E1, "conversion-queue head");
static_assert(TI_DENSE % 16 == 0 && TI_PER_LAYER % 16 == 0 && CQ_W2L0 % 16 == 0, "conversion-queue batches");
constexpr int CW_CQ = 2048;
__device__ __forceinline__ TrItem p0_item_decode(Frame& F, int it) {
    const int l = it / TI_PER_LAYER; int r = it - l * TI_PER_LAYER; const float* W; bf16* WT; int K, N;
    if (r < TI_IN) { W = inp(I_WIN) + (size_t)l * 1024 * INW; WT = (bf16*)(F.ws + WS_WIN) + (size_t)l * INW * 1024; K = 1024; N = INW; }
    else if ((r -= TI_IN) < 3 * TI_BRN) { const int n = r / TI_BRN; r -= n * TI_BRN; W = inp(I_WBR) + (size_t)(l * 3 + n) * 512 * 1024; WT = (bf16*)(F.ws + WS_WBR) + (size_t)(l * 3 + n) * 1024 * 512; K = 512; N = 1024; }
    else if ((r -= 3 * TI_BRN) < TI_OUT) { W = inp(I_WOUT) + (size_t)l * 1024 * 1024; WT = (bf16*)(F.ws + WS_WOUT) + (size_t)l * 1024 * 1024; K = 1024; N = 1024; }
    else if ((r -= TI_OUT) < NEXP * TI_E1) { const int e = r / TI_E1; r -= e * TI_E1; W = inp(I_W1) + (size_t)(l * NEXP + e) * 1024 * 2048; WT = (bf16*)(F.ws + WS_W1) + (size_t)(l * NEXP + e) * 2048 * 1024; K = 1024; N = 2048; }
    else { r -= NEXP * TI_E1; const int e = r / TI_E2; r -= e * TI_E2; W = inp(I_W2) + (size_t)(l * NEXP + e) * 1024 * 1024; WT = (bf16*)(F.ws + WS_W2) + (size_t)(l * NEXP + e) * 1024 * 1024; K = 1024; N = 1024; }
    const int nblk = N / 32, gpr = nblk >> 2, g = r >> 4, i16 = r & 15, gkb = g / gpr, gnb = g - gkb * gpr, kb = 4 * gkb + (i16 >> 2), nb = 4 * gnb + (i16 & 3);
    TrItem t; t.src = W + (size_t)(64 * kb) * N + 32 * nb; t.dst = WT + (size_t)(32 * nb) * K + 64 * kb; t.N = N; t.K = K; return t;
}
__device__ __forceinline__ TrItem cq_decode(Frame& F, int q) { return p0_item_decode(F, CQ_Q0 + q); }
__device__ __forceinline__ void cq_run(Frame& F, int max_batches, int until = CQ_TOTAL) {
    LAS float* scr = (LAS float*)(F.lds + RING_OFF + F.wave * 16384);
    volatile LAS int* slot = (volatile LAS int*)(F.lds + LDSCTL_OFF + 64);
    for (int bt = 0; bt < max_batches; ++bt) {
        if (F.tid == 0) { int v = -1;
            if (until >= CQ_TOTAL || __hip_atomic_load((unsigned*)(F.ctl + CW_CQ), __ATOMIC_RELAXED, __HIP_MEMORY_SCOPE_AGENT) < (unsigned)until) v = (int)__hip_atomic_fetch_add((unsigned*)(F.ctl + CW_CQ), 16u, __ATOMIC_RELAXED, __HIP_MEMORY_SCOPE_AGENT);
            *slot = v; }
        __syncthreads();
        const int base = __builtin_amdgcn_readfirstlane(*slot);
        __syncthreads();
        if (base < 0 || base >= CQ_TOTAL) break;
        const int q0 = base + F.wave, q1 = (base + 8 < CQ_TOTAL) ? q0 + 8 : q0;
        const TrItem t0 = cq_decode(F, q0), t1 = cq_decode(F, q1);
        float v0[32], v1[32]; p0_item_load(t0, v0, F.lane); p0_item_load(t1, v1, F.lane);
        p0_item_store(t0, v0, scr, F.lane); p0_item_store(t1, v1, scr, F.lane);
    }
    __syncthreads();
}
__device__ __forceinline__ bool cq_batch8(Frame& F) {
    LAS float* scr = (LAS float*)(F.lds + RING_OFF + F.wave * 16384);
    volatile LAS int* slot = (volatile LAS int*)(F.lds + LDSCTL_OFF + 64);
    if (F.tid == 0) *slot = (int)__hip_atomic_fetch_add((unsigned*)(F.ctl + CW_CQ), 8u, __ATOMIC_RELAXED, __HIP_MEMORY_SCOPE_AGENT);
    __syncthreads();
    const int base = __builtin_amdgcn_readfirstlane(*slot);
    __syncthreads();
    if (base >= CQ_TOTAL) return false;
    const TrItem t0 = cq_decode(F, base + F.wave);
    float v0[32]; p0_item_load(t0, v0, F.lane); p0_item_store(t0, v0, scr, F.lane);
    return true;
}
__device__ __forceinline__ void xcd_barrier_host(Frame& F, const XcdBarrier& b) {
    asm volatile("s_waitcnt vmcnt(0)" ::: "memory");
    __syncthreads();
    volatile LAS unsigned* hw = (volatile LAS unsigned*)(F.lds + LDSCTL_OFF + 68);
    unsigned gen = 0u, tg = 0u; bool leader = false, last = false;
    if (threadIdx.x == 0) {
        unsigned* bar = b.bar;
        __builtin_amdgcn_s_waitcnt(0);
        unsigned nloc = b.st[0], nx = b.st[1];
        if (nloc == 0u) { xcd_barrier_complete(bar, b.x, nloc, nx); b.st[0] = nloc; b.st[1] = nx; }
        const unsigned old = xb_add(&bar[XB_XSUB(b.x)], 1u);
        gen = old / nloc; leader = (old + 1u == (gen + 1u) * nloc);
        if (leader) {
            __builtin_amdgcn_fence(__ATOMIC_RELEASE, "agent");
            asm volatile("s_waitcnt vmcnt(0)" ::: "memory");
            const unsigned og = xb_add(&bar[XB_TOP], 1u);
            tg = og / nx; last = (og + 1u == (tg + 1u) * nx);
            if (last) xb_add(&bar[XB_TOPGEN], 1u);
        }
        hw[0] = leader ? 1u : 0u;
    }
    __syncthreads();
    if (hw[0] == 0u) {
        for (;;) {
            if (hw[1] != 0u) break;
            if (!cq_batch8(F)) { if (threadIdx.x == 0) hw[1] = 1u; break; }
            asm volatile("s_waitcnt vmcnt(0)" ::: "memory");
            if (threadIdx.x == 0) hw[2] = (xb_ld(&b.bar[XB_XGEN(b.x)]) == gen) ? 0u : 1u;
            __syncthreads();
            const unsigned rel = hw[2];
            __syncthreads();
            if (rel != 0u) break;
        }
    }
    if (threadIdx.x == 0) {
        unsigned* bar = b.bar;
        if (leader) {
            if (!last) XB_SPIN(xb_ld(&bar[XB_TOPGEN]) == tg, bar);
            __builtin_amdgcn_fence(__ATOMIC_ACQUIRE, "agent");
            xb_add(&bar[XB_XGEN(b.x)], 1u);
            asm volatile("s_waitcnt vmcnt(0)" ::: "memory");
        } else {
            XB_SPIN(xb_ld(&bar[XB_XGEN(b.x)]) == gen, bar);
            __builtin_amdgcn_fence(__ATOMIC_ACQUIRE, "agent");
            asm volatile("s_waitcnt vmcnt(0)" ::: "memory");
        }
    }
    __syncthreads();
}
__device__ __forceinline__ void p0_prologue(Frame& F) {
    LAS float* scr = (LAS float*)(F.lds + RING_OFF + F.wave * 16384);
    const int gw = F.vcu * NWAVES + F.wave, NGW = F.G * NWAVES;
    {   constexpr int NIT = CQ_Q0;
        float va[32], vb[32]; int it = gw;
        TrItem ta = p0_item_decode(F, it < NIT ? it : NIT - 1), tb = ta;
        p0_item_load(ta, va, F.lane);
        while (it < NIT) {
            const int i1 = it + NGW; tb = p0_item_decode(F, i1 < NIT ? i1 : NIT - 1); p0_item_load(tb, vb, F.lane);
            p0_item_store(ta, va, scr, F.lane);
            if (i1 >= NIT) break;
            const int i2 = i1 + NGW; ta = p0_item_decode(F, i2 < NIT ? i2 : NIT - 1); p0_item_load(ta, va, F.lane);
            p0_item_store(tb, vb, scr, F.lane);
            it = i2;
        }
    }
    __syncthreads();
    LAS float* red = (LAS float*)(F.lds + RING_OFF);
    LAS float* sil = red + 1024;
    for (int i = F.tid; i < 2048; i += NWAVES * 64) { const float c = inp(I_C)[i]; sil[i] = c / (1.0f + __expf(-c)); }
    __syncthreads();
    const int ks = F.tid >> 5, cl = F.tid & 31;
    for (int it = F.vcu; it < NL * 192; it += F.G) {
        const int l = it / 192, cg = it - l * 192; const float* W = inp(I_WADA) + (size_t)l * 1024 * 6144 + cg * 32 + cl + (size_t)(ks * 64) * 6144;
        float wv[64];
#pragma unroll
        for (int k = 0; k < 64; ++k) wv[k] = __builtin_nontemporal_load(W + (size_t)k * 6144);
        float a0 = 0.f, a1 = 0.f;
#pragma unroll
        for (int k = 0; k < 64; k += 4) { const f32x4 s0 = *(const LAS f32x4*)(sil + ks * 64 + k), s1 = *(const LAS f32x4*)(sil + 1024 + ks * 64 + k);
            a0 += s0.x * wv[k] + s0.y * wv[k + 1] + s0.z * wv[k + 2] + s0.w * wv[k + 3]; a1 += s1.x * wv[k] + s1.y * wv[k + 1] + s1.z * wv[k + 2] + s1.w * wv[k + 3]; }
        red[(ks * 2 + 0) * 32 + cl] = a0; red[(ks * 2 + 1) * 32 + cl] = a1;
        __syncthreads();
        if (F.tid < 64) { const int b = F.tid >> 5; float s = inp(I_BADA)[l * 6144 + cg * 32 + cl];
#pragma unroll
            for (int q = 0; q < 16; ++q) s += red[(q * 2 + b) * 32 + cl];
            ((float*)(F.ws + WS_MOD))[(size_t)(l * 2 + b) * 6144 + cg * 32 + cl] = s; }
        __syncthreads();
    }
}
__device__ __forceinline__ const float* modv(Frame& F, int l, int b, int which) { return (const float*)(F.ws + WS_MOD) + (size_t)(l * 2 + b) * 6144 + which * 1024; }

__device__ __forceinline__ void p_norm_in(Frame& F, int l, const float* x) {
    const int gw = F.vcu * NWAVES + F.wave;
    const int r0 = gw * 8, b = r0 >> 13;
    const float* nm = inp(I_NMIX) + l * 1024; const float* sc = modv(F, l, b, 1); const float* sh = modv(F, l, b, 0);
    f32x4 g1[4], g2[4];
#pragma unroll
    for (int j = 0; j < 4; ++j) { const int c = 4 * F.lane + 256 * j; const f32x4 n4 = *(const f32x4*)(nm + c), s4 = *(const f32x4*)(sc + c); g1[j] = n4 * (s4 + 1.0f); g2[j] = *(const f32x4*)(sh + c); }
    for (int rq = r0; rq < r0 + 8; rq += 4) {
        f32x4 v[4][4];
#pragma unroll
        for (int i = 0; i < 4; ++i) { const f32x4* xr = (const f32x4*)(x + (size_t)(rq + i) * D) + F.lane;
#pragma unroll
            for (int j = 0; j < 4; ++j) v[i][j] = __builtin_nontemporal_load(xr + 64 * j); }
#pragma unroll
        for (int i = 0; i < 4; ++i) { float s = 0.f;
#pragma unroll
            for (int j = 0; j < 4; ++j) s += (v[i][j].x * v[i][j].x + v[i][j].y * v[i][j].y) + (v[i][j].z * v[i][j].z + v[i][j].w * v[i][j].w);
            const float rstd = 1.0f / sqrtf(wave_sum(s) * (1.0f / D) + NORM_EPS);
            unsigned long long* o8 = (unsigned long long*)((bf16*)(F.ws + WS_H) + (size_t)(rq + i) * D) + F.lane;
#pragma unroll
            for (int j = 0; j < 4; ++j) { const f32x4 o = v[i][j] * rstd * g1[j] + g2[j]; o8[64 * j] = (unsigned long long)pk2(o.x, o.y) | ((unsigned long long)pk2(o.z, o.w) << 32); } }
    }
}
__device__ __forceinline__ void qknorm_seg(const bf16* p, bf16* dst, const float* gain, float scale, int lane, bool active) {
    v4u w = active ? *(const v4u*)p : (v4u){0u, 0u, 0u, 0u};
    float x[8] = {bflo(w.x), bfhi(w.x), bflo(w.y), bfhi(w.y), bflo(w.z), bfhi(w.z), bflo(w.w), bfhi(w.w)};
    float s = 0.f;
#pragma unroll
    for (int i = 0; i < 8; ++i) s += x[i] * x[i];
    s += __shfl_xor(s, 1); s += __shfl_xor(s, 2); s += __shfl_xor(s, 4);
    const float r = scale / sqrtf(s * (1.0f / 64.0f) + NORM_EPS);
    const int g0 = (lane & 7) * 8;
    const f32x4 ga = *(const f32x4*)(gain + g0), gb = *(const f32x4*)(gain + g0 + 4);
    v4u o; o.x = pk2(x[0] * r * ga.x, x[1] * r * ga.y); o.y = pk2(x[2] * r * ga.z, x[3] * r * ga.w); o.z = pk2(x[4] * r * gb.x, x[5] * r * gb.y); o.w = pk2(x[6] * r * gb.z, x[7] * r * gb.w);
    if (active) *(v4u*)dst = o;
}
__device__ __forceinline__ void p_qknorm(Frame& F, int l) {
    const int gw = F.vcu * NWAVES + F.wave, NGW = F.G * NWAVES;
    bf16* PROJ = (bf16*)(F.ws + WS_PROJ); bf16* QB = (bf16*)(F.ws + WS_XS);
    const float* gq = inp(I_DQN) + l * 64; const float* gk = inp(I_DKN) + l * 64; const float* sq = inp(I_SQN) + l * 64; const float* sk = inp(I_SKN) + l * 64;
    for (int r = gw; r < T; r += NGW) {
        bf16* row = PROJ + (size_t)r * INW + F.lane * 8;
        qknorm_seg(row + 1024, QB + (size_t)r * 512 + F.lane * 8, gq, QSCALE, F.lane, true);
        qknorm_seg(row + 1536, QB + (size_t)T * 512 + (size_t)r * 512 + F.lane * 8, gk, 1.0f, F.lane, true);
        qknorm_seg(row + 2560, row + 2560, sq, QSCALE, F.lane, true);
        qknorm_seg(row + 3072, row + 3072, sk, 1.0f, F.lane, F.lane < 16);
    }
}
constexpr int LRU_LC = 64, LRU_NCH = SEQ / LRU_LC;
struct LruW { float wa[64], wx[64]; float ba, bx, sp8, cw0, cw1, cw2, cw3, cb; };
template <int PASS> __device__ __forceinline__ void lru_unit(Frame& F, const LruW& W, int b, int chunk) {
    const int ch = F.tid; const bf16* PROJ = (const bf16*)(F.ws + WS_PROJ);
    LAS float* xcw = (LAS float*)(F.lds + RING_OFF) + F.wave * 1024;
    float* SA = (float*)(F.ws + WS_SUMM); float* SB = SA + 2 * LRU_NCH * 512;
    const int t0 = chunk * LRU_LC; const size_t rowb = (size_t)b * SEQ;
    float hst = 0.f, aprod = 1.f;
    if (PASS == 2) {
        const float* a = SA + (size_t)(b * LRU_NCH) * 512 + ch; const float* bb = SB + (size_t)(b * LRU_NCH) * 512 + ch;
        for (int c = 0; c < chunk; ++c) hst = a[(size_t)c * 512] * hst + bb[(size_t)c * 512];
    }
    float xm3 = 0.f, xm2 = 0.f, xm1 = 0.f;
    if (t0 > 0) { const bf16* p = PROJ + (rowb + t0 - 3) * INW + ch; xm3 = bf1(p[0]); xm2 = bf1(p[INW]); xm1 = bf1(p[2 * INW]); }
    for (int sub = 0; sub < LRU_LC / 16; ++sub) {
        const int ts = t0 + sub * 16;
        float xr[16], xc[16];
#pragma unroll
        for (int i = 0; i < 16; ++i) xr[i] = bf1(PROJ[(rowb + ts + i) * INW + ch]);
#pragma unroll
        for (int i = 0; i < 16; ++i) { xc[i] = W.cb + W.cw0 * xm3 + W.cw1 * xm2 + W.cw2 * xm1 + W.cw3 * xr[i]; xm3 = xm2; xm2 = xm1; xm1 = xr[i]; xcw[i * 64 + F.lane] = xc[i]; }
        float gr[16];
        if (PASS == 2) {
#pragma unroll
            for (int i = 0; i < 16; ++i) gr[i] = bf1(PROJ[(rowb + ts + i) * INW + 512 + ch]);
        }
        LDS_WAIT(); asm volatile("" ::: "memory");
#pragma unroll
        for (int i = 0; i < 16; ++i) {
            float ga = W.ba, gx = W.bx;
#pragma unroll
            for (int q = 0; q < 16; ++q) { const f32x4 v = *(const LAS f32x4*)(xcw + i * 64 + 4 * q);
                ga += v.x * W.wa[4 * q] + v.y * W.wa[4 * q + 1] + v.z * W.wa[4 * q + 2] + v.w * W.wa[4 * q + 3];
                gx += v.x * W.wx[4 * q] + v.y * W.wx[4 * q + 1] + v.z * W.wx[4 * q + 2] + v.w * W.wx[4 * q + 3]; }
            const float rg = 1.0f / (1.0f + __expf(-ga)), ig = 1.0f / (1.0f + __expf(-gx));
            const float la = -W.sp8 * rg; const float a = __expf(la); const float mult = sqrtf(-expm1f(2.0f * la));
            const float bv = xc[i] * ig * mult;
            hst = a * hst + bv;
            if (PASS == 1) aprod *= a;
            if (PASS == 2) { const float g = gr[i]; const float u = 0.7978845608028654f * (g + 0.044715f * g * g * g); const float th = 1.0f - 2.0f / (1.0f + __expf(2.0f * u));
                ((bf16*)(F.ws + WS_BR))[(rowb + ts + i) * 512 + ch] = (bf16)f2bf(hst * 0.5f * g * (1.0f + th)); }
        }
        LDS_WAIT(); asm volatile("" ::: "memory");
    }
    if (PASS == 1) { SA[(size_t)(b * LRU_NCH + chunk) * 512 + ch] = aprod; SB[(size_t)(b * LRU_NCH + chunk) * 512 + ch] = hst; }
}
__device__ __forceinline__ void lru_load_w(Frame& F, int l, LruW& W) {
    const int ch = F.tid, h = F.wave;
    const float* WA = inp(I_LWA) + (size_t)(l * 8 + h) * 4096 + F.lane; const float* WX = inp(I_LWX) + (size_t)(l * 8 + h) * 4096 + F.lane;
#pragma unroll
    for (int i = 0; i < 64; ++i) { W.wa[i] = WA[i * 64]; W.wx[i] = WX[i * 64]; }
    W.ba = inp(I_LBA)[l * 512 + ch]; W.bx = inp(I_LBX)[l * 512 + ch];
    const float lam = inp(I_LLAM)[l * 512 + ch]; W.sp8 = 8.0f * log1pf(__expf(-lam));
    const float* cw = inp(I_CONVW) + (size_t)l * 4 * 512 + ch; W.cw0 = cw[0]; W.cw1 = cw[512]; W.cw2 = cw[1024]; W.cw3 = cw[1536]; W.cb = inp(I_CONVB)[l * 512 + ch];
}
__device__ __forceinline__ int t5_bucket(int d) {
    if (d < 16) return d;
    const float lr = logf((float)d / 16.0f) / logf(8.0f);
    const int v = 16 + (int)(lr * 16.0f);
    return v < 31 ? v : 31;
}
__device__ __forceinline__ void build_tabs(Frame& F) {
    LAS float* tab = (LAS float*)(F.lds + TAB_OFF);
    const float* rb = inp(I_RELB);
    for (int i = F.tid; i < 12 * 128; i += NWAVES * 64) { const int hd = i >> 7, d = i & 127; const int bk = t5_bucket(d);
        float v = rb[bk * 12 + hd]; if (hd < 4) v -= rb[31 * 12 + hd];
        tab[i] = v * LOG2E;
        if (hd >= 4) tab[12 * 128 + (hd - 4) * 192 + 32 + d] = v * LOG2E; }
    for (int i = F.tid; i < 8 * 64; i += NWAVES * 64) { const int hd = i >> 6, g = i & 63; tab[12 * 128 + hd * 192 + (g < 32 ? g : 128 + g)] = -INFINITY; }
    __syncthreads();
}
constexpr int SWA_ROWB = 144;
__device__ __forceinline__ void swa_unit(Frame& F, int l, int b, int kvh, int qblk) {
    const bf16* PROJ = (const bf16*)(F.ws + WS_PROJ);
    LAS unsigned char* Kl = F.lds + RING_OFF; LAS unsigned char* Vl = Kl + 256 * SWA_ROWB;
    const LAS float* tab = (const LAS float*)(F.lds + TAB_OFF) + 4 * 128;
    const size_t rowb = (size_t)b * SEQ; const int tb = qblk * 128;
    for (int i = F.tid; i < 2 * 256 * 8; i += NWAVES * 64) {
        const int tsr = i >> 11, rem = i & 2047, r = rem >> 3, c = rem & 7; const int tpos = tb - 128 + r;
        v4u v = (v4u){0u, 0u, 0u, 0u};
        if (tpos >= 0) v = *(const v4u*)(PROJ + (rowb + tpos) * INW + (tsr ? 3200 : 3072) + kvh * 64 + c * 8);
        *(LAS v4u*)((tsr ? Vl : Kl) + r * SWA_ROWB + c * 16) = v;
    }
    __syncthreads();
    const int g = F.tid >> 7, r = F.tid & 127; const int head = kvh * 4 + g; const int tq = tb + r;
    float q[64];
    { const bf16* qp = PROJ + (rowb + tq) * INW + 2560 + head * 64;
#pragma unroll
      for (int c = 0; c < 8; ++c) { const v4u w = *(const v4u*)(qp + c * 8); q[8 * c] = bflo(w.x); q[8 * c + 1] = bfhi(w.x); q[8 * c + 2] = bflo(w.y); q[8 * c + 3] = bfhi(w.y); q[8 * c + 4] = bflo(w.z); q[8 * c + 5] = bfhi(w.z); q[8 * c + 6] = bflo(w.w); q[8 * c + 7] = bfhi(w.w); } }
    const float sink2 = inp(I_SINK)[l * 8 + head] * LOG2E;
    float mx = sink2, lsum = 1.0f; float o[64];
#pragma unroll
    for (int d = 0; d < 64; ++d) o[d] = 0.f;
    const LAS float* tb_h = tab + head * 128;
    for (int dist = 127; dist >= 0; --dist) {
        if (tq - dist < 0) continue;
        const int br = 128 + r - dist;
        const LAS unsigned char* kr = Kl + br * SWA_ROWB; float s = 0.f;
#pragma unroll
        for (int c = 0; c < 8; ++c) { const v4u w = *(const LAS v4u*)(kr + c * 16);
            s += q[8 * c] * bflo(w.x) + q[8 * c + 1] * bfhi(w.x) + q[8 * c + 2] * bflo(w.y) + q[8 * c + 3] * bfhi(w.y) + q[8 * c + 4] * bflo(w.z) + q[8 * c + 5] * bfhi(w.z) + q[8 * c + 6] * bflo(w.w) + q[8 * c + 7] * bfhi(w.w); }
        s += tb_h[dist];
        const float mn = fmaxf(mx, s); const float f = __builtin_amdgcn_exp2f(mx - mn), p = __builtin_amdgcn_exp2f(s - mn);
        lsum = lsum * f + p; mx = mn;
        const LAS unsigned char* vr = Vl + br * SWA_ROWB;
#pragma unroll
        for (int c = 0; c < 8; ++c) { const v4u w = *(const LAS v4u*)(vr + c * 16);
            o[8 * c] = o[8 * c] * f + p * bflo(w.x); o[8 * c + 1] = o[8 * c + 1] * f + p * bfhi(w.x); o[8 * c + 2] = o[8 * c + 2] * f + p * bflo(w.y); o[8 * c + 3] = o[8 * c + 3] * f + p * bfhi(w.y);
            o[8 * c + 4] = o[8 * c + 4] * f + p * bflo(w.z); o[8 * c + 5] = o[8 * c + 5] * f + p * bfhi(w.z); o[8 * c + 6] = o[8 * c + 6] * f + p * bflo(w.w); o[8 * c + 7] = o[8 * c + 7] * f + p * bfhi(w.w); }
    }
    const float inv = 1.0f / lsum;
    bf16* op = (bf16*)(F.ws + WS_BR) + (size_t)2 * T * 512 + (rowb + tq) * 512 + head * 64;
#pragma unroll
    for (int c = 0; c < 8; ++c) { v4u w; w.x = pk2(o[8 * c] * inv, o[8 * c + 1] * inv); w.y = pk2(o[8 * c + 2] * inv, o[8 * c + 3] * inv); w.z = pk2(o[8 * c + 4] * inv, o[8 * c + 5] * inv); w.w = pk2(o[8 * c + 6] * inv, o[8 * c + 7] * inv); *(v4u*)(op + c * 8) = w; }
    __syncthreads();
}
__device__ __forceinline__ void p_diffpost(Frame& F, int l) {
    const int gw = F.vcu * NWAVES + F.wave, NGW = F.G * NWAVES;
    const float* lv = inp(I_DLAM) + l * 256;
    const float s1 = wave_sum(lv[F.lane] * lv[64 + F.lane]), s2 = wave_sum(lv[128 + F.lane] * lv[192 + F.lane]);
    const float lam_init = 0.8f - 0.6f * expf(-0.3f * (float)l);
    const float lam = expf(s1) - expf(s2) + lam_init;
    const int h = F.lane >> 4, e0 = (F.lane & 15) * 8;
    const float* sg = inp(I_DSUB) + l * 128 + e0; const f32x4 ga = *(const f32x4*)sg, gb = *(const f32x4*)(sg + 4);
    const float post = 1.0f - lam_init;
    const bf16* ODT = (const bf16*)(F.ws + WS_ODT); bf16* BR1 = (bf16*)(F.ws + WS_BR) + (size_t)T * 512;
    for (int rb = gw; rb < T; rb += 8 * NGW) {
        v4u w0[8], w1[8];
#pragma unroll
        for (int i = 0; i < 8; ++i) { const int r = rb + i * NGW, rc = r < T ? r : rb; w0[i] = __builtin_nontemporal_load((const v4u*)(ODT + (size_t)rc * 1024 + h * 256 + e0)); w1[i] = __builtin_nontemporal_load((const v4u*)(ODT + (size_t)rc * 1024 + h * 256 + 128 + e0)); }
#pragma unroll
        for (int i = 0; i < 8; ++i) { const int r = rb + i * NGW;
            float x[8] = {bflo(w0[i].x) - lam * bflo(w1[i].x), bfhi(w0[i].x) - lam * bfhi(w1[i].x), bflo(w0[i].y) - lam * bflo(w1[i].y), bfhi(w0[i].y) - lam * bfhi(w1[i].y),
                          bflo(w0[i].z) - lam * bflo(w1[i].z), bfhi(w0[i].z) - lam * bfhi(w1[i].z), bflo(w0[i].w) - lam * bflo(w1[i].w), bfhi(w0[i].w) - lam * bfhi(w1[i].w)};
            float s = 0.f;
#pragma unroll
            for (int k = 0; k < 8; ++k) s += x[k] * x[k];
            s += __shfl_xor(s, 1); s += __shfl_xor(s, 2); s += __shfl_xor(s, 4); s += __shfl_xor(s, 8);
            const float rs = post / sqrtf(s * (1.0f / 128.0f) + NORM_EPS);
            v4u o; o.x = pk2(x[0] * rs * ga.x, x[1] * rs * ga.y); o.y = pk2(x[2] * rs * ga.z, x[3] * rs * ga.w); o.z = pk2(x[4] * rs * gb.x, x[5] * rs * gb.y); o.w = pk2(x[6] * rs * gb.z, x[7] * rs * gb.w);
            if (r < T) *(v4u*)(BR1 + (size_t)r * 512 + h * 128 + e0) = o; }
    }
}
typedef short mbf16x8 __attribute__((ext_vector_type(8)));
typedef float mf32x16 __attribute__((ext_vector_type(16)));
__device__ __forceinline__ int crow16(int r, int hi) { return (r & 3) + 8 * (r >> 2) + 4 * hi; }
__device__ __forceinline__ unsigned cvtpk(float lo, float hi) { typedef float f2_t __attribute__((ext_vector_type(2))); typedef __bf16 b2_t __attribute__((ext_vector_type(2))); f2_t v = {lo, hi}; b2_t b = __builtin_convertvector(v, b2_t); return __builtin_bit_cast(unsigned, b); }
#define MFMA32(a, b, c) __builtin_amdgcn_mfma_f32_32x32x16_bf16(a, b, c, 0, 0, 0)
constexpr int SWK_ROWB = 144, SWV_ROWB = 528;
__device__ __forceinline__ void swa_unit_mfma(Frame& F, int l, int b, int kvh, int qblk) {
    const bf16* PROJ = (const bf16*)(F.ws + WS_PROJ);
    LAS unsigned char* Kl = F.lds + RING_OFF; LAS unsigned char* Vt = Kl + 256 * SWK_ROWB;
    const size_t rowb = (size_t)b * SEQ; const int tb = qblk * 128;
    mbf16x8 qall[2][4];
    { const int g_ = F.wave >> 1, qh_ = F.wave & 1, head_ = kvh * 4 + g_, r32_ = F.lane & 31, hi_ = F.lane >> 5;
#pragma unroll
      for (int sb = 0; sb < 2; ++sb) { const bf16* qp = PROJ + (rowb + tb + 64 * qh_ + 32 * sb + r32_) * INW + 2560 + head_ * 64 + 8 * hi_;
#pragma unroll
          for (int ks = 0; ks < 4; ++ks) qall[sb][ks] = *(const mbf16x8*)(qp + 16 * ks); } }
#pragma unroll
    for (int it = 0; it < 4; ++it) { const int i = F.tid + 512 * it, r = i & 255, c = i >> 8; const int tpos = tb - 128 + r;
        v4u kv = (v4u){0u, 0u, 0u, 0u}, vv = kv;
        if (tpos >= 0) { const bf16* p = PROJ + (rowb + tpos) * INW + kvh * 64 + c * 8; kv = *(const v4u*)(p + 3072); vv = *(const v4u*)(p + 3200); }
        *(LAS v4u*)(Kl + r * SWK_ROWB + c * 16) = kv;
        LAS unsigned short* vt = (LAS unsigned short*)(Vt + (8 * c) * SWV_ROWB + 2 * r);
        vt[0 * (SWV_ROWB / 2)] = (unsigned short)(vv.x & 0xffffu); vt[1 * (SWV_ROWB / 2)] = (unsigned short)(vv.x >> 16);
        vt[2 * (SWV_ROWB / 2)] = (unsigned short)(vv.y & 0xffffu); vt[3 * (SWV_ROWB / 2)] = (unsigned short)(vv.y >> 16);
        vt[4 * (SWV_ROWB / 2)] = (unsigned short)(vv.z & 0xffffu); vt[5 * (SWV_ROWB / 2)] = (unsigned short)(vv.z >> 16);
        vt[6 * (SWV_ROWB / 2)] = (unsigned short)(vv.w & 0xffffu); vt[7 * (SWV_ROWB / 2)] = (unsigned short)(vv.w >> 16); }
    __syncthreads();
    const int g = F.wave >> 1, qh = F.wave & 1, head = kvh * 4 + g, r32 = F.lane & 31, hi = F.lane >> 5;
    const LAS float* tabh = (const LAS float*)(F.lds + TAB_OFF) + (4 + head) * 128;
    const float sink2 = inp(I_SINK)[l * 8 + head] * LOG2E;
    bf16* OUT = (bf16*)(F.ws + WS_BR) + (size_t)2 * T * 512;
#pragma unroll 1
    for (int sb = 0; sb < 2; ++sb) {
        const int r0 = 64 * qh + 32 * sb, kb0 = r0 >> 5;
        mbf16x8 qr[4];
#pragma unroll
        for (int ks = 0; ks < 4; ++ks) qr[ks] = sb == 0 ? qall[0][ks] : qall[1][ks];
        mf32x16 p[5];
#pragma unroll
        for (int kk = 0; kk < 5; ++kk) { p[kk] = (mf32x16){};
            const LAS unsigned char* kp = Kl + (32 * (kb0 + kk) + r32) * SWK_ROWB + 16 * hi;
#pragma unroll
            for (int ks = 0; ks < 4; ++ks) { const mbf16x8 kf = *(const LAS mbf16x8*)(kp + 32 * ks); p[kk] = MFMA32(kf, qr[ks], p[kk]); } }
        const int qpos = 128 + r0 + r32; float mx = -INFINITY;
        {
            const LAS float* tl = (const LAS float*)(F.lds + TAB_OFF) + 12 * 128 + head * 192 + (32 + 128 + r32 - 4 * hi - 159);
            const int lim = (qblk > 0 ? 0 : 128) - 32 * kb0 - 4 * hi;
#pragma unroll
            for (int kk = 0; kk < 5; ++kk) {
#pragma unroll
                for (int r = 0; r < 16; ++r) { const int c = 32 * kk + (r & 3) + 8 * (r >> 2); float s = p[kk][r] + tl[159 - c]; s = c < lim ? -INFINITY : s; p[kk][r] = s; mx = fmaxf(mx, s); }
                asm volatile("" ::: "memory"); }
        }
        mx = fmaxf(mx, __shfl_xor(mx, 32)); mx = fmaxf(mx, sink2);
        float lsum = 0.f;
#pragma unroll
        for (int kk = 0; kk < 5; ++kk)
#pragma unroll
            for (int r = 0; r < 16; ++r) { const float e = __builtin_amdgcn_exp2f(p[kk][r] - mx); p[kk][r] = e; lsum += e; }
        lsum += __shfl_xor(lsum, 32); lsum += __builtin_amdgcn_exp2f(sink2 - mx);
        mf32x16 o[2]; o[0] = (mf32x16){}; o[1] = (mf32x16){};
#pragma unroll
        for (int kk = 0; kk < 5; ++kk)
#pragma unroll
            for (int s = 0; s < 2; ++s) {
                v4u pw; pw.x = cvtpk(p[kk][8 * s], p[kk][8 * s + 1]); pw.y = cvtpk(p[kk][8 * s + 2], p[kk][8 * s + 3]); pw.z = cvtpk(p[kk][8 * s + 4], p[kk][8 * s + 5]); pw.w = cvtpk(p[kk][8 * s + 6], p[kk][8 * s + 7]);
                const mbf16x8 pa = __builtin_bit_cast(mbf16x8, pw);
#pragma unroll
                for (int db = 0; db < 2; ++db) { const LAS unsigned char* vp = Vt + (32 * db + r32) * SWV_ROWB + (32 * (kb0 + kk) + 16 * s + 4 * hi) * 2;
                    const v2u lo = *(const LAS v2u*)vp, hi2 = *(const LAS v2u*)(vp + 16);
                    const v4u vw = (v4u){lo.x, lo.y, hi2.x, hi2.y};
                    o[db] = MFMA32(pa, __builtin_bit_cast(mbf16x8, vw), o[db]); } }
        const float linv = 1.0f / lsum;
#pragma unroll
        for (int r = 0; r < 16; ++r) { const int q = crow16(r, hi); const float li = __shfl(linv, q);
            bf16* op = OUT + (rowb + tb + r0 + q) * 512 + head * 64 + r32;
            op[0] = (bf16)f2bf(o[0][r] * li); op[32] = (bf16)f2bf(o[1][r] * li); }
    }
    __syncthreads();
}
constexpr int LRX_ROWB = 144;
struct LruM { mbf16x8 wb[2][2][4]; float ba[2], bx[2], sp8[2]; float cw0, cw1, cw2, cw3, cb; };
__device__ __forceinline__ void lru_load_m(Frame& F, int l, LruM& W) {
    const int h = F.wave, r32 = F.lane & 31, hi = F.lane >> 5;
#pragma unroll
    for (int g = 0; g < 2; ++g) { const float* Wg = inp(g == 0 ? I_LWA : I_LWX) + (size_t)(l * 8 + h) * 4096;
        { float wf[2][4][8];
#pragma unroll
          for (int n = 0; n < 2; ++n)
#pragma unroll
            for (int ks = 0; ks < 4; ++ks) { const float* p = Wg + (size_t)(16 * ks + 8 * hi) * 64 + 32 * n + r32;
#pragma unroll
                for (int i = 0; i < 8; ++i) wf[n][ks][i] = p[64 * i]; }
#pragma unroll
          for (int n = 0; n < 2; ++n)
#pragma unroll
            for (int ks = 0; ks < 4; ++ks) { v4u w; w.x = cvtpk(wf[n][ks][0], wf[n][ks][1]); w.y = cvtpk(wf[n][ks][2], wf[n][ks][3]); w.z = cvtpk(wf[n][ks][4], wf[n][ks][5]); w.w = cvtpk(wf[n][ks][6], wf[n][ks][7]);
                asm volatile("" : "+v"(w));
                W.wb[g][n][ks] = __builtin_bit_cast(mbf16x8, w); }
          asm volatile("" ::: "memory"); } }
#pragma unroll
    for (int n = 0; n < 2; ++n) { const int ch = l * 512 + 64 * h + 32 * n + r32; W.ba[n] = inp(I_LBA)[ch]; W.bx[n] = inp(I_LBX)[ch]; W.sp8[n] = 8.0f * LOG2E * log1pf(__expf(-inp(I_LLAM)[ch])); }
    const int chc = 64 * h + F.lane; const float* cw = inp(I_CONVW) + (size_t)l * 4 * 512 + chc; W.cw0 = cw[0]; W.cw1 = cw[512]; W.cw2 = cw[1024]; W.cw3 = cw[1536]; W.cb = inp(I_CONVB)[l * 512 + chc];
}
template <int PASS> __device__ __forceinline__ void lru_unit_m(Frame& F, LruM& W, const int l, const bool loadw, int b, int chunk) {
    const bf16* PROJ = (const bf16*)(F.ws + WS_PROJ);
    LAS unsigned char* xcb = F.lds + RING_OFF + F.wave * (64 * LRX_ROWB);
    float* SA = (float*)(F.ws + WS_SUMM); float* SB = SA + 2 * LRU_NCH * 512;
    const int h = F.wave, r32 = F.lane & 31, hi = F.lane >> 5;
    const int t0 = chunk * LRU_LC; const size_t rowb = (size_t)b * SEQ;
    unsigned* const LBW = (unsigned*)(F.ws + WS_ACT) + ((size_t)((b * LRU_NCH + chunk) * 8 + h) * 64) * 64 + F.lane;
    const int chv = 64 * h + F.lane; unsigned short xraw[64], xh3 = 0, xh2 = 0, xh1 = 0;
    if (t0 > 0) { const bf16* p = PROJ + (rowb + t0 - 3) * INW + chv; xh3 = p[0]; xh2 = p[INW]; xh1 = p[2 * INW]; }
#pragma unroll
    for (int i = 0; i < 64; ++i) xraw[i] = PROJ[(rowb + t0 + i) * INW + chv];
    asm volatile("" ::: "memory");
    if (loadw) lru_load_m(F, l, W);
    float hc[2] = {0.f, 0.f}, ap[2] = {1.f, 1.f};
    if (PASS == 2 && chunk > 0) {
        const int c1 = chunk >> 1, lo = hi ? c1 : 0, cnt = hi ? chunk - c1 : c1, cmax = chunk - c1;
        const float* a = SA + (size_t)(b * LRU_NCH) * 512 + 64 * h + r32; const float* bb = SB + (size_t)(b * LRU_NCH) * 512 + 64 * h + r32;
        float Ac[2] = {1.f, 1.f}, Bc[2] = {0.f, 0.f};
#pragma unroll 1
        for (int c = 0; c < cmax; c += 16) { float ta[2][16], tb[2][16];
#pragma unroll
            for (int n = 0; n < 2; ++n)
#pragma unroll
                for (int i = 0; i < 16; ++i) { const int ci = c + i; const bool ok = ci < cnt; const int idx = lo + (ok ? ci : 0); const float va = a[(size_t)idx * 512 + 32 * n], vb = bb[(size_t)idx * 512 + 32 * n]; ta[n][i] = ok ? va : 1.f; tb[n][i] = ok ? vb : 0.f; }
#pragma unroll
            for (int n = 0; n < 2; ++n)
#pragma unroll
                for (int i = 0; i < 16; ++i) { Bc[n] = ta[n][i] * Bc[n] + tb[n][i]; Ac[n] *= ta[n][i]; } }
#pragma unroll
        for (int n = 0; n < 2; ++n) { const float Ap = __shfl_xor(Ac[n], 32), Bp = __shfl_xor(Bc[n], 32);
            hc[n] = hi ? (Ac[n] * Bp + Bc[n]) : (Ap * Bc[n] + Bp); }
    }
    { float xm3 = bf1(xh3), xm2 = bf1(xh2), xm1 = bf1(xh1);
#pragma unroll
      for (int i = 0; i < 64; ++i) { const float xv = bf1(xraw[i]); const float xc = W.cb + W.cw0 * xm3 + W.cw1 * xm2 + W.cw2 * xm1 + W.cw3 * xv; xm3 = xm2; xm2 = xm1; xm1 = xv;
          *(LAS unsigned short*)(xcb + i * LRX_ROWB + 2 * F.lane) = (unsigned short)f2bf(xc); } }
    LDS_WAIT(); asm volatile("" ::: "memory");
#pragma unroll 1
    for (int mt = 0; mt < 2; ++mt) {
        mbf16x8 af[4];
#pragma unroll
        for (int ks = 0; ks < 4; ++ks) af[ks] = *(const LAS mbf16x8*)(xcb + (32 * mt + r32) * LRX_ROWB + 32 * ks + 16 * hi);
#pragma unroll
        for (int n = 0; n < 2; ++n) {
            unsigned short gqr[16];
            if (PASS == 2) {
#pragma unroll
                for (int r = 0; r < 16; ++r) gqr[r] = PROJ[(rowb + t0 + 32 * mt + crow16(r, hi)) * INW + 512 + 64 * h + 32 * n + r32];
                asm volatile("" ::: "memory"); }
            mf32x16 ga = (mf32x16){}, gx = (mf32x16){};
#pragma unroll
            for (int ks = 0; ks < 4; ++ks) { ga = MFMA32(af[ks], W.wb[0][n][ks], ga); gx = MFMA32(af[ks], W.wb[1][n][ks], gx); }
            float av[16], bv[16];
#pragma unroll
            for (int r = 0; r < 16; ++r) { const int tok = 32 * mt + crow16(r, hi);
                const float xc = bf1(*(const LAS unsigned short*)(xcb + tok * LRX_ROWB + 2 * (32 * n + r32)));
                const float rg = __builtin_amdgcn_rcpf(1.0f + __builtin_amdgcn_exp2f(-LOG2E * (ga[r] + W.ba[n])));
                const float ui = 1.0f + __builtin_amdgcn_exp2f(-LOG2E * (gx[r] + W.bx[n]));
                const float la = -W.sp8[n] * rg; const float a = __builtin_amdgcn_exp2f(la);
                const float tq = fmaxf(1.0f - a * a, 0.f);
                av[r] = a; bv[r] = xc * tq * __builtin_amdgcn_rsqf(fmaxf(tq, 1e-30f) * ui * ui);
                if (PASS == 1) LBW[(size_t)(((mt * 2 + n) * 16 + r) * 64)] = pk2(la, bv[r]); }
            float hh = hc[n], hs[16];
#pragma unroll
            for (int m = 0; m < 4; ++m) {
                const float t0_ = av[4 * m] * hh + bv[4 * m], t1_ = av[4 * m + 1] * t0_ + bv[4 * m + 1], t2_ = av[4 * m + 2] * t1_ + bv[4 * m + 2], t3_ = av[4 * m + 3] * t2_ + bv[4 * m + 3];
                const float hA = __shfl_xor(t3_, 32);
                const float u0_ = av[4 * m] * hA + bv[4 * m], u1_ = av[4 * m + 1] * u0_ + bv[4 * m + 1], u2_ = av[4 * m + 2] * u1_ + bv[4 * m + 2], u3_ = av[4 * m + 3] * u2_ + bv[4 * m + 3];
                const float hB = __shfl_xor(u3_, 32);
                hs[4 * m] = hi ? u0_ : t0_; hs[4 * m + 1] = hi ? u1_ : t1_; hs[4 * m + 2] = hi ? u2_ : t2_; hs[4 * m + 3] = hi ? u3_ : t3_;
                hh = hi ? u3_ : hB; }
            hc[n] = hh;
            if (PASS == 1) {
#pragma unroll
                for (int r = 0; r < 16; ++r) ap[n] *= av[r]; }
            if (PASS == 2) {
#pragma unroll
                for (int r = 0; r < 16; ++r) { const size_t row = rowb + t0 + 32 * mt + crow16(r, hi); const int ch = 64 * h + 32 * n + r32;
                    const float gq = bf1(gqr[r]); const float u2 = 2.0f * 0.7978845608028654f * (gq + 0.044715f * gq * gq * gq);
                    const float ge = gq * __builtin_amdgcn_rcpf(1.0f + __builtin_amdgcn_exp2f(-LOG2E * u2));
                    ((bf16*)(F.ws + WS_BR))[row * 512 + ch] = (bf16)f2bf(hs[r] * ge);
                    } }
        }
    }
    if (PASS == 1) {
#pragma unroll
        for (int n = 0; n < 2; ++n) { const float at = ap[n] * __shfl_xor(ap[n], 32);
            if (hi == 0) { const size_t o = (size_t)(b * LRU_NCH + chunk) * 512 + 64 * h + 32 * n + r32; SA[o] = at; SB[o] = hc[n]; } }
    }
    LDS_WAIT(); asm volatile("" ::: "memory");
}

__device__ __forceinline__ void lru_p2_block(Frame& F, const int mt, const unsigned (&lb)[2][16], const unsigned short (&gqv)[2][16], float (&hc)[2], const size_t rowb, const int t0, const int h, const int r32, const int hi) {
#pragma unroll
    for (int n = 0; n < 2; ++n) {
        float av[16], bv[16];
#pragma unroll
        for (int r = 0; r < 16; ++r) { av[r] = __builtin_amdgcn_exp2f(bflo(lb[n][r])); bv[r] = bfhi(lb[n][r]); }
        float hh = hc[n], hs[16];
#pragma unroll
        for (int m = 0; m < 4; ++m) {
            const float t0_ = av[4 * m] * hh + bv[4 * m], t1_ = av[4 * m + 1] * t0_ + bv[4 * m + 1], t2_ = av[4 * m + 2] * t1_ + bv[4 * m + 2], t3_ = av[4 * m + 3] * t2_ + bv[4 * m + 3];
            const float hA = __shfl_xor(t3_, 32);
            const float u0_ = av[4 * m] * hA + bv[4 * m], u1_ = av[4 * m + 1] * u0_ + bv[4 * m + 1], u2_ = av[4 * m + 2] * u1_ + bv[4 * m + 2], u3_ = av[4 * m + 3] * u2_ + bv[4 * m + 3];
            const float hB = __shfl_xor(u3_, 32);
            hs[4 * m] = hi ? u0_ : t0_; hs[4 * m + 1] = hi ? u1_ : t1_; hs[4 * m + 2] = hi ? u2_ : t2_; hs[4 * m + 3] = hi ? u3_ : t3_;
            hh = hi ? u3_ : hB; }
        hc[n] = hh;
#pragma unroll
        for (int r = 0; r < 16; ++r) { const size_t row = rowb + t0 + 32 * mt + crow16(r, hi); const int ch = 64 * h + 32 * n + r32;
            const float gq = bf1(gqv[n][r]); const float u2 = 2.0f * 0.7978845608028654f * (gq + 0.044715f * gq * gq * gq);
            const float ge = gq * __builtin_amdgcn_rcpf(1.0f + __builtin_amdgcn_exp2f(-LOG2E * u2));
            ((bf16*)(F.ws + WS_BR))[row * 512 + ch] = (bf16)f2bf(hs[r] * ge); }
    }
}
__device__ __forceinline__ void lru_unit_p2(Frame& F, int b, int chunk) {
    const bf16* PROJ = (const bf16*)(F.ws + WS_PROJ);
    float* SA = (float*)(F.ws + WS_SUMM); float* SB = SA + 2 * LRU_NCH * 512;
    const int h = F.wave, r32 = F.lane & 31, hi = F.lane >> 5;
    const int t0 = chunk * LRU_LC; const size_t rowb = (size_t)b * SEQ;
    const unsigned* const LB = (const unsigned*)(F.ws + WS_ACT) + ((size_t)((b * LRU_NCH + chunk) * 8 + h) * 64) * 64 + F.lane;
    unsigned lb0[2][16], lb1[2][16]; unsigned short gq0[2][16], gq1[2][16];
#pragma unroll
    for (int n = 0; n < 2; ++n)
#pragma unroll
        for (int r = 0; r < 16; ++r) { lb0[n][r] = LB[(size_t)((n * 16 + r) * 64)]; gq0[n][r] = PROJ[(rowb + t0 + crow16(r, hi)) * INW + 512 + 64 * h + 32 * n + r32]; }
    asm volatile("" ::: "memory");
    float hc[2] = {0.f, 0.f};
    if (chunk > 0) {
        const int c1 = chunk >> 1, lo = hi ? c1 : 0, cnt = hi ? chunk - c1 : c1, cmax = chunk - c1;
        const float* a = SA + (size_t)(b * LRU_NCH) * 512 + 64 * h + r32; const float* bb = SB + (size_t)(b * LRU_NCH) * 512 + 64 * h + r32;
        float Ac[2] = {1.f, 1.f}, Bc[2] = {0.f, 0.f};
#pragma unroll 1
        for (int c = 0; c < cmax; c += 16) { float ta[2][16], tb[2][16];
#pragma unroll
            for (int n = 0; n < 2; ++n)
#pragma unroll
                for (int i = 0; i < 16; ++i) { const int ci = c + i; const bool ok = ci < cnt; const int idx = lo + (ok ? ci : 0); const float va = a[(size_t)idx * 512 + 32 * n], vb = bb[(size_t)idx * 512 + 32 * n]; ta[n][i] = ok ? va : 1.f; tb[n][i] = ok ? vb : 0.f; }
#pragma unroll
            for (int n = 0; n < 2; ++n)
#pragma unroll
                for (int i = 0; i < 16; ++i) { Bc[n] = ta[n][i] * Bc[n] + tb[n][i]; Ac[n] *= ta[n][i]; } }
#pragma unroll
        for (int n = 0; n < 2; ++n) { const float Ap = __shfl_xor(Ac[n], 32), Bp = __shfl_xor(Bc[n], 32);
            hc[n] = hi ? (Ac[n] * Bp + Bc[n]) : (Ap * Bc[n] + Bp); }
    }
#pragma unroll
    for (int n = 0; n < 2; ++n)
#pragma unroll
        for (int r = 0; r < 16; ++r) { lb1[n][r] = LB[(size_t)(((2 + n) * 16 + r) * 64)]; gq1[n][r] = PROJ[(rowb + t0 + 32 + crow16(r, hi)) * INW + 512 + 64 * h + 32 * n + r32]; }
    asm volatile("" ::: "memory");
    lru_p2_block(F, 0, lb0, gq0, hc, rowb, t0, h, r32, hi);
    lru_p2_block(F, 1, lb1, gq1, hc, rowb, t0, h, r32, hi);
}
__device__ __forceinline__ void p_router(Frame& F, int l) {
    LAS float* PART = (LAS float*)(F.lds + RING_OFF);
    LAS float* RSTD = (LAS float*)(F.lds + RING_OFF + 65536);
    LAS float* CVEC = RSTD + 64;
    LAS int* CNT = (LAS int*)(CVEC + 256);
    const bf16* x = (const bf16*)(F.ws + WS_XS) + (size_t)64 * 1024 * 512;
    const int e = F.lane & 31, half = F.lane >> 5;
    const int rows0 = F.vcu * 64; const int b = rows0 >> 13;
    const float* nf = inp(I_NFFN) + l * 1024; const float* sc = modv(F, l, b, 4); const float* sh = modv(F, l, b, 3);
    if (F.tid < 32) CNT[F.tid] = 0;
    v2u xw[8][4];
#pragma unroll
    for (int q = 0; q < 8; ++q) { const v2u* xr = (const v2u*)(x + (size_t)(rows0 + 8 * F.wave + q) * D) + F.lane;
#pragma unroll
        for (int j = 0; j < 4; ++j) xw[q][j] = xr[64 * j]; }
    asm volatile("" ::: "memory");
    { f32x4 g1[4], g2[4];
#pragma unroll
      for (int j = 0; j < 4; ++j) { const int c = 4 * F.lane + 256 * j; const f32x4 n4 = *(const f32x4*)(nf + c), s4 = *(const f32x4*)(sc + c); g1[j] = n4 * (s4 + 1.0f); g2[j] = *(const f32x4*)(sh + c); }
#pragma unroll
      for (int q = 0; q < 8; ++q) { const int lr = 8 * F.wave + q, r = rows0 + lr; f32x4 v[4]; float s = 0.f;
#pragma unroll
          for (int j = 0; j < 4; ++j) { const v2u w = xw[q][j]; v[j] = (f32x4){bflo(w.x), bfhi(w.x), bflo(w.y), bfhi(w.y)}; s += (v[j].x * v[j].x + v[j].y * v[j].y) + (v[j].z * v[j].z + v[j].w * v[j].w); }
          const float rstd = 1.0f / sqrtf(wave_sum(s) * (1.0f / D) + NORM_EPS);
          if (F.lane == 0) RSTD[lr] = rstd;
          unsigned long long* o8 = (unsigned long long*)((bf16*)(F.ws + WS_H) + (size_t)r * D) + F.lane;
#pragma unroll
          for (int j = 0; j < 4; ++j) { const f32x4 o = v[j] * rstd * g1[j] + g2[j]; o8[64 * j] = (unsigned long long)pk2(o.x, o.y) | ((unsigned long long)pk2(o.z, o.w) << 32); } } }
    asm volatile("" ::: "memory");
    mbf16x8 Bh[8], Bl[8]; float cpart = 0.f;
    { const float* wr = inp(I_WR) + (size_t)l * 1024 * 32 + e; const int k0 = 128 * F.wave + 8 * half;
#pragma unroll
      for (int s = 0; s < 8; ++s) { const int kk = k0 + 16 * s;
          const f32x4 n0 = *(const f32x4*)(nf + kk), n1 = *(const f32x4*)(nf + kk + 4), s0 = *(const f32x4*)(sc + kk), s1 = *(const f32x4*)(sc + kk + 4), h0 = *(const f32x4*)(sh + kk), h1 = *(const f32x4*)(sh + kk + 4);
          const f32x4 ga = n0 * (s0 + 1.0f), gb = n1 * (s1 + 1.0f);
          float wp[8];
#pragma unroll
          for (int i = 0; i < 8; ++i) { const float wv = wr[(size_t)(kk + i) * 32]; wp[i] = wv * (i < 4 ? ga[i & 3] : gb[i & 3]); cpart += wv * (i < 4 ? h0[i & 3] : h1[i & 3]); }
          v4u ph, pl;
#pragma unroll
          for (int i = 0; i < 4; ++i) { const unsigned p = pk2(wp[2 * i], wp[2 * i + 1]); ph[i] = p; pl[i] = pk2(wp[2 * i] - bflo(p), wp[2 * i + 1] - bfhi(p)); }
          Bh[s] = __builtin_bit_cast(mbf16x8, ph); Bl[s] = __builtin_bit_cast(mbf16x8, pl);
          if ((s & 3) == 3) asm volatile("" ::: "memory"); } }
    cpart += __shfl_xor(cpart, 32);
    if (half == 0) CVEC[F.wave * 32 + e] = cpart;
    asm volatile("" ::: "memory");
    { const bf16* xa = x + (size_t)(rows0 + e) * D + 128 * F.wave + 8 * half;
      mbf16x8 A0[8], A1[8];
#pragma unroll
      for (int s = 0; s < 8; ++s) { A0[s] = *(const mbf16x8*)(xa + 16 * s); A1[s] = *(const mbf16x8*)(xa + (size_t)32 * D + 16 * s); }
      mf32x16 acc0 = {}, acc1 = {};
#pragma unroll
      for (int s = 0; s < 8; ++s) {
          acc0 = __builtin_amdgcn_mfma_f32_32x32x16_bf16(A0[s], Bh[s], acc0, 0, 0, 0); acc1 = __builtin_amdgcn_mfma_f32_32x32x16_bf16(A1[s], Bh[s], acc1, 0, 0, 0);
          acc0 = __builtin_amdgcn_mfma_f32_32x32x16_bf16(A0[s], Bl[s], acc0, 0, 0, 0); acc1 = __builtin_amdgcn_mfma_f32_32x32x16_bf16(A1[s], Bl[s], acc1, 0, 0, 0); }
#pragma unroll
      for (int r = 0; r < 16; ++r) { const int row = (r & 3) + 8 * (r >> 2) + 4 * half; PART[(F.wave * 64 + row) * 32 + e] = acc0[r]; PART[(F.wave * 64 + 32 + row) * 32 + e] = acc1[r]; } }
    __syncthreads();
    { float cv = inp(I_BR)[l * 32 + e];
#pragma unroll
      for (int w = 0; w < 8; ++w) cv += CVEC[w * 32 + e];
#pragma unroll
      for (int it = 0; it < 4; ++it) { const int lr = 8 * F.wave + 2 * it + half, r = rows0 + lr; float a = 0.f;
#pragma unroll
          for (int w = 0; w < 8; ++w) a += PART[(w * 64 + lr) * 32 + e];
          const float lg = a * RSTD[lr] + cv;
          int rk = 0;
#pragma unroll
          for (int o = 1; o < 32; ++o) { const float ov = __shfl_xor(lg, o); rk += (ov > lg || (ov == lg && (e ^ o) < e)) ? 1 : 0; }
          float tv[4]; int te[4];
#pragma unroll
          for (int k = 0; k < 4; ++k) { const unsigned long long m = __ballot(rk == k); const unsigned mh = (unsigned)(m >> (32 * half)); const int src = (mh ? __builtin_ctz(mh) : 0) + 32 * half; tv[k] = __shfl(lg, src); te[k] = src & 31; }
          const float p1 = __expf(tv[1] - tv[0]), p2 = __expf(tv[2] - tv[0]), p3 = __expf(tv[3] - tv[0]); const float inv = 1.0f / (1.0f + p1 + p2 + p3);
          if (e < 4) { const float pw = e == 0 ? 1.0f : (e == 1 ? p1 : (e == 2 ? p2 : p3)); const int ee = e == 0 ? te[0] : (e == 1 ? te[1] : (e == 2 ? te[2] : te[3]));
              const int rank = atomicAdd((int*)(CNT + ee), 1);
              ((float*)(F.ws + WS_TOPW))[(size_t)r * 4 + e] = pw * inv;
              ((unsigned*)(F.ws + WS_ERANK))[(size_t)r * 4 + e] = ((unsigned)ee << 20) | (unsigned)rank; } } }
    __syncthreads();
    if (F.tid < 32) ((int*)(F.ws + WS_BLKCNT))[F.vcu * 32 + F.tid] = CNT[F.tid];
}
__device__ __forceinline__ void p_scatter(Frame& F) {
    LAS int* S16 = (LAS int*)(F.lds + RING_OFF);
    LAS int* SLOTB = S16 + 512;
    LAS int* TOT = SLOTB + 32;
    const int* BC = (const int*)(F.ws + WS_BLKCNT);
    const int e = F.tid & 31, part = F.tid >> 5;
    const unsigned er_pre = F.tid < 256 ? ((const unsigned*)(F.ws + WS_ERANK))[(size_t)(F.vcu * 64 + (F.tid >> 2)) * 4 + (F.tid & 3)] : 0u;
    LAS int* PRE = TOT + 32;
    { int s = 0, pre = 0;
#pragma unroll
      for (int q = 0; q < 16; ++q) { const int bb = part * 16 + q; const int v = bb < F.G ? BC[bb * 32 + e] : 0; s += v; if (bb < F.vcu) pre += v; }
      S16[part * 32 + e] = s; if (part == (F.vcu >> 4)) PRE[e] = pre; }
    __syncthreads();
    if (F.tid < 32) { int tot = 0, base = 0; const int mp = F.vcu >> 4;
        for (int q = 0; q < 16; ++q) { tot += S16[q * 32 + e]; if (q < mp) base += S16[q * 32 + e]; }
        TOT[e] = tot; SLOTB[e] = base + PRE[e]; }
    __syncthreads();
    if (F.tid < 64) {
        const int ee = F.tid & 31; const int nt = (TOT[ee] + 255) >> 8; int inc = nt;
#pragma unroll
        for (int o = 1; o < 32; o <<= 1) { const int v = __shfl_up(inc, o, 32); if (ee >= o) inc += v; }
        const int t0 = inc - nt;
        if (F.tid < 32) { SLOTB[ee] += t0 << 8;
            if (F.vcu == 0) { int* tm = (int*)(F.ws + WS_TILEMAP); for (int j = 0; j < nt; ++j) tm[1 + t0 + j] = ee; if (ee == 31) tm[0] = inc; } } }
    __syncthreads();
    const unsigned* ER = (const unsigned*)(F.ws + WS_ERANK); int* DEST = (int*)(F.ws + WS_DEST); int* ROWTOK = (int*)(F.ws + WS_ROWTOK);
    const int rows0 = F.vcu * 64;
    if (F.tid < 256) {
        const int p = F.tid, r = rows0 + (p >> 2), k = p & 3; const unsigned er = er_pre; const int slot = SLOTB[er >> 20] + (int)(er & 0xfffffu);
        DEST[(size_t)r * 4 + k] = slot; ROWTOK[slot] = r; }
}
__device__ __forceinline__ void p_combine(Frame& F, int l, bool next_norm) {
    const int gw = F.vcu * NWAVES + F.wave; const int r0 = gw * 8, b = r0 >> 13;
    const float* gf = modv(F, l, b, 5);
    const int c0 = 8 * F.lane;
    f32x4 gfv[2][2], g1[2][2], g2[2][2];
#pragma unroll
    for (int j = 0; j < 2; ++j)
#pragma unroll
        for (int q = 0; q < 2; ++q) { const int c = c0 + 512 * j + 4 * q; gfv[j][q] = *(const f32x4*)(gf + c);
            if (next_norm) { const f32x4 n4 = *(const f32x4*)(inp(I_NMIX) + (l + 1) * 1024 + c), s4 = *(const f32x4*)(modv(F, l + 1, b, 1) + c); g1[j][q] = n4 * (s4 + 1.0f); g2[j][q] = *(const f32x4*)(modv(F, l + 1, b, 0) + c); }
            else { g1[j][q] = (f32x4){0.f, 0.f, 0.f, 0.f}; g2[j][q] = g1[j][q]; } }
    const float* TW = (const float*)(F.ws + WS_TOPW); const int* DEST = (const int*)(F.ws + WS_DEST); const bf16* Y = (const bf16*)(F.ws + WS_Y);
    const bf16* XR1 = (const bf16*)(F.ws + WS_XS) + (size_t)64 * 1024 * 512; bf16* XR2 = (bf16*)(F.ws + WS_XS) + (size_t)96 * 1024 * 512;
    float tws[8][4]; int dss[8][4];
#pragma unroll
    for (int i = 0; i < 8; ++i) { const f32x4 t4 = *(const f32x4*)(TW + (size_t)(r0 + i) * 4); const v4u d4 = *(const v4u*)(DEST + (size_t)(r0 + i) * 4);
#pragma unroll
        for (int k = 0; k < 4; ++k) { tws[i][k] = __uint_as_float(__builtin_amdgcn_readfirstlane(__float_as_uint(t4[k]))); dss[i][k] = __builtin_amdgcn_readfirstlane((int)d4[k]); } }
#pragma unroll
    for (int i = 0; i < 8; ++i) { const int r = r0 + i;
        const f32x4 tw = (f32x4){tws[i][0], tws[i][1], tws[i][2], tws[i][3]}; const int d0 = dss[i][0], d1 = dss[i][1], d2 = dss[i][2], d3 = dss[i][3];
        f32x4 xo[2][2]; float ss = 0.f;
#pragma unroll
        for (int j = 0; j < 2; ++j) {
            const v4u y0 = __builtin_nontemporal_load((const v4u*)(Y + (size_t)d0 * D + c0 + 512 * j)), y1 = __builtin_nontemporal_load((const v4u*)(Y + (size_t)d1 * D + c0 + 512 * j)), y2 = __builtin_nontemporal_load((const v4u*)(Y + (size_t)d2 * D + c0 + 512 * j)), y3 = __builtin_nontemporal_load((const v4u*)(Y + (size_t)d3 * D + c0 + 512 * j));
            f32x4 m0, m1;
            m0.x = tw.x * bflo(y0.x) + tw.y * bflo(y1.x) + tw.z * bflo(y2.x) + tw.w * bflo(y3.x); m0.y = tw.x * bfhi(y0.x) + tw.y * bfhi(y1.x) + tw.z * bfhi(y2.x) + tw.w * bfhi(y3.x);
            m0.z = tw.x * bflo(y0.y) + tw.y * bflo(y1.y) + tw.z * bflo(y2.y) + tw.w * bflo(y3.y); m0.w = tw.x * bfhi(y0.y) + tw.y * bfhi(y1.y) + tw.z * bfhi(y2.y) + tw.w * bfhi(y3.y);
            m1.x = tw.x * bflo(y0.z) + tw.y * bflo(y1.z) + tw.z * bflo(y2.z) + tw.w * bflo(y3.z); m1.y = tw.x * bfhi(y0.z) + tw.y * bfhi(y1.z) + tw.z * bfhi(y2.z) + tw.w * bfhi(y3.z);
            m1.z = tw.x * bflo(y0.w) + tw.y * bflo(y1.w) + tw.z * bflo(y2.w) + tw.w * bflo(y3.w); m1.w = tw.x * bfhi(y0.w) + tw.y * bfhi(y1.w) + tw.z * bfhi(y2.w) + tw.w * bfhi(y3.w);
            const size_t xo_ = (size_t)r * D + c0 + 512 * j; const v4u xw = __builtin_nontemporal_load((const v4u*)(XR1 + xo_));
            xo[j][0] = (f32x4){bflo(xw.x), bfhi(xw.x), bflo(xw.y), bfhi(xw.y)} + gfv[j][0] * m0; xo[j][1] = (f32x4){bflo(xw.z), bfhi(xw.z), bflo(xw.w), bfhi(xw.w)} + gfv[j][1] * m1;
            if (next_norm) { v4u ow; ow.x = pk2(xo[j][0].x, xo[j][0].y); ow.y = pk2(xo[j][0].z, xo[j][0].w); ow.z = pk2(xo[j][1].x, xo[j][1].y); ow.w = pk2(xo[j][1].z, xo[j][1].w); *(v4u*)(XR2 + xo_) = ow; }
            else { *(f32x4*)(F.out + xo_) = xo[j][0]; *(f32x4*)(F.out + xo_ + 4) = xo[j][1]; }
#pragma unroll
            for (int q = 0; q < 2; ++q) ss += (xo[j][q].x * xo[j][q].x + xo[j][q].y * xo[j][q].y) + (xo[j][q].z * xo[j][q].z + xo[j][q].w * xo[j][q].w);
        }
        if (next_norm) {
            const float rstd = 1.0f / sqrtf(wave_sum(ss) * (1.0f / D) + NORM_EPS);
#pragma unroll
            for (int j = 0; j < 2; ++j) { const f32x4 a = xo[j][0] * rstd * g1[j][0] + g2[j][0], c = xo[j][1] * rstd * g1[j][1] + g2[j][1];
                v4u w; w.x = pk2(a.x, a.y); w.y = pk2(a.z, a.w); w.z = pk2(c.x, c.y); w.w = pk2(c.z, c.w);
                *(v4u*)((bf16*)(F.ws + WS_H) + (size_t)r * D + c0 + 512 * j) = w; }
        }
    }
}
#ifndef CQ_PER_ROUND
#define CQ_PER_ROUND 3
#endif
#ifndef MOE_XCD_ROUNDS
#define MOE_XCD_ROUNDS 1
#endif
#if MOE_XCD_ROUNDS
#define MOE_C(b) ((((b) & 7) << 5) | ((b) >> 3))
#else
#define MOE_C(b) (b)
#endif
#ifndef GEMM_SP2
#define GEMM_SP2 true
#endif
#ifndef ATTN_HAND
#define ATTN_HAND 1
#endif
#if ATTN_HAND
#define ATTN_CALL(l_, q_, o_, t_, v_, i_) attn2::attn_phase<8>(l_, (const attn2::bf16*)(q_), (attn2::bf16*)(o_), t_, v_, i_, attn_fast)
#else
#define ATTN_CALL(l_, q_, o_, t_, v_, i_) (void)attn_fast; da::phase(l_, (const da::bf16*)(q_), (da::bf16*)(o_), t_, v_, i_)
#endif
#ifndef XCD_CHUNKED
#define XCD_CHUNKED 0
#endif
#if XCD_CHUNKED
#define XCDMAP_VCU(bx, G) (bx)
#define XCDMAP_C(b) (((b) % 32) * 8 + (b) / 32)
#else
#define XCDMAP_VCU(bx, G) (((G) % 8 == 0) ? ((bx) % 8) * ((G) / 8) + (bx) / 8 : (bx))
#define XCDMAP_C(b) (b)
#endif
constexpr int N_PHASES = 2 + 11 * NL;
__device__ __forceinline__ void RETID_(Frame& F) { int t_ = threadIdx.x; asm volatile("" : "+v"(t_)); F.tid = t_; F.lane = t_ & 63; F.wave = __builtin_amdgcn_readfirstlane(t_ >> 6); }
struct Args { const float* in[30]; float* out; unsigned char* ws; int ph_lo, ph_hi, li, pad; };
#ifndef PHMASK
#define PHMASK 0x1fff
#endif
#define EN(j) (((PHMASK) >> (j)) & 1)
#ifndef REPMASK
#define REPMASK 0
#endif
#define REPS(j) (1 + (((REPMASK) >> (j)) & 1))
#define RETID() do { int t_ = threadIdx.x; asm volatile("" : "+v"(t_)); F.tid = t_; F.lane = t_ & 63; F.wave = __builtin_amdgcn_readfirstlane(t_ >> 6); } while (0)
#define IN(k) (lo <= (k) && (k) < hi && (RETID_(F), true))
#ifndef MOE_MERGE
#define MOE_MERGE 2
#endif
#ifndef BAR_REPS
#define BAR_REPS 1
#endif
#ifndef BAR_HOST
#define BAR_HOST 1
#endif
#define SEAM(k) do { if (IN(k) && IN((k) + 1)) { if (BAR_HOST) { RETID_(F); xcd_barrier_host(F, bar); } else xcd_barrier(bar); } } while (0)
#define H ((bf16*)(F.ws + WS_H))
#define PROJ ((bf16*)(F.ws + WS_PROJ))
#define BRB ((bf16*)(F.ws + WS_BR))
#define MERGED ((bf16*)(F.ws + WS_MERGED))
#define XS ((bf16*)(F.ws + WS_XS))
#define ACT ((bf16*)(F.ws + WS_ACT))
#define YB ((bf16*)(F.ws + WS_Y))

template <int l> __device__ __forceinline__ void layer_phases(Frame& F, const XcdBarrier& bar, const int lo, const int hi, unsigned char* lds) {
        const int pb = 2 + 11 * l;
        if (lo >= pb + 11 || hi <= pb) return;
        if (EN(2) && IN(pb + 0)) {
            pg8::Gemm g{H, (const bf16*)(F.ws + WS_WIN) + (size_t)l * INW * 1024, T, INW, 1024}; pg8::StaticOrder S; S.init(T, INW, F.G, XCDMAP_C((int)blockIdx.x));
            pg8::EpiIn E{PROJ, INW, 13, (bf16*)(F.ws + WS_XS), inp(I_DQN) + l * 64, inp(I_DKN) + l * 64, inp(I_SQN) + l * 64, inp(I_SKN) + l * 64, (LAS float*)(F.lds + LDSCTL_OFF + 4096), QSCALE, NORM_EPS};
            for (int rep = 0; rep < REPS(2); ++rep) pg8::gemm_phase<pg8::EpiIn, pg8::StaticOrder, true, GEMM_SP2>(F.lds + RING_OFF, g, S, E, F.tid);
            { const int nU = (T / 256) * (INW / 256), c = (int)blockIdx.x; RETID_(F); cq_run(F, ((nU + F.G - 1) / F.G - (c < nU ? (nU - c + F.G - 1) / F.G : 0)) * CQ_PER_ROUND); }
        } SEAM(pb + 0);
        if (EN(4) && IN(pb + 2)) {
#ifndef NO_LRU2
            { LruM W; bool first = true;
              for (int rep = 0; rep < REPS(3); ++rep) for (int u = F.vcu; u < 2 * LRU_NCH; u += F.G) { lru_unit_m<1>(F, W, l, first, u >> 7, u & 127); first = false; } }
#endif
            __syncthreads();
            RETID_(F); build_tabs(F);
            RETID_(F);
#ifndef NO_SWA
            for (int rep = 0; rep < REPS(14); ++rep) for (int u = F.vcu; u < 256; u += F.G) swa_unit_mfma(F, l, u >> 7, (u >> 6) & 1, u & 63);
#endif
            __syncthreads();
#ifndef NO_ATTN
            RETID_(F);
            int attn_fast;
            { const float gqa = fabsf(inp(I_DQN)[l * 64 + F.lane]), gka = fabsf(inp(I_DKN)[l * 64 + F.lane]); float mq = gqa, mk = gka;
              const LAS float* tb = (const LAS float*)(F.lds + TAB_OFF); float mt = 0.f;
#pragma unroll
              for (int i = 0; i < 8; ++i) mt = fmaxf(mt, fabsf(tb[F.lane + 64 * i]));
#pragma unroll
              for (int o = 1; o < 64; o <<= 1) { mq = fmaxf(mq, __shfl_xor(mq, o)); mk = fmaxf(mk, __shfl_xor(mk, o)); mt = fmaxf(mt, __shfl_xor(mt, o)); }
              const float bound = 11.5416f * mq * mk + mt;
              attn_fast = __builtin_amdgcn_readfirstlane((bound <= 100.0f) ? 1 : 0); }
            for (int rep = 0; rep < REPS(4); ++rep) ATTN_CALL((char*)lds + RING_OFF, F.ws + WS_XS, F.ws + WS_ODT, (const float*)(lds + TAB_OFF), F.vcu, F.tid);
#endif
        } SEAM(pb + 2);
        if (EN(5) && IN(pb + 3)) {
            for (int rep = 0; rep < REPS(13); ++rep) for (int u = F.vcu; u < 2 * LRU_NCH; u += F.G) lru_unit_p2(F, u >> 7, u & 127);
            __syncthreads(); RETID_(F);
            for (int rep = 0; rep < REPS(5); ++rep) p_diffpost(F, l);
        } SEAM(pb + 3);
        if (EN(6) && IN(pb + 4)) {
            pg8::Gemm g{BRB, (const bf16*)(F.ws + WS_WBR) + (size_t)l * 3 * 1024 * 512, 3 * T, 1024, 512}; pg8::BranchOrder S; S.init(T, F.G, XCDMAP_C((int)blockIdx.x));
            pg8::EpiBranch E{MERGED, PROJ, INW};
            for (int rep = 0; rep < REPS(6); ++rep) pg8::gemm_phase<pg8::EpiBranch, pg8::BranchOrder, true, GEMM_SP2>(F.lds + RING_OFF, g, S, E, F.tid);
        } SEAM(pb + 4);
        if (EN(7) && IN(pb + 5)) {
            pg8::Gemm g{MERGED, (const bf16*)(F.ws + WS_WOUT) + (size_t)l * 1024 * 1024, T, 1024, 1024}; pg8::StaticOrder S; S.init(T, 1024, F.G, XCDMAP_C((int)blockIdx.x));
            bf16* const XR1 = (bf16*)(F.ws + WS_XS) + (size_t)64 * 1024 * 512; bf16* const XR2 = (bf16*)(F.ws + WS_XS) + (size_t)96 * 1024 * 512;
            if (l == 0) { pg8::EpiOutT<false> E{(const void*)inp(I_X), XR1, modv(F, l, 0, 2)}; pg8::gemm_phase<pg8::EpiOutT<false>, pg8::StaticOrder, true, GEMM_SP2>(F.lds + RING_OFF, g, S, E, F.tid); }
            else { pg8::EpiOutT<true> E{(const void*)XR2, XR1, modv(F, l, 0, 2)}; pg8::gemm_phase<pg8::EpiOutT<true>, pg8::StaticOrder, true, GEMM_SP2>(F.lds + RING_OFF, g, S, E, F.tid); }
        } SEAM(pb + 5);
        if (EN(8) && IN(pb + 6)) { for (int rep = 0; rep < REPS(8); ++rep) { p_router(F, l); __syncthreads(); } } SEAM(pb + 6);
        if (EN(9) && IN(pb + 7)) { for (int rep = 0; rep < REPS(9); ++rep) { p_scatter(F); __syncthreads(); } if (l == 1 || CQ_X1 > 0) { RETID_(F); cq_run(F, 1 << 30, l == 1 ? CQ_TOTAL : CQ_X1); } } SEAM(pb + 7);
        if ((EN(10) || EN(11)) && (IN(pb + 8) || IN(pb + 9))) {
            constexpr bool MERGE = ((MOE_MERGE) >> l) & 1;
            LAS int* TM = (LAS int*)(F.lds + TMAP_OFF); const int* tmg = (const int*)(F.ws + WS_TILEMAP);
            if (F.tid < 512) TM[F.tid] = tmg[F.tid];
            LAS unsigned* RO = (LAS unsigned*)(F.lds + LDSCTL_OFF + 4096);
            if (EN(10) && IN(pb + 8)) { const int* ROWTOK = (const int*)(F.ws + WS_ROWTOK); const int c = MOE_C((int)blockIdx.x);
                for (int i = F.tid; i < 9 * 256; i += NWAVES * 64) { const int u = i >> 8, L = u * F.G + c;
                    const int tok = ROWTOK[(L >> 3) * 256 + (i & 255)]; RO[i] = ((unsigned)tok < (unsigned)T ? (unsigned)tok : 0u) * 2048u; } }
            __syncthreads();
            const int ntiles = __builtin_amdgcn_readfirstlane(TM[0]);
            if (EN(10) && IN(pb + 8)) {
                pg8::Gemm g{H, (const bf16*)(F.ws + WS_W1) + (size_t)l * NEXP * 2048 * 1024, NR_MAX, 2048, 1024}; pg8::MoeOrder S{TM + 1, ntiles, 8, F.G, MOE_C((int)blockIdx.x)};
                pg8::EpiGlu E{ACT, inp(I_B1) + (size_t)l * NEXP * 2048};
                if constexpr (MERGE) { pg8::MoeOrderSig SS{{TM + 1, ntiles, 8, F.G, MOE_C((int)blockIdx.x)}, (unsigned*)(F.ctl + CW_TILE + l * 512)}; pg8::EpiGluT<true> EW{ACT, inp(I_B1) + (size_t)l * NEXP * 2048};
                    pg8::gemm_phase<pg8::EpiGluT<true>, pg8::MoeOrderSig, true, true, true>(F.lds + RING_OFF, g, SS, EW, F.tid, RO); }
                else for (int rep = 0; rep < REPS(10); ++rep) pg8::gemm_phase<pg8::EpiGlu, pg8::MoeOrder, true, true, true>(F.lds + RING_OFF, g, S, E, F.tid, RO);
                if (l == 0) { const int nU = ntiles * 8, c = MOE_C((int)blockIdx.x); RETID_(F); cq_run(F, ((nU + F.G - 1) / F.G - (c < nU ? (nU - c + F.G - 1) / F.G : 0)) * CQ_PER_ROUND); }
                if (l == 0) { RETID_(F); cq_run(F, 1 << 30, CQ_X1 + CQ_W2L0); }
            }
            if constexpr (!MERGE) SEAM(pb + 8);
            if (EN(11) && IN(pb + 9)) {
                pg8::Gemm g{ACT, (const bf16*)(F.ws + WS_W2) + (size_t)l * NEXP * 1024 * 1024, NR_MAX, 1024, 1024}; const int c2 = MERGE ? (MOE_C((int)blockIdx.x) + F.G - (ntiles * 8) % F.G) % F.G : MOE_C((int)blockIdx.x);
                pg8::MoeOrder S{TM + 1, ntiles, 4, F.G, c2};
                pg8::EpiY E{YB, inp(I_B2) + (size_t)l * NEXP * 1024};
                if constexpr (MERGE) { pg8::MoeOrderWait SW{{TM + 1, ntiles, 4, F.G, c2}, (unsigned*)(F.ctl + CW_TILE + l * 512)};
                    pg8::gemm_phase<pg8::EpiY, pg8::MoeOrderWait, true, GEMM_SP2>(F.lds + RING_OFF, g, SW, E, F.tid); }
                else for (int rep = 0; rep < REPS(11); ++rep) pg8::gemm_phase<pg8::EpiY, pg8::MoeOrder, true, GEMM_SP2>(F.lds + RING_OFF, g, S, E, F.tid);
                if (l == 0) { const int nU = ntiles * 4, c = MOE_C((int)blockIdx.x); RETID_(F); cq_run(F, ((nU + F.G - 1) / F.G - (c < nU ? (nU - c + F.G - 1) / F.G : 0)) * CQ_PER_ROUND); }
            }
        }
        SEAM(pb + 9);
        if (EN(12) && IN(pb + 10)) { p_combine(F, l, l + 1 < NL); if (l == 0) { __syncthreads(); RETID_(F); cq_run(F, 1 << 30, CQ_X1 + CQ_W2L0 + TI_DENSE); } } SEAM(pb + 10);
}
__global__ void __launch_bounds__(NWAVES * 64, 2) mk_fwd(Args args) {
    extern __shared__ __attribute__((aligned(16))) unsigned char lds[];
    Frame F;
    F.lds = (LAS unsigned char*)lds;
    F.MISC = (volatile LAS unsigned*)(F.lds + MISC_OFF);
    F.tid = threadIdx.x; F.lane = F.tid & 63; F.wave = __builtin_amdgcn_readfirstlane(F.tid >> 6);
    F.G = gridDim.x; { const int bx = blockIdx.x; F.vcu = XCDMAP_VCU(bx, F.G); }
    F.out = args.out; F.ws = args.ws;
    F.ctl = (gu32*)(args.ws + WS_CTL);
    for (int u = F.tid; u < (LDS_BYTES - LDSCTL_OFF) / 4; u += NWAVES * 64) ((LAS unsigned*)(F.lds + LDSCTL_OFF))[u] = 0u;
    __syncthreads();
    const bool one = (args.ph_hi - args.ph_lo) > 1;
    XcdBarrier bar; bar.bar = (unsigned*)(F.ctl + CW_BAR); bar.x = 0; bar.st = nullptr;
    if (one) bar = xcd_barrier_post((unsigned*)(F.ctl + CW_BAR), F.MISC + 8);
    const int lo = args.ph_lo, hi = args.ph_hi;
    if (EN(0) && IN(0)) { for (int rep = 0; rep < REPS(0); ++rep) { p0_prologue(F); __syncthreads(); } } SEAM(0);
    if (EN(1) && IN(1)) { p_norm_in(F, 0, inp(I_X)); } SEAM(1);
    layer_phases<0>(F, bar, lo, hi, lds);
    layer_phases<1>(F, bar, lo, hi, lds);
#undef IN
#undef SEAM
#undef H
#undef PROJ
#undef BRB
#undef MERGED
#undef XS
#undef ACT
#undef YB
}

extern "C" void kernel_launch(void* const* d_in, const int* in_sizes, int n_in, void* d_out, int out_size, void* d_ws, size_t ws_size, hipStream_t stream) {
    static int grid = 0;
    if (grid == 0) {
        if (n_in != 30 || in_sizes[0] != T * D || out_size != T * D || ws_size < WS_END) { fprintf(stderr, "kernel_launch: unexpected shapes (n_in %d, in0 %d, out %d, ws %zu); nothing launched\n", n_in, n_in > 0 ? in_sizes[0] : -1, out_size, ws_size); grid = -1; return; }
        int dev = 0, cus = 0, per_cu = 0;
        if (hipGetDevice(&dev) != hipSuccess || hipDeviceGetAttribute(&cus, hipDeviceAttributeMultiprocessorCount, dev) != hipSuccess) { grid = -1; return; }
        if (hipFuncSetAttribute((const void*)mk_fwd, hipFuncAttributeMaxDynamicSharedMemorySize, LDS_BYTES) != hipSuccess) { fprintf(stderr, "kernel_launch: hipFuncSetAttribute failed\n"); grid = -1; return; }
        if (hipOccupancyMaxActiveBlocksPerMultiprocessor(&per_cu, (const void*)mk_fwd, NWAVES * 64, LDS_BYTES) != hipSuccess || per_cu < 1) fprintf(stderr, "kernel_launch: occupancy query reports %d blocks per CU\n", per_cu);
        (void)hipGetLastError();
        grid = 256;
        if (cus != 256) fprintf(stderr, "kernel_launch: device has %d CUs; this kernel's static maps assume 256\n", cus);
    }
    if (grid < 0) return;
    if (hipMemsetAsync((char*)d_ws + WS_CTL, 0, CTL_ZERO_BYTES, stream) != hipSuccess) return;
    Args a{};
    for (int i = 0; i < 30; ++i) a.in[i] = (const float*)d_in[i];
    a.out = (float*)d_out; a.ws = (unsigned char*)d_ws;
#if MK_ONE_LAUNCH
    a.ph_lo = 0; a.ph_hi = N_PHASES; a.li = 0;
    hipLaunchKernelGGL(mk_fwd, dim3(grid), dim3(NWAVES * 64), LDS_BYTES, stream, a);
#else
    for (int p = 0; p < N_PHASES; ++p) { a.ph_lo = p; a.ph_hi = p + 1; a.li = p; hipLaunchKernelGGL(mk_fwd, dim3(grid), dim3(NWAVES * 64), LDS_BYTES, stream, a); }
#endif
}
```
